# Optimizing an MI355X kernel written in HIP

```python
import math
import jax, jax.numpy as jnp
from jax import lax
import numpy as np

D_MODEL = 4096
BATCH = 4
SEQ = 4096
DEPTH = 1

HEAD_DIM = 128
MIX_WIDTH = D_MODEL
MOBA_WIDTH = MIX_WIDTH // 2
MOBA_HEADS = MOBA_WIDTH // HEAD_DIM
DIFF_WIDTH = MIX_WIDTH - MOBA_WIDTH
DIFF_HEADS = DIFF_WIDTH // (2 * HEAD_DIM)
IN_WIDTH = 3 * MOBA_WIDTH + 3 * DIFF_WIDTH
MOBA_BLOCK = 256
MOBA_TOPK = 3
MOBA_QCHUNK = 32
DIFF_QBLOCK = 128
ROT_DIM = HEAD_DIM // 4
ROPE_THETA = 500000.0
MEM_LEN = 256
MEM_HEADS = 4
MEM_HEAD_DIM = 128
MEM_WIDTH = MEM_HEADS * MEM_HEAD_DIM
D_FF = 4 * D_MODEL
EPS = 1e-5

kernel_name = "hybrid_moba_diffattn_memxattn_sqrelu"


def rms_norm(x, g):
    xf = x.astype(jnp.float32)
    y = xf * lax.rsqrt(jnp.mean(xf * xf, axis=-1, keepdims=True) + EPS)
    return (y * g.astype(jnp.float32)).astype(x.dtype)


def rotary_tables(seq_len):
    pos = jnp.arange(seq_len, dtype=jnp.float32)
    inv_freq = ROPE_THETA ** (-jnp.arange(0, ROT_DIM, 2, dtype=jnp.float32) / ROT_DIM)
    ang = pos[:, None] * inv_freq[None, :]
    return jnp.cos(ang), jnp.sin(ang)


def apply_partial_rope(x, cos, sin):
    half = ROT_DIM // 2
    xr = x[..., :ROT_DIM].astype(jnp.float32)
    x1, x2 = xr[..., :half], xr[..., half:]
    rot = jnp.concatenate([x1 * cos - x2 * sin, x2 * cos + x1 * sin], axis=-1).astype(x.dtype)
    return jnp.concatenate([rot, x[..., ROT_DIM:]], axis=-1)


def to_heads(t, n_heads, dh):
    b, s, _ = t.shape
    return t.reshape(b, s, n_heads, dh).transpose(0, 2, 1, 3)


def from_heads(t):
    b, h, s, dh = t.shape
    return t.transpose(0, 2, 1, 3).reshape(b, s, h * dh)


def moba_attention(q, k, v):
    B, H, S, dh = q.shape
    nb = -(-S // MOBA_BLOCK)
    pad = nb * MOBA_BLOCK - S
    kp = jnp.pad(k, ((0, 0), (0, 0), (0, pad), (0, 0)))
    vp = jnp.pad(v, ((0, 0), (0, 0), (0, pad), (0, 0)))
    kb = kp.reshape(B, H, nb, MOBA_BLOCK, dh)
    vb = vp.reshape(B, H, nb, MOBA_BLOCK, dh)
    kmean = jnp.mean(kb.astype(jnp.float32), axis=3).astype(k.dtype)
    topk = min(MOBA_TOPK, nb)
    scale = dh ** -0.5
    bidx = jnp.arange(B)[:, None, None, None]
    hidx = jnp.arange(H)[None, :, None, None]

    def chunk(c):
        start = c * MOBA_QCHUNK
        cur = start // MOBA_BLOCK
        qc = lax.dynamic_slice_in_dim(q, start, MOBA_QCHUNK, axis=2)
        gate = jnp.einsum('bhqd,bhnd->bhqn', qc, kmean).astype(jnp.float32)
        past = jnp.arange(nb) < cur
        gate = jnp.where(past[None, None, None, :], gate, -jnp.inf)
        _, sel = lax.top_k(gate, topk)
        sel_valid = sel < cur
        k_sel = kb[bidx, hidx, sel]
        v_sel = vb[bidx, hidx, sel]
        s_sel = jnp.einsum('bhqd,bhqnkd->bhqnk', qc, k_sel).astype(jnp.float32) * scale
        s_sel = jnp.where(sel_valid[..., None], s_sel, -jnp.inf)
        k_own = lax.dynamic_slice_in_dim(kp, cur * MOBA_BLOCK, MOBA_BLOCK, axis=2)
        v_own = lax.dynamic_slice_in_dim(vp, cur * MOBA_BLOCK, MOBA_BLOCK, axis=2)
        s_own = jnp.einsum('bhqd,bhkd->bhqk', qc, k_own).astype(jnp.float32) * scale
        qpos = start + jnp.arange(MOBA_QCHUNK)
        kpos = cur * MOBA_BLOCK + jnp.arange(MOBA_BLOCK)
        s_own = jnp.where(kpos[None, :] <= qpos[:, None], s_own, -jnp.inf)
        s = jnp.concatenate([s_sel.reshape(B, H, MOBA_QCHUNK, topk * MOBA_BLOCK), s_own], axis=-1)
        p = jax.nn.softmax(s, axis=-1).astype(v.dtype)
        p_sel = p[..., :topk * MOBA_BLOCK].reshape(B, H, MOBA_QCHUNK, topk, MOBA_BLOCK)
        p_own = p[..., topk * MOBA_BLOCK:]
        return (jnp.einsum('bhqnk,bhqnkd->bhqd', p_sel, v_sel)
                + jnp.einsum('bhqk,bhkd->bhqd', p_own, v_own))

    out = lax.map(chunk, jnp.arange(S // MOBA_QCHUNK))
    return out.transpose(1, 2, 0, 3, 4).reshape(B, H, S, dh)


def diff_attention(q, k, v, lam, lambda_init, subln_g):
    B, H2, S, dh = q.shape
    H = H2 // 2
    scale = dh ** -0.5
    kpos = jnp.arange(S)

    def block(c):
        start = c * DIFF_QBLOCK
        qc = lax.dynamic_slice_in_dim(q, start, DIFF_QBLOCK, axis=2)
        s = jnp.einsum('bhqd,bhkd->bhqk', qc, k).astype(jnp.float32) * scale
        qpos = start + jnp.arange(DIFF_QBLOCK)
        s = jnp.where(kpos[None, :] <= qpos[:, None], s, -jnp.inf)
        p = jax.nn.softmax(s, axis=-1).reshape(B, H, 2, DIFF_QBLOCK, S)
        a = p[:, :, 0] - lam * p[:, :, 1]
        return jnp.einsum('bhqk,bhkd->bhqd', a.astype(v.dtype), v)

    out = lax.map(block, jnp.arange(S // DIFF_QBLOCK))
    out = out.transpose(1, 2, 0, 3, 4).reshape(B, H, S, 2 * dh)
    return (rms_norm(out, subln_g).astype(jnp.float32) * (1.0 - lambda_init)).astype(v.dtype)


def memory_cross_attention(h, m, w_cq, w_ckv, w_co):
    B, S, _ = h.shape
    q = to_heads(h @ w_cq, MEM_HEADS, MEM_HEAD_DIM)
    kv = (m @ w_ckv).reshape(B, MEM_LEN, 2, MEM_HEADS, MEM_HEAD_DIM)
    k = kv[:, :, 0].transpose(0, 2, 1, 3)
    v = kv[:, :, 1].transpose(0, 2, 1, 3)
    s = jnp.einsum('bhqd,bhmd->bhqm', q, k).astype(jnp.float32) * (MEM_HEAD_DIM ** -0.5)
    p = jax.nn.softmax(s, axis=-1).astype(v.dtype)
    o = jnp.einsum('bhqm,bhmd->bhqd', p, v)
    return from_heads(o) @ w_co


def setup_inputs(seed: int = 0) -> dict:
    key = jax.random.key(seed)
    ks = jax.random.split(key, 24)
    f32 = jnp.float32

    def nrm(k, shape, scale):
        return jax.random.normal(k, shape, f32) * scale

    def gain(k, shape):
        return 1.0 + 0.02 * jax.random.normal(k, shape, f32)

    return {
        "x": nrm(ks[0], (BATCH, SEQ, D_MODEL), 1.0),
        "mem": nrm(ks[1], (BATCH, MEM_LEN, D_MODEL), 1.0),
        "ln_mix_g": gain(ks[2], (DEPTH, D_MODEL)),
        "w_in": nrm(ks[3], (DEPTH, D_MODEL, IN_WIDTH), D_MODEL ** -0.5),
        "moba_out_g": gain(ks[4], (DEPTH, MOBA_WIDTH)),
        "lambda_q1": nrm(ks[5], (DEPTH, HEAD_DIM), 0.1),
        "lambda_k1": nrm(ks[6], (DEPTH, HEAD_DIM), 0.1),
        "lambda_q2": nrm(ks[7], (DEPTH, HEAD_DIM), 0.1),
        "lambda_k2": nrm(ks[8], (DEPTH, HEAD_DIM), 0.1),
        "diff_subln_g": gain(ks[9], (DEPTH, 2 * HEAD_DIM)),
        "w_out": nrm(ks[10], (DEPTH, MIX_WIDTH, D_MODEL), MIX_WIDTH ** -0.5),
        "ln_cross_g": gain(ks[11], (DEPTH, D_MODEL)),
        "ln_mem_g": gain(ks[12], (DEPTH, D_MODEL)),
        "w_cq": nrm(ks[13], (DEPTH, D_MODEL, MEM_WIDTH), D_MODEL ** -0.5),
        "w_ckv": nrm(ks[14], (DEPTH, D_MODEL, 2 * MEM_WIDTH), D_MODEL ** -0.5),
        "w_co": nrm(ks[15], (DEPTH, MEM_WIDTH, D_MODEL), MEM_WIDTH ** -0.5),
        "ln_mlp_g": gain(ks[16], (DEPTH, D_MODEL)),
        "w_up": nrm(ks[17], (DEPTH, D_MODEL, D_FF), D_MODEL ** -0.5),
        "w_down": nrm(ks[18], (DEPTH, D_FF, D_MODEL), D_FF ** -0.5),
        "final_g": gain(ks[19], (D_MODEL,)),
    }


def reference(x, mem, ln_mix_g, w_in, moba_out_g, lambda_q1, lambda_k1, lambda_q2, lambda_k2,
              diff_subln_g, w_out, ln_cross_g, ln_mem_g, w_cq, w_ckv, w_co, ln_mlp_g,
              w_up, w_down, final_g):
    B, S, _ = x.shape
    cos, sin = rotary_tables(S)
    splits = [MOBA_WIDTH, 2 * MOBA_WIDTH, 3 * MOBA_WIDTH,
              3 * MOBA_WIDTH + DIFF_WIDTH, 3 * MOBA_WIDTH + 2 * DIFF_WIDTH]
    for l in range(DEPTH):
        h = rms_norm(x, ln_mix_g[l])
        proj = h @ w_in[l]
        mq, mk, mv, dq, dk, dv = jnp.split(proj, splits, axis=-1)
        mq = apply_partial_rope(to_heads(mq, MOBA_HEADS, HEAD_DIM), cos, sin)
        mk = apply_partial_rope(to_heads(mk, MOBA_HEADS, HEAD_DIM), cos, sin)
        mv = to_heads(mv, MOBA_HEADS, HEAD_DIM)
        dq = apply_partial_rope(to_heads(dq, 2 * DIFF_HEADS, HEAD_DIM), cos, sin)
        dk = apply_partial_rope(to_heads(dk, 2 * DIFF_HEADS, HEAD_DIM), cos, sin)
        dv = to_heads(dv, DIFF_HEADS, 2 * HEAD_DIM)

        mo = moba_attention(mq, mk, mv)
        mo = rms_norm(mo, moba_out_g[l].reshape(MOBA_HEADS, 1, HEAD_DIM))

        lambda_init = 0.8 - 0.6 * math.exp(-0.3 * l)
        lam = (jnp.exp(jnp.sum(lambda_q1[l].astype(jnp.float32) * lambda_k1[l].astype(jnp.float32)))
               - jnp.exp(jnp.sum(lambda_q2[l].astype(jnp.float32) * lambda_k2[l].astype(jnp.float32)))
               + lambda_init)
        do = diff_attention(dq, dk, dv, lam, lambda_init, diff_subln_g[l])

        merged = jnp.concatenate([from_heads(mo), from_heads(do)], axis=-1)
        x = x + merged @ w_out[l]

        hc = rms_norm(x, ln_cross_g[l])
        m = rms_norm(mem, ln_mem_g[l])
        x = x + memory_cross_attention(hc, m, w_cq[l], w_ckv[l], w_co[l])

        hm = rms_norm(x, ln_mlp_g[l])
        x = x + jnp.square(jax.nn.relu(hm @ w_up[l])) @ w_down[l]
    return rms_norm(x, final_g)
```

```cpp
#include <hip/hip_runtime.h>
#include <cstdio>
#include <cstdint>
namespace pg8 {
#define PG8_LAS __attribute__((address_space(3)))
typedef unsigned short bf16_t;
typedef short bf16x8 __attribute__((ext_vector_type(8)));
typedef float f32x4 __attribute__((ext_vector_type(4)));
typedef unsigned u32x4 __attribute__((ext_vector_type(4)));
constexpr int BM = 256, BK = 64, HALF = 128, HTB = HALF * BK * 2  , STAGE_BYTES = 8 * HTB, NXCD = 8, WGM = 8;

__host__ __device__ __forceinline__ int lds_byte(int r, int c) { const int st = (r >> 4) * 2 + (c >> 5), rr = r & 15, cc = c & 31, ob = rr * 64 + cc * 2; return st * 1024 + (ob ^ (((ob >> 9) & 1) << 5)); }
__host__ __device__ __forceinline__ void stage_rc(int b, int& R, int& C) { const int st = b / 1024, sb = b % 1024, swz = sb ^ (((sb >> 9) & 1) << 5); R = (st >> 1) * 16 + swz / 64; C = (st & 1) * 32 + (swz % 64) / 2; }
__host__ __device__ __forceinline__ int perm32(int rho) { const int n = rho >> 4, i = rho & 15; return 8 * (i >> 2) + 4 * n + (i & 3); }

struct Unit { int pm, pn; };
struct Gemm { const bf16_t* A; const bf16_t* Bt; int M, N, K; };

struct StaticOrder {
    int nM, nN, nwg, G, c;
    __host__ __device__ void init(int M, int N, int G_, int c_) { nM = M / BM; nN = N / BM; nwg = nM * nN; G = G_; c = c_; }
    __host__ __device__ bool next(int i, Unit& u) const {
        const long L = (long)i * G + c; if (L >= nwg) return false;
        int wgid = (int)L; { const int q = nwg / NXCD, r = nwg % NXCD, xcd = wgid % NXCD, off = wgid / NXCD; wgid = (xcd < r ? xcd * (q + 1) : r * (q + 1) + (xcd - r) * q) + off; }
        const int nig = WGM * nN, gid = wgid / nig, fm = gid * WGM, gsz = (nM - fm) < WGM ? (nM - fm) : WGM;
        u.pm = fm + ((wgid % nig) % gsz); u.pn = (wgid % nig) / gsz; return true;
    }
    __device__ __forceinline__ void a_ready(const Unit&) const {}
    __device__ __forceinline__ void done(const Unit&) const {}
};

__device__ __forceinline__ unsigned cvt_pk_bf16(float lo, float hi) { unsigned r; asm volatile("v_cvt_pk_bf16_f32 %0, %1, %2" : "=v"(r) : "v"(lo), "v"(hi)); return r; }
typedef unsigned u32x2 __attribute__((ext_vector_type(2)));
constexpr float RMS_EPS = 1e-5f;
constexpr int DM = 4096;
__device__ __forceinline__ void rope4(f32x4& v, const f32x4& c, const f32x4& s, int fq) {
#pragma unroll
    for (int j = 0; j < 4; ++j) {
        auto rr = __builtin_amdgcn_permlane32_swap(__float_as_uint(v[j]), __float_as_uint(v[j]), false, false);
        const float x1 = __uint_as_float(rr[0]), x2 = __uint_as_float(rr[1]);
        v[j] = (fq < 2) ? (x1 * c[j] - x2 * s[j]) : (x2 * c[j] + x1 * s[j]);
    }
}
typedef int i32x8 __attribute__((ext_vector_type(8)));
typedef short s16x16 __attribute__((ext_vector_type(16)));
__device__ __forceinline__ unsigned pk4_fp8(float a, float b, float c, float d) {
    a = fminf(fmaxf(a, -448.f), 448.f); b = fminf(fmaxf(b, -448.f), 448.f); c = fminf(fmaxf(c, -448.f), 448.f); d = fminf(fmaxf(d, -448.f), 448.f);
    int w = 0; w = __builtin_amdgcn_cvt_pk_fp8_f32(a, b, w, false); w = __builtin_amdgcn_cvt_pk_fp8_f32(c, d, w, true); return (unsigned)w;
}
struct EpiProj {
    static constexpr bool PERM = true, AFTER_DRAIN = false;
    bf16_t* QKV; const float* ss; const float* cs; int g0; float sc; float* kmf;
    __device__ __forceinline__ void operator()(const f32x4 (&acc)[2][2][4][2], const Unit& u, int wr, int wc, int fr, int fq) const {
        const int g = g0 + (u.pn >> 3), b = u.pm >> 4;
        const bool rope = (wc == 0) && (g != 2) && (g != 5);
        f32x4 ksum[2][2] = {{{0.f, 0.f, 0.f, 0.f}, {0.f, 0.f, 0.f, 0.f}}, {{0.f, 0.f, 0.f, 0.f}, {0.f, 0.f, 0.f, 0.f}}};
#pragma unroll
        for (int ai = 0; ai < 2; ++ai)
#pragma unroll
            for (int m = 0; m < 4; ++m) {
                const int rit = ai * HALF + wr * 64 + m * 16 + fr, s = (u.pm & 15) * 256 + rit, grow = u.pm * 256 + rit;
                const float rs = rsqrtf(ss[grow] * (1.0f / 4096.0f) + RMS_EPS) * sc;
                f32x4 c0 = {1.f, 1.f, 1.f, 1.f}, c1 = c0, s0 = {0.f, 0.f, 0.f, 0.f}, s1 = s0;
                if (rope) { const float* t = cs + (size_t)s * 32 + 8 * (fq & 1); c0 = *(const f32x4*)t; c1 = *(const f32x4*)(t + 4); s0 = *(const f32x4*)(t + 16); s1 = *(const f32x4*)(t + 20); }
#pragma unroll
                for (int bj = 0; bj < 2; ++bj) {
                    f32x4 v0 = acc[ai][bj][m][0] * rs, v1 = acc[ai][bj][m][1] * rs;
                    if (rope) { rope4(v0, c0, s0, fq); rope4(v1, c1, s1, fq); }
                    const int head = (u.pn & 7) * 2 + bj;
                    bf16_t* dst = QKV + ((((size_t)(g * 4 + b) * 16 + head) * 4096 + s) * 128 + wc * 32 + 8 * fq);
                    if (g == 1) {
                        unsigned char* d8 = (unsigned char*)(QKV + (size_t)g * 4 * 16 * 4096 * 128) + ((((size_t)b * 16 + head) * 4096 + s) * 128 + (wc >> 1) * 64 + (fq & 1) * 32 + ((wc & 1) * 2 + (fq >> 1)) * 8);
                        u32x2 w8; w8.x = pk4_fp8(v0[0] * 16.f, v0[1] * 16.f, v0[2] * 16.f, v0[3] * 16.f); w8.y = pk4_fp8(v1[0] * 16.f, v1[1] * 16.f, v1[2] * 16.f, v1[3] * 16.f);
                        *(u32x2*)d8 = w8;
                    } else if (g == 3 || g == 4) {
                        unsigned char* d8 = (unsigned char*)(QKV + (size_t)g * 4 * 16 * 4096 * 128) + ((((size_t)b * 16 + head) * 4096 + s) * 128 + wc * 32 + 8 * fq);
                        u32x2 w8; w8.x = pk4_fp8(v0[0] * 16.f, v0[1] * 16.f, v0[2] * 16.f, v0[3] * 16.f); w8.y = pk4_fp8(v1[0] * 16.f, v1[1] * 16.f, v1[2] * 16.f, v1[3] * 16.f);
                        *(u32x2*)d8 = w8;
                    } else {
                    u32x4 w; w.x = cvt_pk_bf16(v0[0], v0[1]); w.y = cvt_pk_bf16(v0[2], v0[3]); w.z = cvt_pk_bf16(v1[0], v1[1]); w.w = cvt_pk_bf16(v1[2], v1[3]);
                    *(u32x4*)dst = w; }
                    if (g == 1) { ksum[bj][0] += v0; ksum[bj][1] += v1; }
                }
            }
        if (g == 1) {
#pragma unroll
            for (int bj = 0; bj < 2; ++bj)
#pragma unroll
                for (int n = 0; n < 2; ++n)
#pragma unroll
                    for (int j = 0; j < 4; ++j) { float t = ksum[bj][n][j]; t += __shfl_xor(t, 1); t += __shfl_xor(t, 2); t += __shfl_xor(t, 4); t += __shfl_xor(t, 8);
                        if (fr == 0) unsafeAtomicAdd(kmf + (((size_t)(b * 16 + (u.pn & 7) * 2 + bj) * 16 + (u.pm & 15)) * 128 + wc * 32 + 8 * fq + 4 * n + j), t); }
        }
    }
};
struct EpiVT {
    static constexpr bool PERM = true, AFTER_DRAIN = false;
    unsigned char* VT0; unsigned char* VT1; const float* ss; float sc;
    __device__ __forceinline__ void operator()(const f32x4 (&acc)[2][2][4][2], const Unit& u, int wr, int wc, int fr, int fq) const {
        const int b = u.pm >> 4;
#pragma unroll
        for (int ai = 0; ai < 2; ++ai) { float rs4[4];
#pragma unroll
            for (int m = 0; m < 4; ++m) rs4[m] = rsqrtf(ss[u.pm * 256 + ai * HALF + wr * 64 + m * 16 + fr] * (1.0f / 4096.0f) + RMS_EPS) * (sc * 16.f);
            const int T = (u.pm & 15) * 4 + ai * 2 + wr;
#pragma unroll
            for (int bj = 0; bj < 2; ++bj) { const int head = (u.pn & 7) * 2 + bj;
                unsigned char* base = ((u.pn >> 3) ? VT1 : VT0) + (((size_t)b * 16 + head) * 64 + T) * 8192 + (wc * 32 + 8 * fq) * 64 + 32 * (fr >> 3) + 4 * (fr & 7);
#pragma unroll
                for (int n = 0; n < 2; ++n)
#pragma unroll
                    for (int jj = 0; jj < 4; ++jj)
                        *(unsigned*)(base + (4 * n + jj) * 64) = pk4_fp8(acc[ai][bj][0][n][jj] * rs4[0], acc[ai][bj][1][n][jj] * rs4[1], acc[ai][bj][2][n][jj] * rs4[2], acc[ai][bj][3][n][jj] * rs4[3]); } }
    }
};
struct EpiResid {
    static constexpr bool PERM = false, AFTER_DRAIN = false;
    const float* xin; float* xout; bf16_t* xb; unsigned char* x8; float* ss; float sc;
    __device__ __forceinline__ void operator()(const f32x4 (&acc)[2][2][4][2], const Unit& u, int wr, int wc, int fr, int fq) const {
        const int row0 = u.pm * BM + wr * 64 + fr, col0 = u.pn * BM + wc * 32 + 4 * fq;
#pragma unroll
        for (int ai = 0; ai < 2; ++ai)
#pragma unroll
            for (int m = 0; m < 4; ++m) {
                const int row = row0 + ai * HALF + m * 16; const size_t off = (size_t)row * DM + col0; float q = 0.f;
#pragma unroll
                for (int bj = 0; bj < 2; ++bj)
#pragma unroll
                    for (int n = 0; n < 2; ++n) { const size_t o2 = off + bj * HALF + n * 16;
                        const f32x4 v = *(const f32x4*)(xin + o2) + acc[ai][bj][m][n] * sc; *(f32x4*)(xout + o2) = v;
                        q += (v[0] * v[0] + v[1] * v[1]) + (v[2] * v[2] + v[3] * v[3]);
                        if (xb) { u32x2 w; w.x = cvt_pk_bf16(v[0], v[1]); w.y = cvt_pk_bf16(v[2], v[3]); *(u32x2*)(xb + o2) = w; }
                        if (x8) *(unsigned*)(x8 + o2) = pk4_fp8(v[0], v[1], v[2], v[3]); }
                q += __shfl_xor(q, 16); q += __shfl_xor(q, 32);
                if (fq == 0) unsafeAtomicAdd(ss + row, q);
                asm volatile("" ::: "memory");
            }
    }
};
template <bool XF32> struct EpiRes {
    static constexpr bool PERM = true, AFTER_DRAIN = false;
    const void* xin; bf16_t* xb; unsigned char* x8; float* ss; float sc;
    __device__ __forceinline__ void operator()(const f32x4 (&acc)[2][2][4][2], const Unit& u, int wr, int wc, int fr, int fq) const {
        const int row0 = u.pm * BM + wr * 64 + fr, col0 = u.pn * BM + wc * 32 + 8 * fq;
#pragma unroll
        for (int ai = 0; ai < 2; ++ai) {
            f32x4 a[4][2][2];
#pragma unroll
            for (int m = 0; m < 4; ++m)
#pragma unroll
                for (int bj = 0; bj < 2; ++bj) { const size_t o2 = (size_t)(row0 + ai * HALF + m * 16) * DM + col0 + bj * HALF;
                    if constexpr (XF32) { a[m][bj][0] = *(const f32x4*)((const float*)xin + o2); a[m][bj][1] = *(const f32x4*)((const float*)xin + o2 + 4); }
                    else { const u32x4 w = *(const u32x4*)((const bf16_t*)xin + o2); a[m][bj][0] = __builtin_bit_cast(f32x4, w); } }
#pragma unroll
            for (int m = 0; m < 4; ++m) {
                const int row = row0 + ai * HALF + m * 16; const size_t off = (size_t)row * DM + col0; float q = 0.f;
#pragma unroll
                for (int bj = 0; bj < 2; ++bj) { const size_t o2 = off + bj * HALF;
                    f32x4 a0, a1;
                    if constexpr (XF32) { a0 = a[m][bj][0]; a1 = a[m][bj][1]; }
                    else { const u32x4 w = __builtin_bit_cast(u32x4, a[m][bj][0]);
                        a0 = (f32x4){__uint_as_float(w.x << 16), __uint_as_float(w.x & 0xffff0000u), __uint_as_float(w.y << 16), __uint_as_float(w.y & 0xffff0000u)};
                        a1 = (f32x4){__uint_as_float(w.z << 16), __uint_as_float(w.z & 0xffff0000u), __uint_as_float(w.w << 16), __uint_as_float(w.w & 0xffff0000u)}; }
                    const f32x4 v0 = a0 + acc[ai][bj][m][0] * sc, v1 = a1 + acc[ai][bj][m][1] * sc;
                    q += ((v0[0] * v0[0] + v0[1] * v0[1]) + (v0[2] * v0[2] + v0[3] * v0[3])) + ((v1[0] * v1[0] + v1[1] * v1[1]) + (v1[2] * v1[2] + v1[3] * v1[3]));
                    u32x4 wo; wo.x = cvt_pk_bf16(v0[0], v0[1]); wo.y = cvt_pk_bf16(v0[2], v0[3]); wo.z = cvt_pk_bf16(v1[0], v1[1]); wo.w = cvt_pk_bf16(v1[2], v1[3]);
                    *(u32x4*)(xb + o2) = wo;
                    if (x8) { u32x2 w8; w8.x = pk4_fp8(v0[0], v0[1], v0[2], v0[3]); w8.y = pk4_fp8(v1[0], v1[1], v1[2], v1[3]); *(u32x2*)(x8 + o2) = w8; } }
                q += __shfl_xor(q, 16); q += __shfl_xor(q, 32);
                if (fq == 0) unsafeAtomicAdd(ss + row, q);
            }
            asm volatile("" ::: "memory");
        }
    }
};
struct EpiCross {
    static constexpr bool PERM = true, AFTER_DRAIN = false;
    bf16_t* QC; bf16_t* KC; bf16_t* VC; const float* ss; float sc;
    __device__ __forceinline__ void operator()(const f32x4 (&acc)[2][2][4][2], const Unit& u, int wr, int wc, int fr, int fq) const {
        const bool isq = u.pm < 64;
#pragma unroll
        for (int ai = 0; ai < 2; ++ai)
#pragma unroll
            for (int m = 0; m < 4; ++m) {
                const int rit = ai * HALF + wr * 64 + m * 16 + fr;
                float rs = sc; if (isq) rs = rsqrtf(ss[u.pm * 256 + rit] * (1.0f / 4096.0f) + RMS_EPS) * sc;
#pragma unroll
                for (int bj = 0; bj < 2; ++bj) {
                    const f32x4 v0 = acc[ai][bj][m][0] * rs, v1 = acc[ai][bj][m][1] * rs;
                    bf16_t* dst;
                    if (isq) { const int b = u.pm >> 4, s = (u.pm & 15) * 256 + rit, head = 2 * u.pn + bj; dst = QC + (((size_t)(b * 4 + head) * 4096 + s) * 128 + wc * 32 + 8 * fq); }
                    else { const int b = u.pm - 64, cp = 256 * (u.pn - 2) + 128 * bj, head = (cp & 511) >> 7; dst = ((cp >= 512) ? VC : KC) + (((size_t)(b * 4 + head) * 256 + rit) * 128 + wc * 32 + 8 * fq); }
                    u32x4 w; w.x = cvt_pk_bf16(v0[0], v0[1]); w.y = cvt_pk_bf16(v0[2], v0[3]); w.z = cvt_pk_bf16(v1[0], v1[1]); w.w = cvt_pk_bf16(v1[2], v1[3]);
                    *(u32x4*)dst = w;
                }
            }
    }
};
struct CrossOrder {
    int G, c;
    __device__ __forceinline__ bool next(int i, Unit& u) const { const int L = i * G + c; if (L >= 144) return false;
        if (L < 128) { u.pm = L & 63; u.pn = L >> 6; } else { const int j = L - 128; u.pm = 64 + (j >> 2); u.pn = 2 + (j & 3); } return true; }
    __device__ __forceinline__ void a_ready(const Unit&) const {}
    __device__ __forceinline__ void done(const Unit&) const {}
};
struct EpiUp {
    static constexpr bool PERM = true, AFTER_DRAIN = false;
    bf16_t* U; const float* ss;
    __device__ __forceinline__ void operator()(const f32x4 (&acc)[2][2][4][2], const Unit& u, int wr, int wc, int fr, int fq) const {
        const int row0 = u.pm * BM + wr * 64 + fr, col0 = u.pn * BM + wc * 32 + 8 * fq;
#pragma unroll
        for (int ai = 0; ai < 2; ++ai)
#pragma unroll
            for (int m = 0; m < 4; ++m) {
                const int row = row0 + ai * HALF + m * 16;
                const float rs = rsqrtf(ss[row] * (1.0f / 4096.0f) + RMS_EPS);
                bf16_t* rowp = U + (size_t)row * 16384 + col0;
#pragma unroll
                for (int bj = 0; bj < 2; ++bj) {
                    f32x4 v0 = acc[ai][bj][m][0] * rs, v1 = acc[ai][bj][m][1] * rs;
#pragma unroll
                    for (int j = 0; j < 4; ++j) { const float a = fmaxf(v0[j], 0.f), b = fmaxf(v1[j], 0.f); v0[j] = a * a; v1[j] = b * b; }
                    u32x4 w; w.x = cvt_pk_bf16(v0[0], v0[1]); w.y = cvt_pk_bf16(v0[2], v0[3]); w.z = cvt_pk_bf16(v1[0], v1[1]); w.w = cvt_pk_bf16(v1[2], v1[3]);
                    *(u32x4*)(rowp + bj * HALF) = w;
                }
            }
    }
};

struct EpiUp8 {
    static constexpr bool PERM = true, AFTER_DRAIN = false;
    unsigned char* U; const float* ss;
    __device__ __forceinline__ void operator()(const f32x4 (&acc)[2][2][4][2], const Unit& u, int wr, int wc, int fr, int fq) const {
        const int row0 = u.pm * BM + wr * 64 + fr, col0 = u.pn * BM + wc * 32 + 8 * fq;
#pragma unroll
        for (int ai = 0; ai < 2; ++ai)
#pragma unroll
            for (int m = 0; m < 4; ++m) {
                const int row = row0 + ai * HALF + m * 16;
                const float rs = rsqrtf(ss[row] * (1.0f / 4096.0f) + RMS_EPS) * (1.0f / 64.0f);
                unsigned char* rowp = U + ((size_t)(row >> 4) * 512 + (col0 >> 5)) * 512 + (row & 15) * 32 + (col0 & 31);
#pragma unroll
                for (int bj = 0; bj < 2; ++bj) {
                    f32x4 v0 = acc[ai][bj][m][0] * rs, v1 = acc[ai][bj][m][1] * rs;
#pragma unroll
                    for (int j = 0; j < 4; ++j) { const float a = fmaxf(v0[j], 0.f), b = fmaxf(v1[j], 0.f); v0[j] = a * a * 4.f; v1[j] = b * b * 4.f; }
                    u32x2 w; w.x = pk4_fp8(v0[0], v0[1], v0[2], v0[3]); w.y = pk4_fp8(v1[0], v1[1], v1[2], v1[3]);
                    *(u32x2*)(rowp + bj * (HALF / 32) * 512) = w;
                }
            }
    }
};

template <class Epi, class Sched, bool ALIGN_EPI = false, bool SP2 = false>
__device__ __forceinline__ void gemm_phase(PG8_LAS unsigned char* lds, const Gemm g, const Sched& S, const Epi& E) {
    int tid = threadIdx.x; asm volatile("" : "+v"(tid));
    const int wid = __builtin_amdgcn_readfirstlane(tid >> 6), lane = tid & 63, wr = wid >> 2, wc = wid & 3, fr = lane & 15, fq = lane >> 4;
    const int K = g.K, nt = K / BK;
    unsigned voffA[2], voffB[2];
#pragma unroll
    for (int i = 0; i < 2; ++i) { int R, C; stage_rc(tid * 16 + i * 8192, R, C); const int Rb = Epi::PERM ? ((R & ~31) + perm32(R & 31)) : R;
        voffA[i] = (unsigned)(R * K + C) * 2u; voffB[i] = (unsigned)(Rb * K + C) * 2u; }
    const size_t kstep = (size_t)(BK * 2);
    const size_t hstep = (size_t)HALF * K * 2;
    const size_t tstep = 2 * hstep;
    const unsigned ldsw = (unsigned)wid * 1024u;
    const int aoff = lds_byte(wr * 64 + fr, fq * 8), boff = lds_byte(wc * 32 + fr, fq * 8);
#define PG8_SA(b, h) (((b) * 2 + (h)) * HTB)
#define PG8_SB(b, h) ((4 + (b) * 2 + (h)) * HTB)
#define PG8_STAGE(bufoff, gbase, voff) do { _Pragma("unroll") for (int _i = 0; _i < 2; ++_i) \
        __builtin_amdgcn_global_load_lds((const unsigned*)((const char*)(gbase) + (voff)[_i]), (PG8_LAS unsigned*)(lds + (bufoff) + ldsw + _i * 8192), 16, 0, 0); } while (0)
#define PG8_LDA(dst, b, h) do { _Pragma("unroll") for (int m = 0; m < 4; ++m) _Pragma("unroll") for (int k = 0; k < 2; ++k) dst[m][k] = *(const PG8_LAS bf16x8*)(lds + PG8_SA(b, h) + aoff + m * 2048 + k * 1024); } while (0)
#define PG8_LDB(dst, b, h) do { _Pragma("unroll") for (int n = 0; n < 2; ++n) _Pragma("unroll") for (int k = 0; k < 2; ++k) dst[n][k] = *(const PG8_LAS bf16x8*)(lds + PG8_SB(b, h) + boff + n * 2048 + k * 1024); } while (0)
#define PG8_MMA(ai, bj, At, Bt) do { __builtin_amdgcn_s_setprio(1); _Pragma("unroll") for (int m = 0; m < 4; ++m) _Pragma("unroll") for (int n = 0; n < 2; ++n) _Pragma("unroll") for (int k = 0; k < 2; ++k) \
        acc[ai][bj][m][n] = __builtin_amdgcn_mfma_f32_16x16x32_bf16(Bt[n][k], At[m][k], acc[ai][bj][m][n], 0, 0, 0); __builtin_amdgcn_s_setprio(0); } while (0)
#define PG8_WAIT_V(n) asm volatile("s_waitcnt vmcnt(" #n ")" ::: "memory")
#define PG8_WAIT_L(n) asm volatile("s_waitcnt lgkmcnt(" #n ")" ::: "memory")
#define PG8_BAR __builtin_amdgcn_s_barrier()
#define PG8_SCHED __builtin_amdgcn_sched_barrier(0)
    Unit cur, nxt; int ui = 0;
    if (!S.next(0, cur)) return;
    f32x4 acc[2][2][4][2];
#pragma unroll
    for (int a = 0; a < 2; ++a)
#pragma unroll
        for (int b = 0; b < 2; ++b)
#pragma unroll
            for (int m = 0; m < 4; ++m)
#pragma unroll
                for (int n = 0; n < 2; ++n) acc[a][b][m][n] = (f32x4){0.f, 0.f, 0.f, 0.f};
    bf16x8 At[4][2], B0[2][2], B1[2][2];
    const char* cA = (const char*)g.A + (size_t)cur.pm * tstep; const char* cB = (const char*)g.Bt + (size_t)cur.pn * tstep;
    S.a_ready(cur);
    if constexpr (SP2) {
        PG8_STAGE(PG8_SB(0, 0), cB, voffB); PG8_STAGE(PG8_SB(0, 1), cB + hstep, voffB); PG8_STAGE(PG8_SA(0, 0), cA, voffA); PG8_STAGE(PG8_SA(0, 1), cA + hstep, voffA);
        if (wr == 1) PG8_BAR;
        PG8_WAIT_V(2); PG8_BAR;
        PG8_STAGE(PG8_SB(1, 0), cB + kstep, voffB); PG8_STAGE(PG8_SA(1, 0), cA + kstep, voffA); PG8_STAGE(PG8_SB(1, 1), cB + hstep + kstep, voffB);
        PG8_WAIT_V(6); PG8_BAR;
    } else {
        PG8_STAGE(PG8_SB(0, 0), cB, voffB); PG8_STAGE(PG8_SA(0, 0), cA, voffA); PG8_STAGE(PG8_SB(0, 1), cB + hstep, voffB); PG8_STAGE(PG8_SA(0, 1), cA + hstep, voffA);
        if (wr == 1) PG8_BAR;
        PG8_WAIT_V(4); PG8_BAR;
        PG8_STAGE(PG8_SB(1, 0), cB + kstep, voffB); PG8_STAGE(PG8_SA(1, 0), cA + kstep, voffA); PG8_STAGE(PG8_SB(1, 1), cB + hstep + kstep, voffB);
        PG8_WAIT_V(6); PG8_BAR;
    }
    for (;;) {
        const bool has_next = S.next(ui + 1, nxt);
        const char* nA = has_next ? (const char*)g.A + (size_t)nxt.pm * tstep : cA; const char* nB = has_next ? (const char*)g.Bt + (size_t)nxt.pn * tstep : cB;
        for (int t = 0; t < nt; t += 2) {
            const bool last = (t == nt - 2);
            const char* a1 = cA + (size_t)(t + 1) * kstep;
            const char* a2 = last ? nA : cA + (size_t)(t + 2) * kstep; const char* b2 = last ? nB : cB + (size_t)(t + 2) * kstep;
            const char* a3 = a2 + kstep; const char* b3 = b2 + kstep;
            if (last && has_next) S.a_ready(nxt);
            if constexpr (SP2) {
            PG8_LDB(B0, 0, 0); PG8_LDB(B1, 0, 1); PG8_SCHED; PG8_LDA(At, 0, 0); PG8_STAGE(PG8_SA(1, 1), a1 + hstep, voffA);
            PG8_WAIT_V(8); PG8_WAIT_L(0); PG8_BAR; PG8_MMA(0, 0, At, B0); PG8_MMA(0, 1, At, B1); PG8_BAR; PG8_SCHED;
            PG8_LDA(At, 0, 1); PG8_STAGE(PG8_SB(0, 0), b2, voffB); PG8_STAGE(PG8_SB(0, 1), b2 + hstep, voffB); PG8_STAGE(PG8_SA(0, 0), a2, voffA);
            PG8_WAIT_V(8); PG8_WAIT_L(0); PG8_BAR; PG8_MMA(1, 0, At, B0); PG8_MMA(1, 1, At, B1); PG8_BAR; PG8_SCHED;
            PG8_LDB(B0, 1, 0); PG8_LDB(B1, 1, 1); PG8_SCHED; PG8_LDA(At, 1, 0); PG8_STAGE(PG8_SA(0, 1), a2 + hstep, voffA);
            PG8_WAIT_V(8); PG8_WAIT_L(0); PG8_BAR; PG8_MMA(0, 0, At, B0); PG8_MMA(0, 1, At, B1); PG8_BAR; PG8_SCHED;
            PG8_LDA(At, 1, 1); PG8_STAGE(PG8_SB(1, 0), b3, voffB); PG8_STAGE(PG8_SB(1, 1), b3 + hstep, voffB); PG8_STAGE(PG8_SA(1, 0), a3, voffA);
            PG8_WAIT_V(8); PG8_WAIT_L(0); PG8_BAR; PG8_MMA(1, 0, At, B0); PG8_MMA(1, 1, At, B1); PG8_BAR; PG8_SCHED;
            } else {
            PG8_LDB(B0, 0, 0); PG8_SCHED; PG8_LDA(At, 0, 0); PG8_STAGE(PG8_SA(1, 1), a1 + hstep, voffA);
            PG8_WAIT_L(8); PG8_BAR; PG8_WAIT_L(0); PG8_MMA(0, 0, At, B0); PG8_BAR; PG8_SCHED;
            PG8_LDB(B1, 0, 1); PG8_STAGE(PG8_SB(0, 0), b2, voffB);
            PG8_BAR; PG8_WAIT_L(0); PG8_MMA(0, 1, At, B1); PG8_BAR;
            PG8_LDA(At, 0, 1); PG8_STAGE(PG8_SA(0, 0), a2, voffA);
            PG8_BAR; PG8_WAIT_L(0); PG8_MMA(1, 0, At, B0); PG8_BAR; PG8_SCHED;
            PG8_STAGE(PG8_SB(0, 1), b2 + hstep, voffB);
            PG8_WAIT_V(6); PG8_BAR; PG8_MMA(1, 1, At, B1); PG8_BAR;
            PG8_LDB(B0, 1, 0); PG8_SCHED; PG8_LDA(At, 1, 0); PG8_STAGE(PG8_SA(0, 1), a2 + hstep, voffA);
            PG8_WAIT_L(8); PG8_BAR; PG8_WAIT_L(0); PG8_MMA(0, 0, At, B0); PG8_BAR; PG8_SCHED;
            PG8_LDB(B1, 1, 1); PG8_STAGE(PG8_SB(1, 0), b3, voffB);
            PG8_BAR; PG8_WAIT_L(0); PG8_MMA(0, 1, At, B1); PG8_BAR;
            PG8_LDA(At, 1, 1); PG8_STAGE(PG8_SA(1, 0), a3, voffA);
            PG8_BAR; PG8_WAIT_L(0); PG8_MMA(1, 0, At, B0); PG8_BAR; PG8_SCHED;
            PG8_STAGE(PG8_SB(1, 1), b3 + hstep, voffB);
            PG8_WAIT_V(6); PG8_BAR; PG8_MMA(1, 1, At, B1); PG8_BAR;
            }
        }
        if constexpr (ALIGN_EPI) { if (wr == 0) PG8_BAR; }
        if constexpr (!Epi::AFTER_DRAIN) { E(acc, cur, wr, wc, fr, fq); S.done(cur); }
        if (!has_next) break;
#pragma unroll
        for (int a = 0; a < 2; ++a)
#pragma unroll
            for (int b = 0; b < 2; ++b)
#pragma unroll
                for (int m = 0; m < 4; ++m)
#pragma unroll
                    for (int n = 0; n < 2; ++n) acc[a][b][m][n] = (f32x4){0.f, 0.f, 0.f, 0.f};
        cur = nxt; cA = nA; cB = nB; ++ui;
        if constexpr (ALIGN_EPI) { if (wr == 1) PG8_BAR; }
    }
    PG8_WAIT_V(0);
    if constexpr (!ALIGN_EPI) { if (wr == 0) PG8_BAR; }
    PG8_BAR;
    if constexpr (Epi::AFTER_DRAIN) { E.fused(acc, cur, wr, wc, fr, fq, lds, wid, lane); S.done(cur); }
#undef PG8_SA
#undef PG8_SB
#undef PG8_STAGE
#undef PG8_LDA
#undef PG8_LDB
#undef PG8_MMA
#undef PG8_WAIT_V
#undef PG8_WAIT_L
#undef PG8_BAR
#undef PG8_SCHED
}
template <class Epi, class Sched, bool ALIGN_EPI = false, bool SP2 = false, bool ABLK = false, bool BBLK = false>
__device__ __forceinline__ void gemm_phase_f8(PG8_LAS unsigned char* lds, const Gemm g, const Sched& S, const Epi& E) {
    int tid = threadIdx.x; asm volatile("" : "+v"(tid));
    const int wid = __builtin_amdgcn_readfirstlane(tid >> 6), lane = tid & 63, wr = wid >> 2, wc = wid & 3, fr = lane & 15, fq = lane >> 4;
    const int K = g.K  , nt = K / 128;
    unsigned voffA[2], voffB[2];
#pragma unroll
    for (int i = 0; i < 2; ++i) { int R, C; stage_rc(tid * 16 + i * 8192, R, C); const int Rb = Epi::PERM ? ((R & ~31) + perm32(R & 31)) : R;
        voffA[i] = ABLK ? (unsigned)((R >> 4) * (K * 16) + ((2 * C) >> 5) * 512 + (R & 15) * 32 + ((2 * C) & 31)) : (unsigned)(R * K + 2 * C);
        voffB[i] = BBLK ? (unsigned)((Rb >> 4) * (K * 16) + ((2 * C) >> 5) * 512 + (Rb & 15) * 32 + ((2 * C) & 31)) : (unsigned)(Rb * K + 2 * C); }
    const size_t kstepA = ABLK ? (size_t)2048 : (size_t)(BK * 2), kstepB = BBLK ? (size_t)2048 : (size_t)(BK * 2);
    const size_t hstep = (size_t)HALF * K;
    const size_t tstep = 2 * hstep;
    const unsigned ldsw = (unsigned)wid * 1024u;
    const int aoff = lds_byte(wr * 64 + fr, fq * 8), boff = lds_byte(wc * 32 + fr, fq * 8);
#define PG8_SA(b, h) (((b) * 2 + (h)) * HTB)
#define PG8_SB(b, h) ((4 + (b) * 2 + (h)) * HTB)
#define PG8_STAGE(bufoff, gbase, voff) do { _Pragma("unroll") for (int _i = 0; _i < 2; ++_i) \
        __builtin_amdgcn_global_load_lds((const unsigned*)((const char*)(gbase) + (voff)[_i]), (PG8_LAS unsigned*)(lds + (bufoff) + ldsw + _i * 8192), 16, 0, 0); } while (0)
#define PG8_LD32(p) __builtin_bit_cast(i32x8, __builtin_shufflevector(*(const PG8_LAS bf16x8*)(p), *(const PG8_LAS bf16x8*)((p) + 1024), 0, 1, 2, 3, 4, 5, 6, 7, 8, 9, 10, 11, 12, 13, 14, 15))
#define PG8_LDA(dst, b, h) do { _Pragma("unroll") for (int m = 0; m < 4; ++m) dst[m] = PG8_LD32(lds + PG8_SA(b, h) + aoff + m * 2048); } while (0)
#define PG8_LDB(dst, b, h) do { _Pragma("unroll") for (int n = 0; n < 2; ++n) dst[n] = PG8_LD32(lds + PG8_SB(b, h) + boff + n * 2048); } while (0)
#define PG8_MMA(ai, bj, At, Bt) do { __builtin_amdgcn_s_setprio(1); _Pragma("unroll") for (int m = 0; m < 4; ++m) _Pragma("unroll") for (int n = 0; n < 2; ++n) \
        asm volatile("v_mfma_f32_16x16x128_f8f6f4 %0, %1, %2, %0" : "+v"(acc[ai][bj][m][n]) : "v"(Bt[n]), "v"(At[m])); __builtin_amdgcn_s_setprio(0); } while (0)
#define PG8_WAIT_V(n) asm volatile("s_waitcnt vmcnt(" #n ")" ::: "memory")
#define PG8_WAIT_L(n) asm volatile("s_waitcnt lgkmcnt(" #n ")" ::: "memory")
#define PG8_BAR __builtin_amdgcn_s_barrier()
#define PG8_SCHED __builtin_amdgcn_sched_barrier(0)
    Unit cur, nxt; int ui = 0;
    if (!S.next(0, cur)) return;
    f32x4 acc[2][2][4][2];
#pragma unroll
    for (int a = 0; a < 2; ++a)
#pragma unroll
        for (int b = 0; b < 2; ++b)
#pragma unroll
            for (int m = 0; m < 4; ++m)
#pragma unroll
                for (int n = 0; n < 2; ++n) acc[a][b][m][n] = (f32x4){0.f, 0.f, 0.f, 0.f};
    i32x8 At[4], B0[2], B1[2];
    const char* cA = (const char*)g.A + (size_t)cur.pm * tstep; const char* cB = (const char*)g.Bt + (size_t)cur.pn * tstep;
    S.a_ready(cur);
    if constexpr (SP2) {
        PG8_STAGE(PG8_SB(0, 0), cB, voffB); PG8_STAGE(PG8_SB(0, 1), cB + hstep, voffB); PG8_STAGE(PG8_SA(0, 0), cA, voffA); PG8_STAGE(PG8_SA(0, 1), cA + hstep, voffA);
        if (wr == 1) PG8_BAR;
        PG8_WAIT_V(2); PG8_BAR;
        PG8_STAGE(PG8_SB(1, 0), cB + kstepB, voffB); PG8_STAGE(PG8_SA(1, 0), cA + kstepA, voffA); PG8_STAGE(PG8_SB(1, 1), cB + hstep + kstepB, voffB);
        PG8_WAIT_V(6); PG8_BAR;
    } else {
        PG8_STAGE(PG8_SB(0, 0), cB, voffB); PG8_STAGE(PG8_SA(0, 0), cA, voffA); PG8_STAGE(PG8_SB(0, 1), cB + hstep, voffB); PG8_STAGE(PG8_SA(0, 1), cA + hstep, voffA);
        if (wr == 1) PG8_BAR;
        PG8_WAIT_V(4); PG8_BAR;
        PG8_STAGE(PG8_SB(1, 0), cB + kstepB, voffB); PG8_STAGE(PG8_SA(1, 0), cA + kstepA, voffA); PG8_STAGE(PG8_SB(1, 1), cB + hstep + kstepB, voffB);
        PG8_WAIT_V(6); PG8_BAR;
    }
    for (;;) {
        const bool has_next = S.next(ui + 1, nxt);
        const char* nA = has_next ? (const char*)g.A + (size_t)nxt.pm * tstep : cA; const char* nB = has_next ? (const char*)g.Bt + (size_t)nxt.pn * tstep : cB;
        for (int t = 0; t < nt; t += 2) {
            const bool last = (t == nt - 2);
            const char* a1 = cA + (size_t)(t + 1) * kstepA;
            const char* a2 = last ? nA : cA + (size_t)(t + 2) * kstepA; const char* b2 = last ? nB : cB + (size_t)(t + 2) * kstepB;
            const char* a3 = a2 + kstepA; const char* b3 = b2 + kstepB;
            if (last && has_next) S.a_ready(nxt);
            if constexpr (SP2) {
            PG8_LDB(B0, 0, 0); PG8_LDB(B1, 0, 1); PG8_SCHED; PG8_LDA(At, 0, 0); PG8_STAGE(PG8_SA(1, 1), a1 + hstep, voffA);
            PG8_WAIT_V(8); PG8_WAIT_L(0); PG8_BAR; PG8_MMA(0, 0, At, B0); PG8_MMA(0, 1, At, B1); PG8_BAR; PG8_SCHED;
            PG8_LDA(At, 0, 1); PG8_STAGE(PG8_SB(0, 0), b2, voffB); PG8_STAGE(PG8_SB(0, 1), b2 + hstep, voffB); PG8_STAGE(PG8_SA(0, 0), a2, voffA);
            PG8_WAIT_V(8); PG8_WAIT_L(0); PG8_BAR; PG8_MMA(1, 0, At, B0); PG8_MMA(1, 1, At, B1); PG8_BAR; PG8_SCHED;
            PG8_LDB(B0, 1, 0); PG8_LDB(B1, 1, 1); PG8_SCHED; PG8_LDA(At, 1, 0); PG8_STAGE(PG8_SA(0, 1), a2 + hstep, voffA);
            PG8_WAIT_V(8); PG8_WAIT_L(0); PG8_BAR; PG8_MMA(0, 0, At, B0); PG8_MMA(0, 1, At, B1); PG8_BAR; PG8_SCHED;
            PG8_LDA(At, 1, 1); PG8_STAGE(PG8_SB(1, 0), b3, voffB); PG8_STAGE(PG8_SB(1, 1), b3 + hstep, voffB); PG8_STAGE(PG8_SA(1, 0), a3, voffA);
            PG8_WAIT_V(8); PG8_WAIT_L(0); PG8_BAR; PG8_MMA(1, 0, At, B0); PG8_MMA(1, 1, At, B1); PG8_BAR; PG8_SCHED;
            } else {
            PG8_LDB(B0, 0, 0); PG8_SCHED; PG8_LDA(At, 0, 0); PG8_STAGE(PG8_SA(1, 1), a1 + hstep, voffA);
            PG8_WAIT_L(8); PG8_BAR; PG8_WAIT_L(0); PG8_MMA(0, 0, At, B0); PG8_BAR; PG8_SCHED;
            PG8_LDB(B1, 0, 1); PG8_STAGE(PG8_SB(0, 0), b2, voffB);
            PG8_BAR; PG8_WAIT_L(0); PG8_MMA(0, 1, At, B1); PG8_BAR;
            PG8_LDA(At, 0, 1); PG8_STAGE(PG8_SA(0, 0), a2, voffA);
            PG8_BAR; PG8_WAIT_L(0); PG8_MMA(1, 0, At, B0); PG8_BAR; PG8_SCHED;
            PG8_STAGE(PG8_SB(0, 1), b2 + hstep, voffB);
            PG8_WAIT_V(6); PG8_BAR; PG8_MMA(1, 1, At, B1); PG8_BAR;
            PG8_LDB(B0, 1, 0); PG8_SCHED; PG8_LDA(At, 1, 0); PG8_STAGE(PG8_SA(0, 1), a2 + hstep, voffA);
            PG8_WAIT_L(8); PG8_BAR; PG8_WAIT_L(0); PG8_MMA(0, 0, At, B0); PG8_BAR; PG8_SCHED;
            PG8_LDB(B1, 1, 1); PG8_STAGE(PG8_SB(1, 0), b3, voffB);
            PG8_BAR; PG8_WAIT_L(0); PG8_MMA(0, 1, At, B1); PG8_BAR;
            PG8_LDA(At, 1, 1); PG8_STAGE(PG8_SA(1, 0), a3, voffA);
            PG8_BAR; PG8_WAIT_L(0); PG8_MMA(1, 0, At, B0); PG8_BAR; PG8_SCHED;
            PG8_STAGE(PG8_SB(1, 1), b3 + hstep, voffB);
            PG8_WAIT_V(6); PG8_BAR; PG8_MMA(1, 1, At, B1); PG8_BAR;
            }
        }
        if constexpr (ALIGN_EPI) { if (wr == 0) PG8_BAR; }
        asm volatile("s_nop 15\n\ts_nop 15" ::: "memory");
        if constexpr (!Epi::AFTER_DRAIN) { E(acc, cur, wr, wc, fr, fq); S.done(cur); }
        if (!has_next) break;
#pragma unroll
        for (int a = 0; a < 2; ++a)
#pragma unroll
            for (int b = 0; b < 2; ++b)
#pragma unroll
                for (int m = 0; m < 4; ++m)
#pragma unroll
                    for (int n = 0; n < 2; ++n) acc[a][b][m][n] = (f32x4){0.f, 0.f, 0.f, 0.f};
        cur = nxt; cA = nA; cB = nB; ++ui;
        if constexpr (ALIGN_EPI) { if (wr == 1) PG8_BAR; }
    }
    PG8_WAIT_V(0);
    if constexpr (!ALIGN_EPI) { if (wr == 0) PG8_BAR; }
    PG8_BAR;
    if constexpr (Epi::AFTER_DRAIN) { E.fused(acc, cur, wr, wc, fr, fq, lds, wid, lane); S.done(cur); }
#undef PG8_SA
#undef PG8_SB
#undef PG8_STAGE
#undef PG8_LD32
#undef PG8_LDA
#undef PG8_LDB
#undef PG8_MMA
#undef PG8_WAIT_V
#undef PG8_WAIT_L
#undef PG8_BAR
#undef PG8_SCHED
}
}

namespace att {
typedef unsigned short bf16;
typedef short bf16x8 __attribute__((ext_vector_type(8)));
typedef short s16x4 __attribute__((ext_vector_type(4)));
typedef float f32x16 __attribute__((ext_vector_type(16)));
typedef float f32x4 __attribute__((ext_vector_type(4)));
typedef unsigned u32x4 __attribute__((ext_vector_type(4)));
template <class A, class Bt> struct same_t { static constexpr bool v = false; };
template <class A> struct same_t<A, A> { static constexpr bool v = true; };
constexpr int D = 128;
constexpr float SCALE = 0.08838834764831845f;
constexpr float THR = 8.f;
constexpr int NW = 8, QBLK = 32, KVBLK = 64, QB = NW * QBLK;
constexpr int SHM_V = KVBLK * D * 2, SHM_K = KVBLK * D * 2;
constexpr int LDS_WS = 2 * SHM_V + 2 * SHM_K;
constexpr int LDS_SSQ = LDS_WS + NW * 64 * 4;
constexpr int LDS_BYTES = LDS_SSQ + NW * 32 * 4;
typedef int i32x8 __attribute__((ext_vector_type(8)));
typedef int i32x4 __attribute__((ext_vector_type(4)));
#define KSWZ(row, colB) ((row) * 256 + ((colB) ^ (((row) & 15) << 4)))
#define SBAR() __builtin_amdgcn_sched_barrier(0)
__device__ __forceinline__ int v_st(int k, int c) { const int kk = (k & ~0xC) | ((k & 4) << 1) | ((k & 8) >> 1); return ((kk >> 3) * 4 + (c >> 5)) * 512 + ((kk & 7) * 32 + (c & 31)) * 2; }
__device__ __forceinline__ int v_rd_base(int lane) { return ((lane & 3) << 3) | (((lane >> 2) & 3) << 6) | (((lane >> 4) & 1) << 5) | (((lane >> 5) & 1) << 8); }
constexpr int v_rd_off(int d0, int ks, int half) { return d0 * 512 + ks * 4096 + half * 2048; }
__device__ __forceinline__ int crow(int r, int hi) { return (r & 3) + 8 * (r >> 2) + 4 * hi; }
__device__ __forceinline__ unsigned cvtpk(float lo, float hi) {
    unsigned r; asm volatile("v_cvt_pk_bf16_f32 %0, %1, %2" : "=v"(r) : "v"(lo), "v"(hi)); return r;
}
__device__ __forceinline__ bf16x8 pack8(f32x4 a, f32x4 b) {
    u32x4 w = {cvtpk(a[0], a[1]), cvtpk(a[2], a[3]), cvtpk(b[0], b[1]), cvtpk(b[2], b[3])};
    return *reinterpret_cast<bf16x8*>(&w);
}
template <class T> __device__ __forceinline__ bf16x8 load8(const T* p) {
    if constexpr (same_t<T, float>::v) { return pack8(*(const f32x4*)p, *(const f32x4*)(p + 4)); }
    else { return *reinterpret_cast<const bf16x8*>(p); }
}
__device__ __forceinline__ void mask_tile(f32x16& p0, f32x16& p1, int dq, unsigned W) {
    const float NEG = -__builtin_inff();
#pragma unroll
    for (int r = 0; r < 16; ++r) {
        const int c = (r & 3) + 8 * (r >> 2);
        if ((unsigned)(dq - c) >= W) p0[r] = NEG;
        if ((unsigned)(dq - c - 32) >= W) p1[r] = NEG;
    }
}
template <int SH = 0, int THRI = 8, int PSH = 0>
__device__ __forceinline__ void partialSM(f32x16& p0, f32x16& p1, float& m_reg, float& mn, float& alpha, bool dead = false) {
    float pmax;
    { float m0 = fmaxf(p0[0], p0[1]), m1 = fmaxf(p0[2], p0[3]), m2 = fmaxf(p1[0], p1[1]), m3 = fmaxf(p1[2], p1[3]);
#pragma unroll
      for (int r = 4; r < 16; r += 4) { m0 = fmaxf(fmaxf(m0, p0[r]), p0[r + 1]); m1 = fmaxf(fmaxf(m1, p0[r + 2]), p0[r + 3]); m2 = fmaxf(fmaxf(m2, p1[r]), p1[r + 1]); m3 = fmaxf(fmaxf(m3, p1[r + 2]), p1[r + 3]); }
      pmax = fmaxf(fmaxf(m0, m1), fmaxf(m2, m3)); }
    pmax = dead ? -__builtin_inff() : pmax;
    { auto rr = __builtin_amdgcn_permlane32_swap(__float_as_uint(pmax), __float_as_uint(pmax), false, false);
      pmax = fmaxf(__uint_as_float(rr[0]), __uint_as_float(rr[1])); }
    constexpr float SCL = SCALE / (float)(1 << SH), C2 = 1.4426950408889634f * SCL;
    if (__builtin_expect(__all((pmax - m_reg) * SCL <= (float)THRI), 1)) { mn = m_reg; alpha = 1.f; }
    else { mn = fmaxf(m_reg, pmax); alpha = __builtin_amdgcn_exp2f((m_reg - mn) * C2); m_reg = mn; }
    const float mnL = dead ? -__builtin_inff() : -mn * C2 + (float)PSH;
    for (int r = 0; r < 16; ++r) p0[r] = fmaf(p0[r], C2, mnL); for (int r = 0; r < 16; ++r) p1[r] = fmaf(p1[r], C2, mnL);
    for (int r = 0; r < 16; ++r) p0[r] = __builtin_amdgcn_exp2f(p0[r]);
}
__device__ __forceinline__ void finishSM(f32x16& p0, f32x16& p1, float alpha, float& l_reg, bf16x8& pa0, bf16x8& pa1, bf16x8& pa2, bf16x8& pa3) {
    for (int r = 0; r < 16; ++r) p1[r] = __builtin_amdgcn_exp2f(p1[r]);
    float ps;
    { float s0 = p0[0] + p0[1], s1 = p0[2] + p0[3], s2 = p1[0] + p1[1], s3 = p1[2] + p1[3];
#pragma unroll
      for (int r = 4; r < 16; r += 4) { s0 += p0[r]; s0 += p0[r + 1]; s1 += p0[r + 2]; s1 += p0[r + 3]; s2 += p1[r]; s2 += p1[r + 1]; s3 += p1[r + 2]; s3 += p1[r + 3]; }
      ps = (s0 + s1) + (s2 + s3); }
    { auto rr = __builtin_amdgcn_permlane32_swap(__float_as_uint(ps), __float_as_uint(ps), false, false);
      ps = __uint_as_float(rr[0]) + __uint_as_float(rr[1]); }
    l_reg = l_reg * alpha + ps;
#define PK4(P, B_, OUT) do { unsigned a0 = cvtpk(P[B_+0], P[B_+1]), a1 = cvtpk(P[B_+2], P[B_+3]);                          \
        unsigned b0 = cvtpk(P[B_+4], P[B_+5]), b1 = cvtpk(P[B_+6], P[B_+7]);                                             \
        auto r0 = __builtin_amdgcn_permlane32_swap(a0, b0, false, false); auto r1 = __builtin_amdgcn_permlane32_swap(a1, b1, false, false); \
        u32x4 w = {r0[0], r1[0], r0[1], r1[1]}; OUT = *reinterpret_cast<bf16x8*>(&w); } while (0)
    PK4(p0, 0, pa0); PK4(p0, 8, pa1); PK4(p1, 0, pa2); PK4(p1, 8, pa3);
#undef PK4
}
__device__ __forceinline__ void finishSM8(f32x16& p0, f32x16& p1, float alpha, float& l_reg, i32x8& pa) {
    for (int r = 0; r < 16; ++r) p1[r] = __builtin_amdgcn_exp2f(p1[r]);
    float ps;
    { float s0 = p0[0] + p0[1], s1 = p0[2] + p0[3], s2 = p1[0] + p1[1], s3 = p1[2] + p1[3];
#pragma unroll
      for (int r = 4; r < 16; r += 4) { s0 += p0[r]; s0 += p0[r + 1]; s1 += p0[r + 2]; s1 += p0[r + 3]; s2 += p1[r]; s2 += p1[r + 1]; s3 += p1[r + 2]; s3 += p1[r + 3]; }
      ps = (s0 + s1) + (s2 + s3); }
    { auto rr = __builtin_amdgcn_permlane32_swap(__float_as_uint(ps), __float_as_uint(ps), false, false);
      ps = __uint_as_float(rr[0]) + __uint_as_float(rr[1]); }
    l_reg = l_reg * alpha + ps;
#pragma unroll
    for (int d = 0; d < 4; ++d) { int w0 = 0, w1 = 0;
        w0 = __builtin_amdgcn_cvt_pk_fp8_f32(p0[4 * d], p0[4 * d + 1], w0, false); w0 = __builtin_amdgcn_cvt_pk_fp8_f32(p0[4 * d + 2], p0[4 * d + 3], w0, true);
        w1 = __builtin_amdgcn_cvt_pk_fp8_f32(p1[4 * d], p1[4 * d + 1], w1, false); w1 = __builtin_amdgcn_cvt_pk_fp8_f32(p1[4 * d + 2], p1[4 * d + 3], w1, true);
        pa[d] = w0; pa[4 + d] = w1; }
}
__device__ __forceinline__ void mask_tile_perm(f32x16& p0, f32x16& p1, int dq) {
    const float NEG = -__builtin_inff();
#pragma unroll
    for (int r = 0; r < 16; ++r) { const int c = 16 * (r & 3) + (r >> 2);
        if (dq - c < 0) p0[r] = NEG;
        if (dq - c - 4 < 0) p1[r] = NEG; }
}
template <int KB, bool SK>
__device__ __forceinline__ void qkt(f32x16& p0, f32x16& p1, const char* K_lds, int r32, int hi, const bf16x8* qr, bool act) {
    if (SK && !act) { const float NEG = -__builtin_inff();
#pragma unroll
        for (int r = 0; r < 16; ++r) { p0[r] = NEG; p1[r] = NEG; } return; }
    p0 = f32x16{}; p1 = f32x16{};
    typedef const __attribute__((address_space(3))) char* lds_cptr;
    lds_cptr kb[4];
#pragma unroll
    for (int dd = 0; dd < 4; ++dd) kb[dd] = (lds_cptr)(K_lds + KB * SHM_K + KSWZ(r32, (dd * 16 + hi * 8) * 2));
    unsigned flip = 128u; asm volatile("" : "+v"(flip));
#pragma unroll
    for (int d0 = 0; d0 < 8; ++d0) { lds_cptr a = (d0 < 4) ? kb[d0] : (lds_cptr)((unsigned)(__UINTPTR_TYPE__)kb[d0 & 3] ^ flip);
        bf16x8 b0 = *reinterpret_cast<const __attribute__((address_space(3))) bf16x8*>(a);
        bf16x8 b1 = *reinterpret_cast<const __attribute__((address_space(3))) bf16x8*>(a + 32 * 256);
        p0 = __builtin_amdgcn_mfma_f32_32x32x16_bf16(b0, qr[d0], p0, 0, 0, 0);
        p1 = __builtin_amdgcn_mfma_f32_32x32x16_bf16(b1, qr[d0], p1, 0, 0, 0); }
}
template <int KB>
__device__ __forceinline__ void qkt_p(f32x16& p0, f32x16& p1, const char* K_lds, int r32, int hi, const bf16x8* qr) {
    unsigned kb[4], kf[4];
    asm volatile("" : "+v"(r32), "+v"(hi));
#pragma unroll
    for (int dd = 0; dd < 4; ++dd) kb[dd] = (unsigned)(__UINTPTR_TYPE__)K_lds + (unsigned)KSWZ(r32, (dd * 16 + hi * 8) * 2);
    unsigned flip = 128u; asm volatile("" : "+v"(flip));
#pragma unroll
    for (int dd = 0; dd < 4; ++dd) kf[dd] = kb[dd] ^ flip;
    bf16x8 A0, A1, B0, B1, C0, C1;
#define KRD(d0_, d1_, addr) asm volatile("ds_read_b128 %0, %2 offset:%3\n\tds_read_b128 %1, %2 offset:%4" : "=&v"(d0_), "=&v"(d1_) : "v"(addr), "i"(KB * SHM_K), "i"(KB * SHM_K + 32 * 256) : "memory")
#define KWT(n) do { asm volatile("s_waitcnt lgkmcnt(" #n ")" ::: "memory"); SBAR(); } while (0)
#define KMM(f0_, f1_, d0) do { p0 = __builtin_amdgcn_mfma_f32_32x32x16_bf16(f0_, qr[d0], p0, 0, 0, 0); p1 = __builtin_amdgcn_mfma_f32_32x32x16_bf16(f1_, qr[d0], p1, 0, 0, 0); SBAR(); } while (0)
    p0 = f32x16{}; p1 = f32x16{};
    SBAR(); KRD(A0, A1, kb[0]); KRD(B0, B1, kb[1]);
    KRD(C0, C1, kb[2]); KWT(4); KMM(A0, A1, 0);
    KRD(A0, A1, kb[3]); KWT(4); KMM(B0, B1, 1);
    KRD(B0, B1, kf[0]); KWT(4); KMM(C0, C1, 2);
    KRD(C0, C1, kf[1]); KWT(4); KMM(A0, A1, 3);
    KRD(A0, A1, kf[2]); KWT(4); KMM(B0, B1, 4);
    KRD(B0, B1, kf[3]); KWT(4); KMM(C0, C1, 5);
    KWT(2); KMM(A0, A1, 6);
    KWT(0); KMM(B0, B1, 7);
#undef KRD
#undef KWT
#undef KMM
}
template <int KB, bool LOWREG = false>
__device__ __forceinline__ void qkt_f8(f32x16& p0, f32x16& p1, const char* K_lds, int r32, int hi, const i32x8 (&q8)[2]) {
    asm volatile("" : "+v"(r32), "+v"(hi));
    typedef const __attribute__((address_space(3))) bf16x8* lds_f;
    const unsigned sw = (unsigned)((r32 >> 1) & 7), base = (unsigned)(__UINTPTR_TYPE__)K_lds + (unsigned)(r32 * 128) + (unsigned)(KB * SHM_K);
    if constexpr (LOWREG) {
#define KF8(c_, hf_) __builtin_bit_cast(i32x8, __builtin_shufflevector(*(lds_f)(__UINTPTR_TYPE__)(base + ((((unsigned)(4 * (c_) + 2 * hi)) ^ sw) << 4) + (hf_) * 4096),          \
                                                                      *(lds_f)(__UINTPTR_TYPE__)(base + ((((unsigned)(4 * (c_) + 2 * hi + 1)) ^ sw) << 4) + (hf_) * 4096), 0, 1, 2, 3, 4, 5, 6, 7, 8, 9, 10, 11, 12, 13, 14, 15))
        i32x8 f0 = KF8(0, 0), f1 = KF8(0, 1);
        SBAR();
        asm volatile("v_mfma_f32_32x32x64_f8f6f4 %0, %1, %2, 0" : "=&v"(p0) : "v"(f0), "v"(q8[0]));
        asm volatile("v_mfma_f32_32x32x64_f8f6f4 %0, %1, %2, 0" : "=&v"(p1) : "v"(f1), "v"(q8[0]));
        SBAR();
        f0 = KF8(1, 0); f1 = KF8(1, 1);
        SBAR();
        asm volatile("v_mfma_f32_32x32x64_f8f6f4 %0, %1, %2, %0" : "+v"(p0) : "v"(f0), "v"(q8[1]));
        asm volatile("v_mfma_f32_32x32x64_f8f6f4 %0, %1, %2, %0" : "+v"(p1) : "v"(f1), "v"(q8[1]));
        asm volatile("s_nop 15\n\ts_nop 15" ::: "memory");
        SBAR();
#undef KF8
        return;
    }
    i32x8 kf[2][2];
#pragma unroll
    for (int c = 0; c < 2; ++c) { const unsigned a0 = base + ((((unsigned)(4 * c + 2 * hi)) ^ sw) << 4), a1 = base + ((((unsigned)(4 * c + 2 * hi + 1)) ^ sw) << 4);
#pragma unroll
        for (int hf = 0; hf < 2; ++hf)
            kf[c][hf] = __builtin_bit_cast(i32x8, __builtin_shufflevector(*(lds_f)(__UINTPTR_TYPE__)(a0 + hf * 4096), *(lds_f)(__UINTPTR_TYPE__)(a1 + hf * 4096), 0, 1, 2, 3, 4, 5, 6, 7, 8, 9, 10, 11, 12, 13, 14, 15)); }
    SBAR();
    asm volatile("v_mfma_f32_32x32x64_f8f6f4 %0, %1, %2, 0" : "=&v"(p0) : "v"(kf[0][0]), "v"(q8[0]));
    asm volatile("v_mfma_f32_32x32x64_f8f6f4 %0, %1, %2, 0" : "=&v"(p1) : "v"(kf[0][1]), "v"(q8[0]));
    asm volatile("v_mfma_f32_32x32x64_f8f6f4 %0, %1, %2, %0" : "+v"(p0) : "v"(kf[1][0]), "v"(q8[1]));
    asm volatile("v_mfma_f32_32x32x64_f8f6f4 %0, %1, %2, %0" : "+v"(p1) : "v"(kf[1][1]), "v"(q8[1]));
    asm volatile("s_nop 15\n\ts_nop 15" ::: "memory");
    SBAR();
}
template <int VB, bool SK>
__device__ __forceinline__ void pv_tile(f32x16* o, int vb0, bf16x8 pa0, bf16x8 pa1, bf16x8 pa2, bf16x8 pa3, bool act) {
    if (SK && !act) return;
#define TRRD(dst, off) asm volatile("ds_read_b64_tr_b16 %0, %1 offset:%2" : "=&v"(dst) : "v"(vb0), "i"(off) : "memory")
#define PV_D0(d0) do { s16x4 l0, l1, l2, l3, h0, h1, h2, h3; constexpr int b_ = VB * SHM_V + v_rd_off(d0, 0, 0);     \
        TRRD(l0, b_); TRRD(h0, b_ + 2048); TRRD(l1, b_ + 4096); TRRD(h1, b_ + 6144); TRRD(l2, b_ + 8192); TRRD(h2, b_ + 10240); TRRD(l3, b_ + 12288); TRRD(h3, b_ + 14336); \
        asm volatile("s_waitcnt lgkmcnt(0)" ::: "memory"); SBAR();                 \
        o[d0] = __builtin_amdgcn_mfma_f32_32x32x16_bf16(pa0, (bf16x8){l0[0], l0[1], l0[2], l0[3], h0[0], h0[1], h0[2], h0[3]}, o[d0], 0, 0, 0);   \
        o[d0] = __builtin_amdgcn_mfma_f32_32x32x16_bf16(pa1, (bf16x8){l1[0], l1[1], l1[2], l1[3], h1[0], h1[1], h1[2], h1[3]}, o[d0], 0, 0, 0);   \
        o[d0] = __builtin_amdgcn_mfma_f32_32x32x16_bf16(pa2, (bf16x8){l2[0], l2[1], l2[2], l2[3], h2[0], h2[1], h2[2], h2[3]}, o[d0], 0, 0, 0);   \
        o[d0] = __builtin_amdgcn_mfma_f32_32x32x16_bf16(pa3, (bf16x8){l3[0], l3[1], l3[2], l3[3], h3[0], h3[1], h3[2], h3[3]}, o[d0], 0, 0, 0); } while (0)
    PV_D0(0); PV_D0(1); PV_D0(2); PV_D0(3);
#undef PV_D0
#undef TRRD
}

struct BlockRef { const bf16* Q; const bf16* K; const bf16* V; int P0; };
struct Seam { bf16x8 qr[8]; bf16x8 st_v0, st_v1, st_k0, st_k1; i32x8 q8[2]; };
#define ROW(p, k0, rr) ((p) + (size_t)((k0) + (rr)) * D + sc)
#define VMW() asm volatile("s_waitcnt vmcnt(0)" ::: "memory")
#define SLOAD_H(Kp, Vp, k0) do { if constexpr (F8) { S.st_v0 = *reinterpret_cast<const bf16x8*>((const char*)(Vp) + (size_t)(k0) * 128 + tid * 16);                 \
                                             S.st_k0 = *reinterpret_cast<const bf16x8*>((const char*)(Kp) + (size_t)((k0) + kp8) * 128 + kc8); }                 \
                         else { S.st_v0 = load8<bf16>(ROW(Vp, k0, sr)); S.st_v1 = load8<bf16>(ROW(Vp, k0, 32 + sr));                                              \
                                S.st_k0 = load8<bf16>(ROW(Kp, k0, sr)); S.st_k1 = load8<bf16>(ROW(Kp, k0, 32 + sr)); } } while (0)
#define SWRITE_HK(bf) do { if constexpr (F8) { *(bf16x8*)(K_lds + (bf) * SHM_K + kws8) = S.st_k0; }                                                          \
                           else { *(bf16x8*)(K_lds + (bf) * SHM_K + kws) = S.st_k0; *(bf16x8*)(K_lds + (bf) * SHM_K + kws + 32 * 256) = S.st_k1; } } while (0)
#define SWRITE_HV(bf) do { if constexpr (F8) { *(bf16x8*)(V_lds + (bf) * SHM_V + vws8) = S.st_v0; }                                                          \
                           else { *(bf16x8*)(V_lds + (bf) * SHM_V + vst0) = S.st_v0; *(bf16x8*)(V_lds + (bf) * SHM_V + vst1) = S.st_v1; } } while (0)
#define SWRITE_H(bf) do { SWRITE_HV(bf); SWRITE_HK(bf); } while (0)
template <bool F8 = false>
__device__ __forceinline__ void prime(const BlockRef& cur, char* lds, Seam& S) {
    int tid = threadIdx.x; asm volatile("" : "+v"(tid));
    const int wid = __builtin_amdgcn_readfirstlane(tid >> 6), lane = tid & 63, r32 = lane & 31, hi = lane >> 5;
    const int sr = tid >> 4, sc = (tid & 15) * 8, kws = KSWZ(sr, sc * 2); char* K_lds = lds + 2 * SHM_V;
    const int kr8 = tid >> 3, kc8 = (tid & 7) * 16, kws8 = kr8 * 128 + (((tid & 7) ^ ((kr8 >> 1) & 7)) << 4);
    const int krp8 = kr8 & 31, kt8 = (krp8 & 3) + 4 * (krp8 >> 3) + 16 * (kr8 >> 5), kp8 = 16 * (kt8 & 3) + (kt8 >> 2) + 8 * ((krp8 >> 2) & 1);
#pragma unroll
    for (int d0 = 0; d0 < 8; ++d0) S.qr[d0] = load8<bf16>(cur.Q + (size_t)(wid * QBLK + r32) * D + d0 * 16 + hi * 8);
    SLOAD_H(cur.K, cur.V, 0); VMW(); SWRITE_HK(0);
    __syncthreads();
}
template <class Epi, bool F8 = false>
__device__ __forceinline__ void block(const BlockRef& cur, int skv, char* lds, Seam& S, bool moba, unsigned selmask, const Epi& E) {
    int tid = threadIdx.x; asm volatile("" : "+v"(tid));
    const int wid = __builtin_amdgcn_readfirstlane(tid >> 6), lane = tid & 63, r32 = lane & 31, hi = lane >> 5;
    int j_hi = (cur.P0 + QB - 1) / KVBLK + 1; if (j_hi > skv / KVBLK) j_hi = skv / KVBLK;
    const int NT = j_hi;
    const int qlo = cur.P0 + wid * QBLK, qm = qlo + r32 - 4 * hi;
    char* V_lds = lds; char* K_lds = lds + 2 * SHM_V;
    float* ws = (float*)(lds + LDS_WS) + wid * 64; float* li_l = ws, * al_l = ws + 32;
    float m_reg = -1e30f, l_reg = 0; f32x16 o[4] = {};
    const int sr = tid >> 4, sc = (tid & 15) * 8, vst0 = v_st(sr, sc), vst1 = v_st(32 + sr, sc), kws = KSWZ(sr, sc * 2);
    const int kr8 = tid >> 3, kc8 = (tid & 7) * 16, kws8 = kr8 * 128 + (((tid & 7) ^ ((kr8 >> 1) & 7)) << 4);
    const int krp8 = kr8 & 31, kt8 = (krp8 & 3) + 4 * (krp8 >> 3) + 16 * (kr8 >> 5), kp8 = 16 * (kt8 & 3) + (kt8 >> 2) + 8 * ((krp8 >> 2) & 1);
    const int vc8 = tid >> 2, vws8 = vc8 * 64 + (((tid & 3) ^ ((vc8 >> 2) & 3)) << 4), qm8 = qlo + r32 - 8 * hi;
    typedef const __attribute__((address_space(3))) bf16x8* lds_f;
    const unsigned vsw = (unsigned)((r32 >> 2) & 3), va0 = (unsigned)(__UINTPTR_TYPE__)V_lds + (unsigned)(r32 * 64) + (((unsigned)(2 * hi) ^ vsw) << 4), va1 = (unsigned)(__UINTPTR_TYPE__)V_lds + (unsigned)(r32 * 64) + (((unsigned)(2 * hi + 1) ^ vsw) << 4);
    i32x8 pa8;
#define VF8N(VB_, g) __builtin_bit_cast(i32x8, __builtin_shufflevector(*(lds_f)(__UINTPTR_TYPE__)(va0 + (VB_) * SHM_V + (g) * 2048), *(lds_f)(__UINTPTR_TYPE__)(va1 + (VB_) * SHM_V + (g) * 2048), 0, 1, 2, 3, 4, 5, 6, 7, 8, 9, 10, 11, 12, 13, 14, 15))
#define MM8(g, f_) asm volatile("v_mfma_f32_32x32x64_f8f6f4 %0, %1, %2, %0" : "+v"(o[g]) : "v"(pa8), "v"(f_))
#define PV8(VB_) do { SBAR(); i32x8 f0_ = VF8N(VB_, 0), f1_ = VF8N(VB_, 1); SBAR(); MM8(0, f0_); f0_ = VF8N(VB_, 2); SBAR(); MM8(1, f1_); f1_ = VF8N(VB_, 3); SBAR(); MM8(2, f0_); MM8(3, f1_);   \
        asm volatile("s_nop 15\n\ts_nop 15" ::: "memory"); SBAR(); } while (0)
#define FIN(PY0_, PY1_, alY_) do { if constexpr (F8) finishSM8(PY0_, PY1_, alY_, l_reg, pa8); else finishSM(PY0_, PY1_, alY_, l_reg, pa0, pa1, pa2, pa3); } while (0)
#define PVT(VB_) do { if constexpr (F8) PV8(VB_); else pv_tile<VB_, false>(o, vb0, pa0, pa1, pa2, pa3, true); } while (0)
#define PSM(P0_, P1_, mn_, al_) partialSM<F8 ? 8 : 0, F8 ? 2 : 8, F8 ? 5 : 0>(P0_, P1_, m_reg, mn_, al_, dead_)
    bool dead_ = false;
    const int vb0 = (int)(uintptr_t)V_lds + v_rd_base(lane);
    const bf16* Kh = cur.K; const bf16* Vh = cur.V;
#define RESC(a) do { if (__any((a) < 1.f)) { if (hi == 0) al_l[r32] = (a); asm volatile("s_waitcnt lgkmcnt(0)" ::: "memory");              \
                     for (int d_ = 0; d_ < 4; ++d_) for (int r = 0; r < 16; ++r) o[d_][r] *= al_l[crow(r, hi)]; } } while (0)
#define KBASE(t) ((t) * KVBLK)
#define QKT(KB_, P0_, P1_) do { if constexpr (F8) qkt_f8<KB_, true>(P0_, P1_, K_lds, r32, hi, S.q8); else qkt<KB_, false>(P0_, P1_, K_lds, r32, hi, S.qr, true); } while (0)
#define MASKT(P0_, P1_, t) do { const int kb_ = KBASE(t); if (kb_ + KVBLK - 1 > qlo) { if constexpr (F8) mask_tile_perm(P0_, P1_, qm8 - kb_); else mask_tile(P0_, P1_, qm - kb_, 0x7fffffffu); }   \
        dead_ = moba && kb_ < cur.P0 && (((selmask >> (kb_ >> 8)) & 1u) == 0u); } while (0)
    f32x16 pA0, pA1, pB0, pB1; float mnA, mnB, alA, alB; bf16x8 pa0, pa1, pa2, pa3;
    SWRITE_HV(0); SBAR();
    if (NT > 1) SLOAD_H(Kh, Vh, KBASE(1));
    SBAR(); QKT(0, pA0, pA1);
    MASKT(pA0, pA1, 0); PSM(pA0, pA1, mnA, alA);
    if (NT > 1) { VMW(); SWRITE_H(1); }
    __syncthreads();
#define HALF_STEP(PX0, PX1, mnX, alX, PY0, PY1, alY, t, KB, VB, SB) do {                                                      \
        SBAR(); QKT(KB, PX0, PX1);                                                         \
        FIN(PY0, PY1, alY); SBAR();                                                           \
        if ((t) + 1 < NT) { SLOAD_H(Kh, Vh, KBASE((t) + 1)); SBAR(); }                                                        \
        PVT(VB); MASKT(PX0, PX1, (t)); PSM(PX0, PX1, mnX, alX);     \
        __syncthreads();                                                                                                      \
        if ((t) + 1 < NT) { VMW(); SWRITE_H(SB); }                                                                            \
        RESC(alX); __syncthreads(); } while (0)
    for (int t = 1; t + 1 < NT; t += 2) {
        HALF_STEP(pB0, pB1, mnB, alB, pA0, pA1, alA, t, 1, 0, 0);
        HALF_STEP(pA0, pA1, mnA, alA, pB0, pB1, alB, t + 1, 0, 1, 1);
    }
    const bool even = (NT & 1) == 0;
    if (even) { SBAR(); QKT(1, pB0, pB1); SBAR(); }
    FIN(pA0, pA1, alA); SBAR();
    PVT(0);
    if (even) { MASKT(pB0, pB1, NT - 1); PSM(pB0, pB1, mnB, alB); __syncthreads(); RESC(alB);
        FIN(pB0, pB1, alB); SBAR(); PVT(1); }
    SBAR();
    if (hi == 0) li_l[r32] = l_reg; asm volatile("s_waitcnt lgkmcnt(0)" ::: "memory");
    float rli[16];
#pragma unroll
    for (int r = 0; r < 16; ++r) rli[r] = __builtin_amdgcn_rcpf(li_l[crow(r, hi)]) * (F8 ? 1.0f / 16.0f : 1.0f);
    E(o, rli, wid, lane, r32, hi);
    __syncthreads();
#undef RESC
#undef KBASE
#undef QKT
#undef VF8N
#undef MM8
#undef PV8
#undef FIN
#undef PVT
#undef PSM
#undef MASKT
#undef HALF_STEP
}
constexpr int WIDE_WS = 4 * SHM_V + 2 * SHM_K;
constexpr int WIDE_BYTES = WIDE_WS + NW * 64 * 4;
template <class Epi, int VAR = 0>
__device__ __forceinline__ void block_wide(const BlockRef& cur, const bf16* V2, int skv, char* lds, Seam& S, const Epi& E) {
    int tid = threadIdx.x; asm volatile("" : "+v"(tid));
    const int wid = __builtin_amdgcn_readfirstlane(tid >> 6), lane = tid & 63, r32 = lane & 31, hi = lane >> 5;
    int j_hi = (cur.P0 + QB - 1) / KVBLK + 1; if (j_hi > skv / KVBLK) j_hi = skv / KVBLK;
    const int NT = j_hi;
    const int qlo = cur.P0 + wid * QBLK, qm = qlo + r32 - 4 * hi;
    char* V_lds = lds; char* K_lds = lds + 4 * SHM_V;
    float* ws = (float*)(lds + WIDE_WS) + wid * 64; float* li_l = ws, * al_l = ws + 32;
    float m_reg = -1e30f, l_reg = 0; f32x16 o[8] = {};
    const int vb0 = (int)(uintptr_t)V_lds + v_rd_base(lane);
    const int krow = 8 * wid + (lane >> 3);
    const unsigned koff = (unsigned)(krow * 128 + (((lane & 7) ^ ((krow >> 1) & 7)) << 4));
    const int vkk = (wid >> 1) * 8 + ((lane >> 2) & 7), vkey = (vkk & ~0xC) | ((vkk & 4) << 1) | ((vkk & 8) >> 1);
    const unsigned voff = (unsigned)(vkey * 256 + ((((wid & 1) * 2 + (lane >> 5)) * 32 + (lane & 3) * 8) * 2));
    const char* Kh = (const char*)cur.K; const char* Va = (const char*)cur.V; const char* Vb = (const char*)V2;
    typedef __attribute__((address_space(3))) unsigned* lds_uptr;
#define WDMA(gb, ldsb) do { __builtin_amdgcn_global_load_lds((const unsigned*)((gb) + voff_), (lds_uptr)((ldsb) + wid * 1024), 16, 0, 0);                    \
                            __builtin_amdgcn_global_load_lds((const unsigned*)((gb) + 8192 + voff_), (lds_uptr)((ldsb) + 8192 + wid * 1024), 16, 0, 0); } while (0)
#define WLOADK(k0, par) do { if constexpr (VAR == 4) { if ((k0) > 0) break; } const size_t tb_ = (VAR == 5) ? (size_t)0 : (size_t)(k0) * D;                                            \
        __builtin_amdgcn_global_load_lds((const unsigned*)(Kh + tb_ + koff), (lds_uptr)(K_lds + (par) * SHM_K + wid * 1024), 16, 0, 0); } while (0)
#define WLOADV(k0, par) do { if constexpr (VAR == 4) { if ((k0) > 0) break; } const size_t tb_ = (VAR == 5) ? (size_t)0 : (size_t)(k0) * (D * 2); const unsigned voff_ = voff;                                \
        WDMA(Va + tb_, V_lds + (2 * (par)) * SHM_V); WDMA(Vb + tb_, V_lds + (2 * (par) + 1) * SHM_V); } while (0)
    i32x8 q8[2];
    { const i32x4* qp = (const i32x4*)((const char*)cur.Q + (size_t)(wid * QBLK + r32) * D + hi * 32);
#pragma unroll
      for (int c = 0; c < 2; ++c) { const i32x4 lo_ = qp[4 * c], hi_ = qp[4 * c + 1]; q8[c] = (i32x8){lo_[0], lo_[1], lo_[2], lo_[3], hi_[0], hi_[1], hi_[2], hi_[3]}; } }
    WLOADK(0, 0); WLOADV(0, 0); VMW();
    __syncthreads();
    f32x16 p0, p1; float mn, al; bf16x8 pa0, pa1, pa2, pa3;
#define WBAR() do { asm volatile("s_waitcnt vmcnt(0) lgkmcnt(0)" ::: "memory"); __builtin_amdgcn_s_barrier(); asm volatile("" ::: "memory"); } while (0)
#define WBARN(more, n) do { if (more) asm volatile("s_waitcnt vmcnt(" #n ") lgkmcnt(0)" ::: "memory"); else asm volatile("s_waitcnt vmcnt(0) lgkmcnt(0)" ::: "memory");                 \
        __builtin_amdgcn_s_barrier(); asm volatile("" ::: "memory"); } while (0)
#define WQKSM(t, PAR) do { __builtin_amdgcn_s_setprio(1);       \
        qkt_f8<PAR>(p0, p1, K_lds, r32, hi, q8);                                                                                                   \
        { const int kb_ = (t) * KVBLK; if (kb_ + KVBLK - 1 > qlo) mask_tile(p0, p1, qm - kb_, 0x7fffffffu); }                                      \
        if constexpr (VAR != 1) { partialSM<8>(p0, p1, m_reg, mn, al);                                                                               \
        if (__any(al < 1.f)) { if (hi == 0) al_l[r32] = al; asm volatile("s_waitcnt lgkmcnt(0)" ::: "memory");                                     \
            for (int d_ = 0; d_ < 8; ++d_) for (int r = 0; r < 16; ++r) o[d_][r] *= al_l[crow(r, hi)]; }                                            \
        finishSM(p0, p1, al, l_reg, pa0, pa1, pa2, pa3); }                                                                                         \
        else { pa0 = pack8(f32x4{p0[0], p0[1], p0[2], p0[3]}, f32x4{p0[4], p0[5], p0[6], p0[7]}); pa1 = pack8(f32x4{p0[8], p0[9], p0[10], p0[11]}, f32x4{p0[12], p0[13], p0[14], p0[15]});   \
               pa2 = pack8(f32x4{p1[0], p1[1], p1[2], p1[3]}, f32x4{p1[4], p1[5], p1[6], p1[7]}); pa3 = pack8(f32x4{p1[8], p1[9], p1[10], p1[11]}, f32x4{p1[12], p1[13], p1[14], p1[15]}); l_reg += p0[0]; } \
        __builtin_amdgcn_s_setprio(0); SBAR(); } while (0)
    s16x4 Xl0, Xl1, Xl2, Xl3, Xh0, Xh1, Xh2, Xh3, Yl0, Yl1, Yl2, Yl3, Yh0, Yh1, Yh2, Yh3;
#define TRRD(dst, off) asm volatile("ds_read_b64_tr_b16 %0, %1 offset:%2" : "=&v"(dst) : "v"(vb0), "i"(off) : "memory")
#define WRD(S_, PAR, g) do { constexpr int b_ = (2 * (PAR) + ((g) >> 2)) * SHM_V + ((g) & 3) * 512;                                                \
        TRRD(S_##l0, b_); TRRD(S_##h0, b_ + 2048); TRRD(S_##l1, b_ + 4096); TRRD(S_##h1, b_ + 6144);                                             \
        TRRD(S_##l2, b_ + 8192); TRRD(S_##h2, b_ + 10240); TRRD(S_##l3, b_ + 12288); TRRD(S_##h3, b_ + 14336); } while (0)
#define WMM(S_, g) do {                                                                                                                            \
        o[g] = __builtin_amdgcn_mfma_f32_32x32x16_bf16(pa0, (bf16x8){S_##l0[0], S_##l0[1], S_##l0[2], S_##l0[3], S_##h0[0], S_##h0[1], S_##h0[2], S_##h0[3]}, o[g], 0, 0, 0);   \
        o[g] = __builtin_amdgcn_mfma_f32_32x32x16_bf16(pa1, (bf16x8){S_##l1[0], S_##l1[1], S_##l1[2], S_##l1[3], S_##h1[0], S_##h1[1], S_##h1[2], S_##h1[3]}, o[g], 0, 0, 0);   \
        o[g] = __builtin_amdgcn_mfma_f32_32x32x16_bf16(pa2, (bf16x8){S_##l2[0], S_##l2[1], S_##l2[2], S_##l2[3], S_##h2[0], S_##h2[1], S_##h2[2], S_##h2[3]}, o[g], 0, 0, 0);   \
        o[g] = __builtin_amdgcn_mfma_f32_32x32x16_bf16(pa3, (bf16x8){S_##l3[0], S_##l3[1], S_##l3[2], S_##l3[3], S_##h3[0], S_##h3[1], S_##h3[2], S_##h3[3]}, o[g], 0, 0, 0); SBAR(); } while (0)
#define WW8() do { asm volatile("s_waitcnt lgkmcnt(8)" ::: "memory"); SBAR(); } while (0)
#define WPV(PAR) do { if constexpr (VAR == 2) { o[0][0] += (float)pa0[0] + (float)pa1[0] + (float)pa2[0] + (float)pa3[0]; break; } SBAR(); WRD(X, PAR, 0); WRD(Y, PAR, 1); WW8(); WMM(X, 0); WRD(X, PAR, 2); WW8(); WMM(Y, 1); WRD(Y, PAR, 3); WW8(); WMM(X, 2); WRD(X, PAR, 4); WW8(); WMM(Y, 3);    \
        WRD(Y, PAR, 5); WW8(); WMM(X, 4); WRD(X, PAR, 6); WW8(); WMM(Y, 5); WRD(Y, PAR, 7); WW8(); WMM(X, 6); asm volatile("s_waitcnt lgkmcnt(0)" ::: "memory"); SBAR(); WMM(Y, 7); } while (0)
    if (wid < 4) {
#define WSTEP_L(t, PAR) do { const bool more_ = (t) + 1 < NT; if (more_) WLOADK(((t) + 1) * KVBLK, 1 - PAR); WQKSM(t, PAR); WBARN(more_, 1); if (more_) WLOADV(((t) + 1) * KVBLK, 1 - PAR); WPV(PAR); WBARN(more_, 4); } while (0)
        for (int t = 0; t < NT; t += 2) { WSTEP_L(t, 0); WSTEP_L(t + 1, 1); }
        WBAR();
#undef WSTEP_L
    } else {
#define WSTEP_T(t, PAR) do { const bool more_ = (t) + 1 < NT; if (more_) WLOADK(((t) + 1) * KVBLK, 1 - PAR); if ((t) > 0) WPV(1 - PAR); WBARN(more_, 1); if (more_) WLOADV(((t) + 1) * KVBLK, 1 - PAR); WQKSM(t, PAR); WBARN(more_, 4); } while (0)
        for (int t = 0; t < NT; t += 2) { WSTEP_T(t, 0); WSTEP_T(t + 1, 1); }
        WPV(1); WBAR();
#undef WSTEP_T
    }
    if (hi == 0) li_l[r32] = l_reg; asm volatile("s_waitcnt lgkmcnt(0)" ::: "memory");
    float rli[16];
#pragma unroll
    for (int r = 0; r < 16; ++r) rli[r] = __builtin_amdgcn_rcpf(li_l[crow(r, hi)]);
    E(o, rli, wid, lane, r32, hi);
    __syncthreads();
#undef WBAR
#undef WBARN
#undef WQKSM
#undef WPV
#undef TRRD
#undef WRD
#undef WMM
#undef WW8
#undef WDMA
#undef WLOADK
#undef WLOADV
}
template <class Epi>
__device__ __forceinline__ void block_wide8(const BlockRef& cur, const bf16* V2, int skv, char* lds, Seam& S, const Epi& E) {
    int tid = threadIdx.x; asm volatile("" : "+v"(tid));
    const int wid = __builtin_amdgcn_readfirstlane(tid >> 6), lane = tid & 63, r32 = lane & 31, hi = lane >> 5;
    int j_hi = (cur.P0 + QB - 1) / KVBLK + 1; if (j_hi > skv / KVBLK) j_hi = skv / KVBLK;
    const int NT = j_hi;
    const int qlo = cur.P0 + wid * QBLK, qm = qlo + r32 - 8 * hi;
    char* V_lds = lds; char* K_lds = lds + 4 * SHM_V;
    float* ws = (float*)(lds + WIDE_WS) + wid * 64; float* li_l = ws, * al_l = ws + 32;
    float m_reg = -1e30f, l_reg = 0; f32x16 o[8] = {};
    const int krow = 8 * wid + (lane >> 3), krp = krow & 31, kt = (krp & 3) + 4 * (krp >> 3) + 16 * (krow >> 5), kkey = 16 * (kt & 3) + (kt >> 2) + 8 * ((krp >> 2) & 1);
    const unsigned koff = (unsigned)(kkey * 128 + (((lane & 7) ^ ((krow >> 1) & 7)) << 4));
    const int vc = 16 * wid + (lane >> 2);
    const unsigned voff = (unsigned)(vc * 64 + (((lane & 3) ^ ((vc >> 2) & 3)) << 4));
    const char* Kh = (const char*)cur.K; const char* Va = (const char*)cur.V; const char* Vb = (const char*)V2;
    typedef __attribute__((address_space(3))) unsigned* lds_uptr;
#define WLOADK(t_, par) __builtin_amdgcn_global_load_lds((const unsigned*)(Kh + (size_t)(t_) * (KVBLK * D) + koff), (lds_uptr)(K_lds + (par) * SHM_K + wid * 1024), 16, 0, 0)
#define WLOADV(t_, par) do { __builtin_amdgcn_global_load_lds((const unsigned*)(Va + (size_t)(t_) * 8192 + voff), (lds_uptr)(V_lds + (2 * (par)) * SHM_V + wid * 1024), 16, 0, 0);      \
                             __builtin_amdgcn_global_load_lds((const unsigned*)(Vb + (size_t)(t_) * 8192 + voff), (lds_uptr)(V_lds + (2 * (par) + 1) * SHM_V + wid * 1024), 16, 0, 0); } while (0)
    i32x8 q8[2];
    { const i32x4* qp = (const i32x4*)((const char*)cur.Q + (size_t)(wid * QBLK + r32) * D + hi * 32);
#pragma unroll
      for (int c = 0; c < 2; ++c) { const i32x4 lo_ = qp[4 * c], hi_ = qp[4 * c + 1]; q8[c] = (i32x8){lo_[0], lo_[1], lo_[2], lo_[3], hi_[0], hi_[1], hi_[2], hi_[3]}; } }
    WLOADK(0, 0); WLOADV(0, 0); VMW();
    __syncthreads();
    f32x16 p0, p1; float mn, al; i32x8 pa8;
    typedef const __attribute__((address_space(3))) bf16x8* lds_f;
    const unsigned vsw = (unsigned)((r32 >> 2) & 3), va0 = (unsigned)(__UINTPTR_TYPE__)V_lds + (unsigned)(r32 * 64) + (((unsigned)(2 * hi) ^ vsw) << 4), va1 = (unsigned)(__UINTPTR_TYPE__)V_lds + (unsigned)(r32 * 64) + (((unsigned)(2 * hi + 1) ^ vsw) << 4);
#define VF8(PAR, g) __builtin_bit_cast(i32x8, __builtin_shufflevector(*(lds_f)(__UINTPTR_TYPE__)(va0 + (2 * (PAR) + ((g) >> 2)) * SHM_V + ((g) & 3) * 2048),                       \
                                                                      *(lds_f)(__UINTPTR_TYPE__)(va1 + (2 * (PAR) + ((g) >> 2)) * SHM_V + ((g) & 3) * 2048), 0, 1, 2, 3, 4, 5, 6, 7, 8, 9, 10, 11, 12, 13, 14, 15))
#define MM8(g, f_) asm volatile("v_mfma_f32_32x32x64_f8f6f4 %0, %1, %2, %0" : "+v"(o[g]) : "v"(pa8), "v"(f_))
#define WBAR() do { asm volatile("s_waitcnt vmcnt(0) lgkmcnt(0)" ::: "memory"); __builtin_amdgcn_s_barrier(); asm volatile("" ::: "memory"); } while (0)
#define WBARN(more, n) do { if (more) asm volatile("s_waitcnt vmcnt(" #n ") lgkmcnt(0)" ::: "memory"); else asm volatile("s_waitcnt vmcnt(0) lgkmcnt(0)" ::: "memory");                 \
        __builtin_amdgcn_s_barrier(); asm volatile("" ::: "memory"); } while (0)
#define WQKSM(t, PAR) do { __builtin_amdgcn_s_setprio(1);                                                                                          \
        qkt_f8<PAR, true>(p0, p1, K_lds, r32, hi, q8);                                                                                                   \
        { const int kb_ = (t) * KVBLK; if (kb_ + KVBLK - 1 > qlo) mask_tile_perm(p0, p1, qm - kb_); }                                              \
        partialSM<8, 2, 5>(p0, p1, m_reg, mn, al);                                                                                                 \
        if (__any(al < 1.f)) { if (hi == 0) al_l[r32] = al; asm volatile("s_waitcnt lgkmcnt(0)" ::: "memory");                                     \
            for (int d_ = 0; d_ < 8; ++d_) for (int r = 0; r < 16; ++r) o[d_][r] *= al_l[crow(r, hi)]; }                                            \
        finishSM8(p0, p1, al, l_reg, pa8);                                                                                                         \
        __builtin_amdgcn_s_setprio(0); SBAR(); } while (0)
#define WPV(PAR) do { SBAR(); i32x8 f0_ = VF8(PAR, 0), f1_ = VF8(PAR, 1); SBAR(); MM8(0, f0_); f0_ = VF8(PAR, 2); SBAR(); MM8(1, f1_); f1_ = VF8(PAR, 3); SBAR(); MM8(2, f0_); f0_ = VF8(PAR, 4); SBAR();   \
        MM8(3, f1_); f1_ = VF8(PAR, 5); SBAR(); MM8(4, f0_); f0_ = VF8(PAR, 6); SBAR(); MM8(5, f1_); f1_ = VF8(PAR, 7); SBAR(); MM8(6, f0_); MM8(7, f1_);                                                  \
        asm volatile("s_nop 15\n\ts_nop 15" ::: "memory"); SBAR(); } while (0)
    if (wid < 4) {
#define WSTEP_L(t, PAR) do { const bool more_ = (t) + 1 < NT; if (more_) WLOADK((t) + 1, 1 - PAR); WQKSM(t, PAR); WBARN(more_, 1); if (more_) WLOADV((t) + 1, 1 - PAR); WPV(PAR); WBARN(more_, 2); } while (0)
        for (int t = 0; t < NT; t += 2) { WSTEP_L(t, 0); WSTEP_L(t + 1, 1); }
        WBAR();
#undef WSTEP_L
    } else {
#define WSTEP_T(t, PAR) do { const bool more_ = (t) + 1 < NT; if (more_) WLOADK((t) + 1, 1 - PAR); if ((t) > 0) WPV(1 - PAR); WBARN(more_, 1); if (more_) WLOADV((t) + 1, 1 - PAR); WQKSM(t, PAR); WBARN(more_, 2); } while (0)
        for (int t = 0; t < NT; t += 2) { WSTEP_T(t, 0); WSTEP_T(t + 1, 1); }
        WPV(1); WBAR();
#undef WSTEP_T
    }
    if (hi == 0) li_l[r32] = l_reg; asm volatile("s_waitcnt lgkmcnt(0)" ::: "memory");
    float rli[16];
#pragma unroll
    for (int r = 0; r < 16; ++r) rli[r] = __builtin_amdgcn_rcpf(li_l[crow(r, hi)]) * (1.0f / 16.0f);
    E(o, rli, wid, lane, r32, hi);
    __syncthreads();
#undef WLOADK
#undef WLOADV
#undef VF8
#undef MM8
#undef WBAR
#undef WBARN
#undef WQKSM
#undef WPV
}
#undef ROW
#undef VMW
#undef SLOAD_H
#undef SWRITE_HK
#undef SWRITE_HV
#undef SWRITE_H

template <int X> __device__ __forceinline__ float swz_xor(float v) {
    return __int_as_float(__builtin_amdgcn_ds_swizzle(__float_as_int(v), (X << 10) | 0x1f));
}
__device__ __forceinline__ float half_sum(float s) {
    s += swz_xor<1>(s); s += swz_xor<2>(s); s += swz_xor<4>(s); s += swz_xor<8>(s); s += swz_xor<16>(s); return s;
}
__device__ __forceinline__ void store_pair(bf16* p, float v, int r32) {
    const float vn = swz_xor<1>(v);
    if ((r32 & 1) == 0) *(unsigned*)p = cvtpk(v, vn);
}
__device__ __forceinline__ void store_quad8(unsigned char* p, float v, int r32) {
    v = fminf(fmaxf(v, -448.f), 448.f);
    const float v1 = swz_xor<1>(v);
    const int w = __builtin_amdgcn_cvt_pk_fp8_f32(v, v1, 0, false);
    const int w2 = __builtin_amdgcn_ds_swizzle(w, (2 << 10) | 0x1f);
    if ((r32 & 3) == 0) *(unsigned*)p = ((unsigned)w & 0xffffu) | ((unsigned)w2 << 16);
}
struct EpiSelf {
    int mode, vh;
    unsigned char* out;
    const float* gain;
    float* scr;
    float* ssq;
    float lam;
    __device__ __forceinline__ void operator()(f32x16 (&o)[4], const float (&rli)[16], int wid, int lane, int r32, int hi) const {
        asm volatile("" : "+v"(lane), "+v"(r32), "+v"(hi));
        unsigned char* base = out + (size_t)(wid * QBLK) * 4096;
        if (mode == 0) {
            float rn[16];
#pragma unroll
            for (int r = 0; r < 16; ++r) { float s = 0.f;
#pragma unroll
                for (int d0 = 0; d0 < 4; ++d0) { const float v = o[d0][r] * rli[r]; o[d0][r] = v; s += v * v; }
                s = half_sum(s); rn[r] = rsqrtf(s * (1.0f / 128.0f) + 1e-5f); }
            float g[4];
#pragma unroll
            for (int d0 = 0; d0 < 4; ++d0) g[d0] = gain[d0 * 32 + r32];
#pragma unroll
            for (int r = 0; r < 16; ++r)
#pragma unroll
                for (int d0 = 0; d0 < 4; ++d0) store_quad8(base + (size_t)crow(r, hi) * 4096 + d0 * 32 + r32, o[d0][r] * rn[r] * g[d0], r32);
        } else if (mode == 1) {
            float* p = scr + vh * 4096 + lane;
#pragma unroll
            for (int r = 0; r < 16; ++r)
#pragma unroll
                for (int d0 = 0; d0 < 4; ++d0) p[(r * 4 + d0) * 64] = o[d0][r] * rli[r];
        } else {
            float* p = scr + vh * 4096 + lane;
            float rn[16];
#pragma unroll
            for (int r = 0; r < 16; ++r) { float s = 0.f;
#pragma unroll
                for (int d0 = 0; d0 < 4; ++d0) { const float t = p[(r * 4 + d0) * 64]; const float dd = t - lam * (o[d0][r] * rli[r]); o[d0][r] = dd; s += dd * dd;
                    if (vh == 0) p[(r * 4 + d0) * 64] = dd; }
                s = half_sum(s);
                if (vh == 0) { if (r32 == 0) ssq[crow(r, hi)] = s; rn[r] = 0.f; }
                else rn[r] = rsqrtf((s + ssq[crow(r, hi)]) * (1.0f / 256.0f) + 1e-5f) * 0.8f; }
            if (vh == 1) {
                float g[4];
#pragma unroll
                for (int d0 = 0; d0 < 4; ++d0) g[d0] = gain[128 + d0 * 32 + r32];
#pragma unroll
                for (int r = 0; r < 16; ++r)
#pragma unroll
                    for (int d0 = 0; d0 < 4; ++d0) store_quad8(base + (size_t)crow(r, hi) * 4096 + 128 + d0 * 32 + r32, o[d0][r] * rn[r] * g[d0], r32);
                const float* pa = scr + lane;
#pragma unroll
                for (int d0 = 0; d0 < 4; ++d0) g[d0] = gain[d0 * 32 + r32];
#pragma unroll
                for (int r = 0; r < 16; ++r)
#pragma unroll
                    for (int d0 = 0; d0 < 4; ++d0) store_quad8(base + (size_t)crow(r, hi) * 4096 + d0 * 32 + r32, pa[(r * 4 + d0) * 64] * rn[r] * g[d0], r32);
            }
        }
    }
};
__device__ __forceinline__ float mul_ns(float a, float b) { float r; asm("v_mul_f32 %0, %1, %2" : "=v"(r) : "v"(a), "v"(b)); return r; }
__device__ __forceinline__ float fma_ns(float a, float b, float c) { float r; asm("v_fma_f32 %0, %1, %2, %3" : "=v"(r) : "v"(a), "v"(b), "v"(c)); return r; }
struct EpiWide {
    int mode;
    unsigned char* out;
    const float* gain;
    float* scr;
    float lam;
    __device__ __forceinline__ void operator()(f32x16 (&o)[8], const float (&rli)[16], int wid, int lane, int r32, int hi) const {
        asm volatile("" : "+v"(lane), "+v"(r32), "+v"(hi));
        const unsigned ul = (unsigned)lane;
        if (mode == 1) {
#pragma unroll
            for (int r = 0; r < 16; ++r)
#pragma unroll
                for (int d0 = 0; d0 < 8; ++d0) (scr + ((d0 >> 2) * 4096 + (r * 4 + (d0 & 3)) * 64))[ul] = mul_ns(o[d0][r], rli[r]);
        } else {
            unsigned char* base = out + (size_t)(wid * QBLK) * 4096; const unsigned uo = (unsigned)(hi * 4 * 4096 + r32);
            const float nlam = -lam;
            float rn[16];
#pragma unroll
            for (int rb = 0; rb < 16; rb += 2) { float tt[2][8];
#pragma unroll
                for (int q = 0; q < 2; ++q)
#pragma unroll
                    for (int d0 = 0; d0 < 8; ++d0) tt[q][d0] = (scr + ((d0 >> 2) * 4096 + ((rb + q) * 4 + (d0 & 3)) * 64))[ul];
                asm volatile("" ::: "memory"); SBAR();
#pragma unroll
                for (int q = 0; q < 2; ++q) { const int r = rb + q; float s = 0.f;
#pragma unroll
                    for (int d0 = 0; d0 < 8; ++d0) { const float dd = fma_ns(nlam, mul_ns(o[d0][r], rli[r]), tt[q][d0]); s = fma_ns(dd, dd, s); }
                    s = half_sum(s); rn[r] = rsqrtf(s * (1.0f / 256.0f) + 1e-5f) * 0.8f; }
                asm volatile("" ::: "memory"); SBAR(); }
            float g[8];
#pragma unroll
            for (int d0 = 0; d0 < 8; ++d0) g[d0] = gain[d0 * 32 + r32];
#pragma unroll
            for (int rb = 0; rb < 16; rb += 2) { float tt[2][8];
#pragma unroll
                for (int q = 0; q < 2; ++q)
#pragma unroll
                    for (int d0 = 0; d0 < 8; ++d0) tt[q][d0] = (scr + ((d0 >> 2) * 4096 + ((rb + q) * 4 + (d0 & 3)) * 64))[ul];
                asm volatile("" ::: "memory"); SBAR();
#pragma unroll
                for (int q = 0; q < 2; ++q) { const int r = rb + q;
#pragma unroll
                    for (int d0 = 0; d0 < 8; ++d0) { const float dd = fma_ns(nlam, mul_ns(o[d0][r], rli[r]), tt[q][d0]);
                        store_quad8(base + (crow(r, 0) * 4096 + d0 * 32) + uo, mul_ns(mul_ns(dd, rn[r]), g[d0]), r32); } }
                asm volatile("" ::: "memory"); SBAR(); }
        }
    }
};
struct EpiNull {
    float* scr;
    __device__ __forceinline__ void operator()(f32x16 (&o)[8], const float (&rli)[16], int wid, int lane, int r32, int hi) const {
        float a = 0.f;
#pragma unroll
        for (int d0 = 0; d0 < 8; ++d0)
#pragma unroll
            for (int r = 0; r < 16; ++r) a += o[d0][r] * rli[r];
        if (a == 123.456f) scr[lane] = a;
    }
};
struct EpiMem {
    unsigned char* out;
    __device__ __forceinline__ void operator()(f32x16 (&o)[4], const float (&rli)[16], int wid, int lane, int r32, int hi) const {
        asm volatile("" : "+v"(lane), "+v"(r32), "+v"(hi));
        unsigned char* base = out + (size_t)(wid * QBLK) * 512;
#pragma unroll
        for (int r = 0; r < 16; ++r)
#pragma unroll
            for (int d0 = 0; d0 < 4; ++d0) store_quad8(base + (size_t)crow(r, hi) * 512 + d0 * 32 + r32, o[d0][r] * rli[r] * 16.f, r32);
    }
};
__device__ __forceinline__ unsigned moba_select(const Seam& S, const float* KM, int qb, int r32, int hi) {
    asm volatile("" : "+v"(r32), "+v"(hi));
    f32x16 g = f32x16{};
#pragma unroll
    for (int d0 = 0; d0 < 8; ++d0) { const float* kp = KM + (size_t)(r32 & 15) * 128 + d0 * 16 + hi * 8; const bf16x8 kf = pack8(*(const f32x4*)kp * (1.0f / 256.0f), *(const f32x4*)(kp + 4) * (1.0f / 256.0f));
        g = __builtin_amdgcn_mfma_f32_32x32x16_bf16(kf, S.qr[d0], g, 0, 0, 0); }
    const float NEG = -__builtin_inff();
    float gate[16];
#pragma unroll
    for (int r = 0; r < 8; ++r) { const float own = g[r]; const auto sw = __builtin_amdgcn_permlane32_swap(__float_as_uint(own), __float_as_uint(own), false, false);
        const float oth = __uint_as_float(hi ? sw[0] : sw[1]);
        const int blk = (r & 3) + 8 * (r >> 2);
        gate[blk] = hi ? oth : own; gate[blk + 4] = hi ? own : oth; }
#pragma unroll
    for (int blk = 0; blk < 16; ++blk) gate[blk] = (blk < qb) ? gate[blk] : NEG;
    unsigned sel = 0u;
#pragma unroll
    for (int k = 0; k < 3; ++k) { float best = NEG; int bi = 16;
#pragma unroll
        for (int blk = 0; blk < 16; ++blk) if (gate[blk] > best) { best = gate[blk]; bi = blk; }
        sel |= (bi < 16) ? (1u << bi) : 0u;
#pragma unroll
        for (int blk = 0; blk < 16; ++blk) gate[blk] = (blk == bi) ? NEG : gate[blk]; }
    return sel;
}
__device__ __forceinline__ void q8_from_qr(Seam& S) {
#pragma unroll
    for (int c = 0; c < 2; ++c)
#pragma unroll
        for (int dd = 0; dd < 4; ++dd) { const bf16x8 v = S.qr[4 * c + dd]; float f[8];
#pragma unroll
            for (int j = 0; j < 8; ++j) f[j] = __builtin_amdgcn_fmed3f(__uint_as_float(((unsigned)(unsigned short)v[j]) << 16) * 16.f, -448.f, 448.f);
            int w0 = 0, w1 = 0;
            w0 = __builtin_amdgcn_cvt_pk_fp8_f32(f[0], f[1], w0, false); w0 = __builtin_amdgcn_cvt_pk_fp8_f32(f[2], f[3], w0, true);
            w1 = __builtin_amdgcn_cvt_pk_fp8_f32(f[4], f[5], w1, false); w1 = __builtin_amdgcn_cvt_pk_fp8_f32(f[6], f[7], w1, true);
            S.q8[c][2 * dd] = w0; S.q8[c][2 * dd + 1] = w1; }
}
}

#ifndef MK_N_LAUNCHES
#define MK_N_LAUNCHES 1
#endif
constexpr int NWAVES = 8;
constexpr int NPHASE = 11;
constexpr int N_LAUNCHES = MK_N_LAUNCHES;
constexpr int BATCH = 4, SEQ = 4096, DMODEL = 4096, MTOK = BATCH * SEQ, NPROJ = 12288, MEMLEN = 256, MEMW = 512, DFF = 16384;
constexpr size_t MiB = 1u << 20;
constexpr size_t WS_CTL = 0, CTL_ZERO_BYTES = 1 * MiB;
constexpr size_t WS_ROPE = 1 * MiB;
constexpr size_t WS_SS0 = WS_ROPE + 512 * 1024;
constexpr size_t WS_KMEAN = WS_SS0 + 128 * 1024;
constexpr size_t WS_WUP = 4 * MiB, WS_WDOWN = 136 * MiB;
constexpr size_t WS_XB8 = 68 * MiB;
constexpr size_t WS_XB = 260 * MiB;
constexpr size_t WS_WOUT = 396 * MiB, WS_WCQKV = 428 * MiB, WS_WCO = 440 * MiB;
constexpr size_t WS_QKV = 444 * MiB;
constexpr size_t WS_MERGED = 828 * MiB, WS_WIN = 828 * MiB;
constexpr size_t WS_QC = 444 * MiB, WS_KC = 460 * MiB, WS_VC = 461 * MiB, WS_OC = 462 * MiB;
constexpr size_t WS_SCR = 892 * MiB;
constexpr size_t WS_U = 444 * MiB;
constexpr size_t WS_END = 956 * MiB;
constexpr int CW_TMO = 0, CW_CODE = 1, CW_QUEUE = 64, CW_BAR = 4096, CW_SS1 = 8192, CW_SS2 = CW_SS1 + 16384, CW_SS3 = CW_SS2 + 16384, CW_KMF = 81920;
static_assert(CW_SS3 + 2 * 16384 <= CW_KMF && (CW_KMF + 131072) * 4 <= (int)CTL_ZERO_BYTES, "CTL words inside the memset region");
constexpr int RING_OFF = 0, RING_BYTES = 131072;
constexpr int LDSCTL_OFF = 135168, MISC_OFF = LDSCTL_OFF + 320;
constexpr int LDS_BYTES = 147456;
static_assert(att::LDS_BYTES <= RING_BYTES && att::WIDE_BYTES <= RING_BYTES, "attention LDS");

#define GAS __attribute__((address_space(1)))
#define LAS __attribute__((address_space(3)))
typedef unsigned short bf16;
typedef unsigned v4u __attribute__((ext_vector_type(4)));
typedef unsigned v2u __attribute__((ext_vector_type(2)));
typedef float f32x4 __attribute__((ext_vector_type(4)));
typedef GAS unsigned gu32;
#define RLX_AGENT __ATOMIC_RELAXED, __HIP_MEMORY_SCOPE_AGENT
#define LDS_WAIT() asm volatile("s_waitcnt lgkmcnt(0)" ::: "memory")
#define VM_WAIT() asm volatile("s_waitcnt vmcnt(0)" ::: "memory")
__device__ __forceinline__ unsigned f2bf(float f) { unsigned u = __builtin_bit_cast(unsigned, f); return (u + 0x7fffu + ((u >> 16) & 1u)) >> 16; }
__device__ __forceinline__ unsigned pk2(float lo, float hi) { return f2bf(lo) | (f2bf(hi) << 16); }

#define XB_TMO      128
#define XB_XCNT(j)  (256  + 64 * (j))
#define XB_XSUB(j)  (1280 + 64 * (j))
#define XB_XGEN(j)  (2304 + 64 * (j))
#define XB_TOP      3328
#define XB_TOPGEN   3392
#define XCD_BAR_WORDS 3456
#define XB_SPIN_CAP (1u << 18)

__device__ __forceinline__ unsigned xb_ld(unsigned* p)              { return __hip_atomic_load(p, __ATOMIC_RELAXED, __HIP_MEMORY_SCOPE_AGENT); }
__device__ __forceinline__ unsigned xb_add(unsigned* p, unsigned v) { return __hip_atomic_fetch_add(p, v, __ATOMIC_RELAXED, __HIP_MEMORY_SCOPE_AGENT); }
__device__ __forceinline__ unsigned xb_xcc_id() { return (unsigned)__builtin_amdgcn_s_getreg((3 << 11) | 20) & 0xFu; }
#define XB_SPIN(cond, bar) do { unsigned _sp = 0; while (cond) { __builtin_amdgcn_s_sleep(1); \
    if ((++_sp & 255u) == 0u) { if (xb_ld(&(bar)[XB_TMO])) break; if (_sp > XB_SPIN_CAP) { atomicAdd(&(bar)[XB_TMO], 1u); break; } } } } while (0)

struct XcdBarrier {
    unsigned* bar; unsigned x;
    volatile LAS unsigned* st;
};

__device__ __forceinline__ XcdBarrier xcd_barrier_post(unsigned* bar, volatile LAS unsigned* st) {
    XcdBarrier b; b.bar = bar; b.x = xb_xcc_id(); b.st = st;
    if (threadIdx.x == 0) (void)xb_add(&bar[XB_XCNT(b.x)], 1u);
    return b;
}
__device__ __forceinline__ void xcd_barrier_complete(unsigned* bar, unsigned x, unsigned& nloc, unsigned& nx) {
    const unsigned G = gridDim.x * gridDim.y * gridDim.z;
    unsigned sum, cnt, mine, sp = 0u;
    for (;;) {
        sum = 0u; cnt = 0u; mine = 0u;
#pragma unroll
        for (unsigned j = 0; j < 16; ++j) { const unsigned c = xb_ld(&bar[XB_XCNT(j)]); sum += c; cnt += (c > 0u) ? 1u : 0u; mine = (j == x) ? c : mine; }
        if (sum == G) break;
        __builtin_amdgcn_s_sleep(1);
        if ((++sp & 255u) == 0u) { if (xb_ld(&bar[XB_TMO])) break; if (sp > XB_SPIN_CAP) { atomicAdd(&bar[XB_TMO], 1u); break; } }
    }
    nloc = mine > 0u ? mine : 1u; nx = cnt > 0u ? cnt : 1u;
}

__device__ __forceinline__ void xcd_barrier(const XcdBarrier& b) {
    asm volatile("s_waitcnt vmcnt(0)" ::: "memory");
    __syncthreads();
    if (threadIdx.x == 0) {
        unsigned* bar = b.bar;
        __builtin_amdgcn_s_waitcnt(0);
        unsigned nloc = b.st[0], nx = b.st[1];
        if (nloc == 0u) { xcd_barrier_complete(bar, b.x, nloc, nx); b.st[0] = nloc; b.st[1] = nx; }
        const unsigned old = xb_add(&bar[XB_XSUB(b.x)], 1u);
        const unsigned gen = old / nloc;
        if (old + 1u == (gen + 1u) * nloc) {
            __builtin_amdgcn_fence(__ATOMIC_RELEASE, "agent");
            asm volatile("s_waitcnt vmcnt(0)" ::: "memory");
            const unsigned og = xb_add(&bar[XB_TOP], 1u);
            const unsigned tg = og / nx;
            if (og + 1u == (tg + 1u) * nx) xb_add(&bar[XB_TOPGEN], 1u);
            else XB_SPIN(xb_ld(&bar[XB_TOPGEN]) == tg, bar);
            __builtin_amdgcn_fence(__ATOMIC_ACQUIRE, "agent");
            xb_add(&bar[XB_XGEN(b.x)], 1u);
            asm volatile("s_waitcnt vmcnt(0)" ::: "memory");
        } else {
            XB_SPIN(xb_ld(&bar[XB_XGEN(b.x)]) == gen, bar);
            __builtin_amdgcn_fence(__ATOMIC_ACQUIRE, "agent");
            asm volatile("s_waitcnt vmcnt(0)" ::: "memory");
        }
    }
    __syncthreads();
}


__device__ __forceinline__ float wave_sum(float v) {
#pragma unroll
    for (int o = 1; o < 64; o <<= 1) v += __shfl_xor(v, o);
    return v;
}
__device__ __forceinline__ void p0_transpose_item(const float* W, int K, int N, const float* gk, bf16* WT, int row_off, LAS float* scr, int item, int lane, int ldw = 0) {
    const int nblk = N / 64, kb = item / nblk, nb = item - kb * nblk, k0 = 64 * kb, n0 = 64 * nb; if (ldw == 0) ldw = N;
    const int c4 = lane & 15, kq = lane >> 4;
#pragma unroll 4
    for (int i = 0; i < 16; ++i) { const int kk = 4 * i + kq;
        f32x4 v = __builtin_nontemporal_load((const GAS f32x4*)(W + (size_t)(k0 + kk) * ldw + n0 + 4 * c4));
        if (gk) v = v * gk[k0 + kk];
        LAS float* d = scr + kk * 65 + 4 * c4; d[0] = v[0]; d[1] = v[1]; d[2] = v[2]; d[3] = v[3]; }
    LDS_WAIT(); asm volatile("" ::: "memory");
    const int c = lane & 7;
#pragma unroll
    for (int j = 0; j < 8; ++j) { const int n = (lane >> 3) + 8 * j; const LAS float* s = scr + (8 * c) * 65 + n;
        v4u o; o.x = pk2(s[0 * 65], s[1 * 65]); o.y = pk2(s[2 * 65], s[3 * 65]); o.z = pk2(s[4 * 65], s[5 * 65]); o.w = pk2(s[6 * 65], s[7 * 65]);
        *(GAS v4u*)(WT + (size_t)(row_off + n0 + n) * K + k0 + 8 * c) = o; }
    LDS_WAIT(); asm volatile("" ::: "memory");
}
__device__ __forceinline__ void p0_transpose_item_f8(const float* W, int K, int N, const float* gk, float scale, unsigned char* WT, LAS float* scr, int item, int lane, int ldw = 0, bool win_order = false) {
    const int nblk = N / 64, kb = item / nblk, nb = item - kb * nblk, k0 = 64 * kb, n0 = 64 * nb; if (ldw == 0) ldw = N;
    const int nd0 = win_order ? 64 * ((nb < 32) ? nb + 64 : (nb < 96) ? nb - 32 : nb) : n0;
    const int c4 = lane & 15, kq = lane >> 4;
#pragma unroll 4
    for (int i = 0; i < 16; ++i) { const int kk = 4 * i + kq;
        f32x4 v = __builtin_nontemporal_load((const GAS f32x4*)(W + (size_t)(k0 + kk) * ldw + n0 + 4 * c4));
        v = v * (gk ? gk[k0 + kk] * scale : scale);
        LAS float* d = scr + kk * 65 + 4 * c4; d[0] = v[0]; d[1] = v[1]; d[2] = v[2]; d[3] = v[3]; }
    LDS_WAIT(); asm volatile("" ::: "memory");
    const int c = lane & 3;
#pragma unroll
    for (int j = 0; j < 4; ++j) { const int n = (lane >> 2) + 16 * j; const LAS float* s = scr + (16 * c) * 65 + n;
        v4u o; o.x = pg8::pk4_fp8(s[0 * 65], s[1 * 65], s[2 * 65], s[3 * 65]); o.y = pg8::pk4_fp8(s[4 * 65], s[5 * 65], s[6 * 65], s[7 * 65]);
        o.z = pg8::pk4_fp8(s[8 * 65], s[9 * 65], s[10 * 65], s[11 * 65]); o.w = pg8::pk4_fp8(s[12 * 65], s[13 * 65], s[14 * 65], s[15 * 65]);
        *(GAS v4u*)(WT + ((size_t)((nd0 + n) >> 4) * (K >> 5) + ((k0 + 16 * c) >> 5)) * 512 + ((nd0 + n) & 15) * 32 + ((16 * c) & 31)) = o; }
    LDS_WAIT(); asm volatile("" ::: "memory");
}
__device__ __forceinline__ void cos_sin_d(float angf, float& co, float& si) {
    const double a = (double)angf;
    const double kd = __builtin_rint(a * 0.6366197723675814);
    const double r = __builtin_fma(-kd, 1.5707963267948966, a) - kd * 6.123233995736766e-17;
    const double r2 = r * r;
    const double sp = r * (1.0 + r2 * (-1.0 / 6 + r2 * (1.0 / 120 + r2 * (-1.0 / 5040 + r2 * (1.0 / 362880 + r2 * (-1.0 / 39916800 + r2 * (1.0 / 6227020800.0)))))));
    const double cp = 1.0 + r2 * (-0.5 + r2 * (1.0 / 24 + r2 * (-1.0 / 720 + r2 * (1.0 / 40320 + r2 * (-1.0 / 3628800 + r2 * (1.0 / 479001600 + r2 * (-1.0 / 87178291200.0)))))));
    const int q = (int)((long long)kd & 3);
    const double c = (q == 0) ? cp : (q == 1) ? -sp : (q == 2) ? -cp : sp;
    const double s = (q == 0) ? sp : (q == 1) ? cp : (q == 2) ? -sp : -cp;
    co = (float)c; si = (float)s;
}

struct Args { const float* in[20]; float* out; unsigned char* ws; int ph_lo, ph_hi; };
__global__ void __launch_bounds__(NWAVES * 64, 2) mk_fwd(Args args) {
    extern __shared__ __attribute__((aligned(16))) unsigned char lds[];
    LAS unsigned char* const ldsl = (LAS unsigned char*)lds;
    volatile LAS unsigned* const MISC = (volatile LAS unsigned*)(ldsl + MISC_OFF);
    const int tid = threadIdx.x, lane = tid & 63, wave = __builtin_amdgcn_readfirstlane(tid >> 6);
    const int G = gridDim.x; const int bx = blockIdx.x;
    const int vcu = (G % 8 == 0) ? (bx % 8) * (G / 8) + bx / 8 : bx;
    unsigned char* const ws = args.ws;
    gu32* const ctl = (gu32*)(ws + WS_CTL);
    const float* x = args.in[0]; const float* mem = args.in[1]; const float* ln_mix_g = args.in[2]; const float* w_in = args.in[3]; const float* moba_out_g = args.in[4];
    const float* lq1 = args.in[5]; const float* lk1 = args.in[6]; const float* lq2 = args.in[7]; const float* lk2 = args.in[8]; const float* subln_g = args.in[9];
    const float* w_out = args.in[10]; const float* ln_cross_g = args.in[11]; const float* ln_mem_g = args.in[12]; const float* w_cq = args.in[13]; const float* w_ckv = args.in[14];
    const float* w_co = args.in[15]; const float* ln_mlp_g = args.in[16]; const float* w_up = args.in[17]; const float* w_down = args.in[18]; const float* final_g = args.in[19];
    float* const out = args.out;
    bf16* const W_INA_T = (bf16*)(ws + WS_WIN); unsigned char* const W_IN8 = ws + WS_WIN + 32 * MiB; unsigned char* const X8 = ws + WS_XB8; unsigned char* const W_OUT8 = ws + WS_WOUT; unsigned char* const W_CQKV8 = ws + WS_WCQKV; bf16* const W_CO_T = (bf16*)(ws + WS_WCO);
    unsigned char* const W_UP8 = ws + WS_WUP; unsigned char* const W_DN8 = ws + WS_WDOWN; unsigned char* const XB8 = ws + WS_XB8; unsigned char* const U8 = ws + WS_U;
    bf16* const XB = (bf16*)(ws + WS_XB); bf16* const QKV = (bf16*)(ws + WS_QKV); unsigned char* const MERGED8 = ws + WS_MERGED;
    bf16* const QC = (bf16*)(ws + WS_QC); bf16* const KC = (bf16*)(ws + WS_KC); bf16* const VC = (bf16*)(ws + WS_VC); bf16* const OC = (bf16*)(ws + WS_OC);
    float* const KMF = (float*)(ws + WS_CTL) + CW_KMF;
    float* const ROPE = (float*)(ws + WS_ROPE); float* const SS0 = (float*)(ws + WS_SS0);
    float* const SS1 = (float*)(ws + WS_CTL) + CW_SS1; float* const SS2 = (float*)(ws + WS_CTL) + CW_SS2; float* const SS3 = (float*)(ws + WS_CTL) + CW_SS3;
    float* const SCR = (float*)(ws + WS_SCR);

    for (int u = tid; u < (LDS_BYTES - LDSCTL_OFF) / 4; u += NWAVES * 64) ((LAS unsigned*)(ldsl + LDSCTL_OFF))[u] = 0u;
    __syncthreads();
    const int lo = args.ph_lo, hi_ph = args.ph_hi;
    XcdBarrier bar; bar.bar = (unsigned*)(ctl + CW_BAR); bar.x = 0; bar.st = nullptr;
    if (hi_ph - lo > 1) bar = xcd_barrier_post((unsigned*)(ctl + CW_BAR), MISC + 8);
#ifndef P1_REP_SEL
#define P1_REP_SEL 7
#endif
#ifndef REPEAT_MASK
#define REPEAT_MASK 0
#endif
#define NREP(k) (1 + ((REPEAT_MASK >> (k)) & 1))
#ifndef PHASE_MASK
#define PHASE_MASK 0x7ff
#endif
#define IN(k) (((PHASE_MASK >> (k)) & 1) && lo <= (k) && (k) < hi_ph)
#define BOTH(k) (IN(k) && IN((k) + 1))
#define GRID_BAR(k) do { if (BOTH(k)) xcd_barrier(bar); } while (0)
    const int gw = vcu * NWAVES + wave, NGW = G * NWAVES;
    constexpr int I_INA = 64 * 64, I_INB = 64 * 128, I_OUT = 64 * 64, I_CQ = 64 * 8, I_CKV = 64 * 16, I_CO = 8 * 64, I_UP = 64 * 256, I_DN = 256 * 64;
    constexpr int ND = I_OUT + I_CQ + I_CKV + I_CO + I_UP + I_DN;

    if (IN(0)) for (int rep = 0; rep < NREP(0); ++rep) {
        LAS float* scr = (LAS float*)(ldsl + RING_OFF + wave * 16640);
        constexpr int NITEMS = I_INA + I_INB;
        for (int it = gw; it < NITEMS; it += NGW) {
            int r = it;
            if (r < I_INA) { p0_transpose_item(w_in, DMODEL, 4096, ln_mix_g, W_INA_T, 0, scr, r, lane, NPROJ); continue; } r -= I_INA;
            p0_transpose_item_f8(w_in + 4096, DMODEL, 8192, ln_mix_g, 64.f, W_IN8, scr, r, lane, NPROJ, true);
        }
        for (int m = gw; m < MTOK; m += NGW) {
            const GAS f32x4* xr = (const GAS f32x4*)(x + (size_t)m * DMODEL) + lane;
            f32x4 v[16]; float s = 0.f;
#pragma unroll
            for (int j = 0; j < 16; ++j) { v[j] = __builtin_nontemporal_load(xr + 64 * j); s += (v[j].x * v[j].x + v[j].y * v[j].y) + (v[j].z * v[j].z + v[j].w * v[j].w); }
            s = wave_sum(s);
            if (lane == 0) SS0[m] = s;
            GAS v2u* o8 = (GAS v2u*)(XB + (size_t)m * DMODEL) + lane; GAS unsigned* o4 = (GAS unsigned*)(X8 + (size_t)m * DMODEL) + lane;
#pragma unroll
            for (int j = 0; j < 16; ++j) { v2u w; w.x = pk2(v[j].x, v[j].y); w.y = pk2(v[j].z, v[j].w); o8[64 * j] = w; o4[64 * j] = pg8::pk4_fp8(v[j].x, v[j].y, v[j].z, v[j].w); }
        }
        for (int m = gw; m < BATCH * MEMLEN; m += NGW) {
            const GAS f32x4* xr = (const GAS f32x4*)(mem + (size_t)m * DMODEL) + lane;
            const GAS f32x4* gr = (const GAS f32x4*)ln_mem_g + lane;
            f32x4 v[16]; float s = 0.f;
#pragma unroll
            for (int j = 0; j < 16; ++j) { v[j] = xr[64 * j]; s += (v[j].x * v[j].x + v[j].y * v[j].y) + (v[j].z * v[j].z + v[j].w * v[j].w); }
            const float rs = rsqrtf(wave_sum(s) * (1.0f / DMODEL) + 1e-5f);
            GAS unsigned* o4 = (GAS unsigned*)(XB8 + (size_t)(MTOK + m) * DMODEL) + lane;
#pragma unroll
            for (int j = 0; j < 16; ++j) { const f32x4 g = gr[64 * j]; o4[64 * j] = pg8::pk4_fp8(v[j].x * rs * g.x, v[j].y * rs * g.y, v[j].z * rs * g.z, v[j].w * rs * g.w); }
        }
        for (int e = gw * 64 + lane; e < SEQ * 16; e += NGW * 64) {
            const int pos = e >> 4, i = e & 15;
            const double invd = (i == 0) ? 1.0 : (i == 1) ? 0.44036660267178046 : (i == 2) ? 0.19392274474868576 : (i == 3) ? 0.08539710028576561 : (i == 4) ? 0.03760603093086393
                : (i == 5) ? 0.016560440080994446 : (i == 6) ? 0.007292664737217109 : (i == 7) ? 0.003211445994752591 : (i == 8) ? 0.001414213562373095 : (i == 9) ? 0.000622772421914596
                : (i == 10) ? 0.0002742481756762073 : (i == 11) ? 0.00012076973741146504 : (i == 12) ? 5.318295896944988e-05 : (i == 13) ? 2.341999896140934e-05
                : (i == 14) ? 1.031338537721246e-05 : 4.5416704806078695e-06;
            const float ang = (float)pos * (float)invd;
            float co, si; cos_sin_d(ang, co, si);
            ROPE[pos * 32 + i] = co; ROPE[pos * 32 + 16 + i] = si;
        }
        if (rep == NREP(0) - 1) GRID_BAR(0);
    }

    if (IN(1)) {
        { pg8::Gemm g{XB, W_INA_T, MTOK, 4096, DMODEL}; pg8::StaticOrder S; S.init(MTOK, 4096, G, bx);
          pg8::EpiProj E{QKV, SS0, ROPE, 0, 1.f, KMF};
          pg8::gemm_phase<pg8::EpiProj, pg8::StaticOrder, true, true>(ldsl + RING_OFF, g, S, E);
          if (NREP(1) == 2 && (P1_REP_SEL & 1)) pg8::gemm_phase<pg8::EpiProj, pg8::StaticOrder, true, true>(ldsl + RING_OFF, g, S, E); }
        { pg8::Gemm g{(const bf16*)X8, (const bf16*)W_IN8, MTOK, 4096, DMODEL  }; pg8::StaticOrder S; S.init(MTOK, 4096, G, bx);
          pg8::EpiProj E{QKV, SS0, ROPE, 3, 1.0f / 64.0f, KMF};
          pg8::gemm_phase_f8<pg8::EpiProj, pg8::StaticOrder, true, true, false, true>(ldsl + RING_OFF, g, S, E);
          if (NREP(1) == 2 && (P1_REP_SEL & 2)) pg8::gemm_phase_f8<pg8::EpiProj, pg8::StaticOrder, true, true, false, true>(ldsl + RING_OFF, g, S, E); }
        { pg8::Gemm g{(const bf16*)X8, (const bf16*)(W_IN8 + (size_t)4096 * DMODEL), MTOK, 4096, DMODEL}; pg8::StaticOrder S; S.init(MTOK, 4096, G, bx);
          pg8::EpiVT E{(unsigned char*)(QKV + (size_t)2 * 64 * 4096 * 128), (unsigned char*)(QKV + (size_t)5 * 64 * 4096 * 128), SS0, 1.0f / 64.0f};
          pg8::gemm_phase_f8<pg8::EpiVT, pg8::StaticOrder, true, true, false, true>(ldsl + RING_OFF, g, S, E);
          if (NREP(1) == 2 && (P1_REP_SEL & 4)) pg8::gemm_phase_f8<pg8::EpiVT, pg8::StaticOrder, true, true, false, true>(ldsl + RING_OFF, g, S, E); }
        GRID_BAR(1);
    }


    if (IN(3)) {
        float lam;
        { const float s1 = wave_sum(lq1[lane] * lk1[lane] + lq1[lane + 64] * lk1[lane + 64]), s2 = wave_sum(lq2[lane] * lk2[lane] + lq2[lane + 64] * lk2[lane + 64]);
          lam = __expf(s1) - __expf(s2) + 0.2f; lam = __uint_as_float(__builtin_amdgcn_readfirstlane(__float_as_uint(lam))); }
        att::Seam S;
        float* const scrw = SCR + ((size_t)bx * NWAVES + wave) * 8192;
        float* const ssqw = (float*)((char*)lds + RING_OFF + att::LDS_SSQ) + wave * 32;
        constexpr size_t GRP = (size_t)64 * 4096 * 128;
        for (int rep = 0; rep < NREP(3); ++rep) {
#define P3_DEFERRED(it_) do { int r_ = (it_); int lane = (int)(threadIdx.x & 63u); asm volatile("" : "+v"(lane));     \
            LAS float* scr_ = (LAS float*)(ldsl + RING_OFF + wave * 16640);                                             \
            if (r_ < I_OUT) { p0_transpose_item_f8(w_out, DMODEL, DMODEL, nullptr, 64.f, W_OUT8, scr_, r_, lane); break; } r_ -= I_OUT;                          \
            if (r_ < I_CQ) { p0_transpose_item_f8(w_cq, DMODEL, MEMW, ln_cross_g, 64.f, W_CQKV8, scr_, r_, lane); break; } r_ -= I_CQ;                          \
            if (r_ < I_CKV) { p0_transpose_item_f8(w_ckv, DMODEL, 2 * MEMW, nullptr, 64.f, W_CQKV8 + (size_t)MEMW * DMODEL, scr_, r_, lane); break; } r_ -= I_CKV; \
            if (r_ < I_CO) { p0_transpose_item_f8(w_co, MEMW, DMODEL, nullptr, 64.f, (unsigned char*)W_CO_T, scr_, r_, lane); break; } r_ -= I_CO;                                    \
            if (r_ < I_UP) { p0_transpose_item_f8(w_up, DMODEL, DFF, ln_mlp_g, 64.f, W_UP8, scr_, r_, lane); break; } r_ -= I_UP;                              \
            p0_transpose_item_f8(w_down, DFF, DMODEL, nullptr, 128.f, W_DN8, scr_, r_, lane); } while (0)
        int cd = (rep == 0) ? 0 : 100000;
        constexpr int ND_Q = 512, NM_Q = 1024;
        int t = 0, pass = 0, npass = 0;
        for (;;) {
            if (pass == npass) {
                for (int k = 0; k < 4 && cd * NGW < ND; ++k, ++cd) { const int it = cd * NGW + gw; if (it < ND) P3_DEFERRED(it); }
                if (tid == 0) MISC[16] = __hip_atomic_fetch_add(ctl + CW_QUEUE + 64 * rep, 1u, RLX_AGENT);
                __syncthreads();
                t = __builtin_amdgcn_readfirstlane((int)MISC[16]);
#ifdef P3_REP_KIND
                if (rep == 1) { if (P3_REP_KIND == 1 && t >= ND_Q) break; if (P3_REP_KIND == 2) t += ND_Q; }
#endif
                if (t >= ND_Q + NM_Q) break;
                pass = 0; npass = (t < ND_Q) ? 2 : 1;
            }
            att::BlockRef r;
            if (t < ND_Q) {
                const int lvl = t >> 5, idx = t & 31, b = idx >> 3, h = idx & 7, s = pass, qb = 15 - lvl;
                r.Q = (const bf16*)((const unsigned char*)(QKV + 3 * GRP) + ((size_t)(b * 16 + 2 * h + s) * 4096 + qb * 256) * 128);
                r.K = (const bf16*)((const unsigned char*)(QKV + 4 * GRP) + (size_t)(b * 16 + 2 * h + s) * 4096 * 128);
                r.V = (const bf16*)((const unsigned char*)(QKV + 5 * GRP) + (size_t)(b * 16 + 2 * h) * 4096 * 128); r.P0 = qb * 256;
                att::EpiWide E; E.mode = s ? 2 : 1; E.out = MERGED8 + (size_t)(b * 4096 + qb * 256) * 4096 + 2048 + h * 256; E.gain = subln_g; E.scr = scrw; E.lam = lam;
#ifdef P3_WIDE_VAR
                if (rep == 1) { att::EpiNull EN; EN.scr = scrw; att::block_wide<att::EpiNull, P3_WIDE_VAR>(r, r.V + (size_t)4096 * 128, SEQ, (char*)lds + RING_OFF, S, EN); } else
#endif
                att::block_wide8<att::EpiWide>(r, (const bf16*)((const unsigned char*)r.V + (size_t)4096 * 128), SEQ, (char*)lds + RING_OFF, S, E);
            } else {
                const int u = t - ND_Q, lvl = u >> 6, idx = u & 63, b = idx >> 4, h = idx & 15, qb = 15 - lvl;
                r.Q = QKV + ((size_t)(b * 16 + h) * 4096 + qb * 256) * 128; r.K = (const bf16*)((const unsigned char*)(QKV + 1 * GRP) + (size_t)(b * 16 + h) * 4096 * 128);
                r.V = (const bf16*)((const unsigned char*)(QKV + 2 * GRP) + (size_t)(b * 16 + h) * 4096 * 128); r.P0 = qb * 256;
                att::EpiSelf E; E.mode = 0; E.vh = 0; E.out = MERGED8 + (size_t)(b * 4096 + qb * 256) * 4096 + h * 128; E.gain = moba_out_g + h * 128; E.scr = scrw; E.ssq = ssqw; E.lam = lam;
                const float* KMp = KMF + (size_t)(b * 16 + h) * 16 * 128;
                att::prime<true>(r, (char*)lds + RING_OFF, S);
                unsigned sel = 0u;
                if (qb > 0) { int ln_ = (int)(threadIdx.x & 63u); asm volatile("" : "+v"(ln_)); sel = att::moba_select(S, KMp, qb, ln_ & 31, ln_ >> 5); }
                att::q8_from_qr(S);
                att::block<att::EpiSelf, true>(r, SEQ, (char*)lds + RING_OFF, S, true, sel, E);
            }
            ++pass;
        }
        for (; cd * NGW < ND; ++cd) { const int it = cd * NGW + gw; if (it < ND) P3_DEFERRED(it); }
#undef P3_DEFERRED
        }
        GRID_BAR(3);
    }

    if (IN(4)) {
        pg8::Gemm g{(const bf16*)MERGED8, (const bf16*)W_OUT8, MTOK, DMODEL, DMODEL  }; pg8::StaticOrder S; S.init(MTOK, DMODEL, G, bx);
        pg8::EpiRes<false> E{XB, XB, XB8, SS1, 1.0f / 64.0f};
        pg8::gemm_phase_f8<pg8::EpiRes<false>, pg8::StaticOrder, true, true, false, true>(ldsl + RING_OFF, g, S, E);
        if (NREP(4) == 2) { E.ss = SS1 + 3 * 16384; E.sc = 0.f; pg8::gemm_phase_f8<pg8::EpiRes<false>, pg8::StaticOrder, true, true, false, true>(ldsl + RING_OFF, g, S, E); }
        GRID_BAR(4);
    }

    if (IN(5)) {
        pg8::Gemm g{(const bf16*)XB8, (const bf16*)W_CQKV8, MTOK + BATCH * MEMLEN, 3 * MEMW, DMODEL  }; pg8::CrossOrder S{G, bx};
        pg8::EpiCross E{QC, KC, VC, SS1, 1.0f / 64.0f};
        pg8::gemm_phase_f8<pg8::EpiCross, pg8::CrossOrder, true, true, false, true>(ldsl + RING_OFF, g, S, E);
        if (NREP(5) == 2) pg8::gemm_phase_f8<pg8::EpiCross, pg8::CrossOrder, true, true, false, true>(ldsl + RING_OFF, g, S, E);
        GRID_BAR(5);
    }

    if (IN(6)) {
        att::Seam S;
        for (int rep = 0; rep < NREP(6); ++rep)
        for (int u = bx; u < 256; u += G) {
            const int b = u >> 6, hh = (u >> 4) & 3, qb = u & 15;
            att::BlockRef r; r.Q = QC + ((size_t)(b * 4 + hh) * 4096 + qb * 256) * 128; r.K = KC + (size_t)(b * 4 + hh) * 256 * 128; r.V = VC + (size_t)(b * 4 + hh) * 256 * 128; r.P0 = 1 << 20;
            att::EpiMem E{(unsigned char*)OC + (size_t)(b * 4096 + qb * 256) * 512 + hh * 128};
            att::prime(r, (char*)lds + RING_OFF, S);
            att::block<att::EpiMem>(r, MEMLEN, (char*)lds + RING_OFF, S, false, 0u, E);
        }
        GRID_BAR(6);
    }

    if (IN(7)) {
        pg8::Gemm g{OC, W_CO_T, MTOK, DMODEL, MEMW  }; pg8::StaticOrder S; S.init(MTOK, DMODEL, G, bx);
        pg8::EpiRes<false> E{XB, XB, XB8, SS2, 1.0f / 1024.0f};
        pg8::gemm_phase_f8<pg8::EpiRes<false>, pg8::StaticOrder, true, true, false, true>(ldsl + RING_OFF, g, S, E);
        if (NREP(7) == 2) { E.ss = SS1 + 3 * 16384; E.sc = 0.f; pg8::gemm_phase_f8<pg8::EpiRes<false>, pg8::StaticOrder, true, true, false, true>(ldsl + RING_OFF, g, S, E); }
        GRID_BAR(7);
    }

    if (IN(8)) {
        pg8::Gemm g{(const bf16*)XB8, (const bf16*)W_UP8, MTOK, DFF, DMODEL  }; pg8::StaticOrder S; S.init(MTOK, DFF, G, bx);
        pg8::EpiUp8 E{U8, SS2};
        pg8::gemm_phase_f8<pg8::EpiUp8, pg8::StaticOrder, true, true, false, true>(ldsl + RING_OFF, g, S, E);
        if (NREP(8) == 2) pg8::gemm_phase_f8<pg8::EpiUp8, pg8::StaticOrder, true, true, false, true>(ldsl + RING_OFF, g, S, E);
        GRID_BAR(8);
    }

    if (IN(9)) {
        pg8::Gemm g{(const bf16*)U8, (const bf16*)W_DN8, MTOK, DMODEL, DFF  }; pg8::StaticOrder S; S.init(MTOK, DMODEL, G, bx);
        pg8::EpiRes<false> E{XB, XB, nullptr, SS3, 1.0f / 512.0f};
        pg8::gemm_phase_f8<pg8::EpiRes<false>, pg8::StaticOrder, true, true, true, true>(ldsl + RING_OFF, g, S, E);
        if (NREP(9) == 2) { E.ss = SS1 + 3 * 16384; E.sc = 0.f; pg8::gemm_phase_f8<pg8::EpiRes<false>, pg8::StaticOrder, true, true, true, true>(ldsl + RING_OFF, g, S, E); }
        GRID_BAR(9);
    }

    if (IN(10)) {
        const GAS f32x4* gr = (const GAS f32x4*)final_g + 2 * lane;
        for (int m = gw; m < MTOK; m += NGW) {
            const GAS v4u* xr = (const GAS v4u*)(XB + (size_t)m * DMODEL) + lane;
            GAS f32x4* orow = (GAS f32x4*)(out + (size_t)m * DMODEL) + 2 * lane;
            const float rs = rsqrtf(__hip_atomic_load(SS3 + m, __ATOMIC_RELAXED, __HIP_MEMORY_SCOPE_AGENT) * (1.0f / DMODEL) + 1e-5f);
#pragma unroll
            for (int j = 0; j < 8; ++j) { const v4u w = __builtin_nontemporal_load(xr + 64 * j); const f32x4 g0 = gr[128 * j], g1 = gr[128 * j + 1];
                const f32x4 a0 = {__uint_as_float(w.x << 16), __uint_as_float(w.x & 0xffff0000u), __uint_as_float(w.y << 16), __uint_as_float(w.y & 0xffff0000u)};
                const f32x4 a1 = {__uint_as_float(w.z << 16), __uint_as_float(w.z & 0xffff0000u), __uint_as_float(w.w << 16), __uint_as_float(w.w & 0xffff0000u)};
                __builtin_nontemporal_store(a0 * rs * g0, orow + 128 * j); __builtin_nontemporal_store(a1 * rs * g1, orow + 128 * j + 1); }
        }
    }
#undef IN
#undef BOTH
#undef GRID_BAR
}

extern "C" void kernel_launch(void* const* d_in, const int* in_sizes, int n_in, void* d_out, int out_size, void* d_ws, size_t ws_size, hipStream_t stream) {
    static int grid = 0;
    if (grid == 0) {
        if (n_in != 20 || in_sizes[0] != MTOK * DMODEL || out_size != MTOK * DMODEL || ws_size < WS_END) {
            fprintf(stderr, "kernel_launch: built for 20 inputs, x/out of %d floats, >= %zu bytes of workspace; got n_in %d, in0 %d, out %d, ws %zu; nothing launched\n", MTOK * DMODEL, (size_t)WS_END, n_in, n_in > 0 ? in_sizes[0] : -1, out_size, ws_size);
            grid = -1; return; }
        int dev = 0, cus = 0, per_cu = 0;
        if (hipGetDevice(&dev) != hipSuccess || hipDeviceGetAttribute(&cus, hipDeviceAttributeMultiprocessorCount, dev) != hipSuccess) { fprintf(stderr, "kernel_launch: device query failed\n"); grid = -1; return; }
        if (hipFuncSetAttribute((const void*)mk_fwd, hipFuncAttributeMaxDynamicSharedMemorySize, LDS_BYTES) != hipSuccess) { fprintf(stderr, "kernel_launch: hipFuncSetAttribute failed\n"); grid = -1; return; }
        if (hipOccupancyMaxActiveBlocksPerMultiprocessor(&per_cu, (const void*)mk_fwd, NWAVES * 64, LDS_BYTES) != hipSuccess || per_cu < 1)
            fprintf(stderr, "kernel_launch: note: the occupancy query reports %d workgroups per CU\n", per_cu);
        (void)hipGetLastError();
        grid = cus;
    }
    if (grid < 0) return;
    if (hipMemsetAsync((char*)d_ws + WS_CTL, 0, CTL_ZERO_BYTES, stream) != hipSuccess) { fprintf(stderr, "kernel_launch: hipMemsetAsync failed\n"); return; }
    Args a{};
    for (int i = 0; i < 20; ++i) a.in[i] = (const float*)d_in[i];
    a.out = (float*)d_out; a.ws = (unsigned char*)d_ws;
    for (int li = 0; li < N_LAUNCHES; ++li) {
        a.ph_lo = (N_LAUNCHES == 1) ? 0 : li; a.ph_hi = (N_LAUNCHES == 1) ? NPHASE : li + 1;
        hipLaunchKernelGGL(mk_fwd, dim3(grid), dim3(NWAVES * 64), LDS_BYTES, stream, a);
        const hipError_t le = hipPeekAtLastError();
        if (le != hipSuccess) { fprintf(stderr, "kernel_launch: launch %d failed: %s\n", li, hipGetErrorName(le)); break; }
    }
}
```

```cpp
#include <hip/hip_runtime.h>
#include <cstdio>
#include <cstdint>
namespace pg8 {
#define PG8_LAS __attribute__((address_space(3)))
typedef unsigned short bf16_t;
typedef short bf16x8 __attribute__((ext_vector_type(8)));
typedef float f32x4 __attribute__((ext_vector_type(4)));
typedef unsigned u32x4 __attribute__((ext_vector_type(4)));
constexpr int BM = 256, BK = 64, HALF = 128, HTB = HALF * BK * 2  , STAGE_BYTES = 8 * HTB, NXCD = 8, WGM = 8;

__host__ __device__ __forceinline__ int lds_byte(int r, int c) { const int st = (r >> 4) * 2 + (c >> 5), rr = r & 15, cc = c & 31, ob = rr * 64 + cc * 2; return st * 1024 + (ob ^ (((ob >> 9) & 1) << 5)); }
__host__ __device__ __forceinline__ void stage_rc(int b, int& R, int& C) { const int st = b / 1024, sb = b % 1024, swz = sb ^ (((sb >> 9) & 1) << 5); R = (st >> 1) * 16 + swz / 64; C = (st & 1) * 32 + (swz % 64) / 2; }
__host__ __device__ __forceinline__ int perm32(int rho) { const int n = rho >> 4, i = rho & 15; return 8 * (i >> 2) + 4 * n + (i & 3); }

struct Unit { int pm, pn; };
struct Gemm { const bf16_t* A; const bf16_t* Bt; int M, N, K; };

struct StaticOrder {
    int nM, nN, nwg, G, c;
    __host__ __device__ void init(int M, int N, int G_, int c_) { nM = M / BM; nN = N / BM; nwg = nM * nN; G = G_; c = c_; }
    __host__ __device__ bool next(int i, Unit& u) const {
        const long L = (long)i * G + c; if (L >= nwg) return false;
        int wgid = (int)L; { const int q = nwg / NXCD, r = nwg % NXCD, xcd = wgid % NXCD, off = wgid / NXCD; wgid = (xcd < r ? xcd * (q + 1) : r * (q + 1) + (xcd - r) * q) + off; }
        const int nig = WGM * nN, gid = wgid / nig, fm = gid * WGM, gsz = (nM - fm) < WGM ? (nM - fm) : WGM;
        u.pm = fm + ((wgid % nig) % gsz); u.pn = (wgid % nig) / gsz; return true;
    }
    __device__ __forceinline__ void a_ready(const Unit&) const {}
    __device__ __forceinline__ void done(const Unit&) const {}
};

__device__ __forceinline__ unsigned cvt_pk_bf16(float lo, float hi) { unsigned r; asm volatile("v_cvt_pk_bf16_f32 %0, %1, %2" : "=v"(r) : "v"(lo), "v"(hi)); return r; }
typedef unsigned u32x2 __attribute__((ext_vector_type(2)));
constexpr float RMS_EPS = 1e-5f;
constexpr int DM = 4096;
__device__ __forceinline__ void rope4(f32x4& v, const f32x4& c, const f32x4& s, int fq) {
#pragma unroll
    for (int j = 0; j < 4; ++j) {
        auto rr = __builtin_amdgcn_permlane32_swap(__float_as_uint(v[j]), __float_as_uint(v[j]), false, false);
        const float x1 = __uint_as_float(rr[0]), x2 = __uint_as_float(rr[1]);
        v[j] = (fq < 2) ? (x1 * c[j] - x2 * s[j]) : (x2 * c[j] + x1 * s[j]);
    }
}
typedef int i32x8 __attribute__((ext_vector_type(8)));
typedef short s16x16 __attribute__((ext_vector_type(16)));
__device__ __forceinline__ unsigned pk4_fp8(float a, float b, float c, float d) {
    a = fminf(fmaxf(a, -448.f), 448.f); b = fminf(fmaxf(b, -448.f), 448.f); c = fminf(fmaxf(c, -448.f), 448.f); d = fminf(fmaxf(d, -448.f), 448.f);
    int w = 0; w = __builtin_amdgcn_cvt_pk_fp8_f32(a, b, w, false); w = __builtin_amdgcn_cvt_pk_fp8_f32(c, d, w, true); return (unsigned)w;
}
struct EpiProj {
    static constexpr bool PERM = true, AFTER_DRAIN = false;
    bf16_t* QKV; const float* ss; const float* cs; int g0; float sc; float* kmf;
    __device__ __forceinline__ void operator()(const f32x4 (&acc)[2][2][4][2], const Unit& u, int wr, int wc, int fr, int fq) const {
        const int g = g0 + (u.pn >> 3), b = u.pm >> 4;
        const bool rope = (wc == 0) && (g != 2) && (g != 5);
        f32x4 ksum[2][2] = {{{0.f, 0.f, 0.f, 0.f}, {0.f, 0.f, 0.f, 0.f}}, {{0.f, 0.f, 0.f, 0.f}, {0.f, 0.f, 0.f, 0.f}}};
#pragma unroll
        for (int ai = 0; ai < 2; ++ai)
#pragma unroll
            for (int m = 0; m < 4; ++m) {
                const int rit = ai * HALF + wr * 64 + m * 16 + fr, s = (u.pm & 15) * 256 + rit, grow = u.pm * 256 + rit;
                const float rs = rsqrtf(ss[grow] * (1.0f / 4096.0f) + RMS_EPS) * sc;
                f32x4 c0 = {1.f, 1.f, 1.f, 1.f}, c1 = c0, s0 = {0.f, 0.f, 0.f, 0.f}, s1 = s0;
                if (rope) { const float* t = cs + (size_t)s * 32 + 8 * (fq & 1); c0 = *(const f32x4*)t; c1 = *(const f32x4*)(t + 4); s0 = *(const f32x4*)(t + 16); s1 = *(const f32x4*)(t + 20); }
#pragma unroll
                for (int bj = 0; bj < 2; ++bj) {
                    f32x4 v0 = acc[ai][bj][m][0] * rs, v1 = acc[ai][bj][m][1] * rs;
                    if (rope) { rope4(v0, c0, s0, fq); rope4(v1, c1, s1, fq); }
                    const int head = (u.pn & 7) * 2 + bj;
                    bf16_t* dst = QKV + ((((size_t)(g * 4 + b) * 16 + head) * 4096 + s) * 128 + wc * 32 + 8 * fq);
                    if (g == 1) {
                        unsigned char* d8 = (unsigned char*)(QKV + (size_t)g * 4 * 16 * 4096 * 128) + ((((size_t)b * 16 + head) * 4096 + s) * 128 + (wc >> 1) * 64 + (fq & 1) * 32 + ((wc & 1) * 2 + (fq >> 1)) * 8);
                        u32x2 w8; w8.x = pk4_fp8(v0[0] * 16.f, v0[1] * 16.f, v0[2] * 16.f, v0[3] * 16.f); w8.y = pk4_fp8(v1[0] * 16.f, v1[1] * 16.f, v1[2] * 16.f, v1[3] * 16.f);
                        *(u32x2*)d8 = w8;
                    } else if (g == 3 || g == 4) {
                        unsigned char* d8 = (unsigned char*)(QKV + (size_t)g * 4 * 16 * 4096 * 128) + ((((size_t)b * 16 + head) * 4096 + s) * 128 + wc * 32 + 8 * fq);
                        u32x2 w8; w8.x = pk4_fp8(v0[0] * 16.f, v0[1] * 16.f, v0[2] * 16.f, v0[3] * 16.f); w8.y = pk4_fp8(v1[0] * 16.f, v1[1] * 16.f, v1[2] * 16.f, v1[3] * 16.f);
                        *(u32x2*)d8 = w8;
                    } else {
                    u32x4 w; w.x = cvt_pk_bf16(v0[0], v0[1]); w.y = cvt_pk_bf16(v0[2], v0[3]); w.z = cvt_pk_bf16(v1[0], v1[1]); w.w = cvt_pk_bf16(v1[2], v1[3]);
                    *(u32x4*)dst = w; }
                    if (g == 1) { ksum[bj][0] += v0; ksum[bj][1] += v1; }
                }
            }
        if (g == 1) {
#pragma unroll
            for (int bj = 0; bj < 2; ++bj)
#pragma unroll
                for (int n = 0; n < 2; ++n)
#pragma unroll
                    for (int j = 0; j < 4; ++j) { float t = ksum[bj][n][j]; t += __shfl_xor(t, 1); t += __shfl_xor(t, 2); t += __shfl_xor(t, 4); t += __shfl_xor(t, 8);
                        if (fr == 0) unsafeAtomicAdd(kmf + (((size_t)(b * 16 + (u.pn & 7) * 2 + bj) * 16 + (u.pm & 15)) * 128 + wc * 32 + 8 * fq + 4 * n + j), t); }
        }
    }
};
struct EpiVT {
    static constexpr bool PERM = true, AFTER_DRAIN = false;
    unsigned char* VT; const float* ss; float sc;
    __device__ __forceinline__ void operator()(const f32x4 (&acc)[2][2][4][2], const Unit& u, int wr, int wc, int fr, int fq) const {
        const int b = u.pm >> 4;
#pragma unroll
        for (int ai = 0; ai < 2; ++ai) { float rs4[4];
#pragma unroll
            for (int m = 0; m < 4; ++m) rs4[m] = rsqrtf(ss[u.pm * 256 + ai * HALF + wr * 64 + m * 16 + fr] * (1.0f / 4096.0f) + RMS_EPS) * (sc * 16.f);
            const int T = (u.pm & 15) * 4 + ai * 2 + wr;
#pragma unroll
            for (int bj = 0; bj < 2; ++bj) { const int head = u.pn * 2 + bj;
                unsigned char* base = VT + (((size_t)b * 16 + head) * 64 + T) * 8192 + (wc * 32 + 8 * fq) * 64 + 32 * (fr >> 3) + 4 * (fr & 7);
#pragma unroll
                for (int n = 0; n < 2; ++n)
#pragma unroll
                    for (int jj = 0; jj < 4; ++jj)
                        *(unsigned*)(base + (4 * n + jj) * 64) = pk4_fp8(acc[ai][bj][0][n][jj] * rs4[0], acc[ai][bj][1][n][jj] * rs4[1], acc[ai][bj][2][n][jj] * rs4[2], acc[ai][bj][3][n][jj] * rs4[3]); } }
    }
};
struct EpiResid {
    static constexpr bool PERM = false, AFTER_DRAIN = false;
    const float* xin; float* xout; bf16_t* xb; unsigned char* x8; float* ss; float sc;
    __device__ __forceinline__ void operator()(const f32x4 (&acc)[2][2][4][2], const Unit& u, int wr, int wc, int fr, int fq) const {
        const int row0 = u.pm * BM + wr * 64 + fr, col0 = u.pn * BM + wc * 32 + 4 * fq;
#pragma unroll
        for (int ai = 0; ai < 2; ++ai)
#pragma unroll
            for (int m = 0; m < 4; ++m) {
                const int row = row0 + ai * HALF + m * 16; const size_t off = (size_t)row * DM + col0; float q = 0.f;
#pragma unroll
                for (int bj = 0; bj < 2; ++bj)
#pragma unroll
                    for (int n = 0; n < 2; ++n) { const size_t o2 = off + bj * HALF + n * 16;
                        const f32x4 v = *(const f32x4*)(xin + o2) + acc[ai][bj][m][n] * sc; *(f32x4*)(xout + o2) = v;
                        q += (v[0] * v[0] + v[1] * v[1]) + (v[2] * v[2] + v[3] * v[3]);
                        if (xb) { u32x2 w; w.x = cvt_pk_bf16(v[0], v[1]); w.y = cvt_pk_bf16(v[2], v[3]); *(u32x2*)(xb + o2) = w; }
                        if (x8) *(unsigned*)(x8 + o2) = pk4_fp8(v[0], v[1], v[2], v[3]); }
                q += __shfl_xor(q, 16); q += __shfl_xor(q, 32);
                if (fq == 0) unsafeAtomicAdd(ss + row, q);
                asm volatile("" ::: "memory");
            }
    }
};
template <bool XF32> struct EpiRes {
    static constexpr bool PERM = true, AFTER_DRAIN = false;
    const void* xin; bf16_t* xb; unsigned char* x8; float* ss; float sc;
    __device__ __forceinline__ void operator()(const f32x4 (&acc)[2][2][4][2], const Unit& u, int wr, int wc, int fr, int fq) const {
        const int row0 = u.pm * BM + wr * 64 + fr, col0 = u.pn * BM + wc * 32 + 8 * fq;
#pragma unroll
        for (int ai = 0; ai < 2; ++ai) {
            f32x4 a[4][2][2];
#pragma unroll
            for (int m = 0; m < 4; ++m)
#pragma unroll
                for (int bj = 0; bj < 2; ++bj) { const size_t o2 = (size_t)(row0 + ai * HALF + m * 16) * DM + col0 + bj * HALF;
                    if constexpr (XF32) { a[m][bj][0] = *(const f32x4*)((const float*)xin + o2); a[m][bj][1] = *(const f32x4*)((const float*)xin + o2 + 4); }
                    else { const u32x4 w = *(const u32x4*)((const bf16_t*)xin + o2); a[m][bj][0] = __builtin_bit_cast(f32x4, w); } }
#pragma unroll
            for (int m = 0; m < 4; ++m) {
                const int row = row0 + ai * HALF + m * 16; const size_t off = (size_t)row * DM + col0; float q = 0.f;
#pragma unroll
                for (int bj = 0; bj < 2; ++bj) { const size_t o2 = off + bj * HALF;
                    f32x4 a0, a1;
                    if constexpr (XF32) { a0 = a[m][bj][0]; a1 = a[m][bj][1]; }
                    else { const u32x4 w = __builtin_bit_cast(u32x4, a[m][bj][0]);
                        a0 = (f32x4){__uint_as_float(w.x << 16), __uint_as_float(w.x & 0xffff0000u), __uint_as_float(w.y << 16), __uint_as_float(w.y & 0xffff0000u)};
                        a1 = (f32x4){__uint_as_float(w.z << 16), __uint_as_float(w.z & 0xffff0000u), __uint_as_float(w.w << 16), __uint_as_float(w.w & 0xffff0000u)}; }
                    const f32x4 v0 = a0 + acc[ai][bj][m][0] * sc, v1 = a1 + acc[ai][bj][m][1] * sc;
                    q += ((v0[0] * v0[0] + v0[1] * v0[1]) + (v0[2] * v0[2] + v0[3] * v0[3])) + ((v1[0] * v1[0] + v1[1] * v1[1]) + (v1[2] * v1[2] + v1[3] * v1[3]));
                    u32x4 wo; wo.x = cvt_pk_bf16(v0[0], v0[1]); wo.y = cvt_pk_bf16(v0[2], v0[3]); wo.z = cvt_pk_bf16(v1[0], v1[1]); wo.w = cvt_pk_bf16(v1[2], v1[3]);
                    *(u32x4*)(xb + o2) = wo;
                    if (x8) { u32x2 w8; w8.x = pk4_fp8(v0[0], v0[1], v0[2], v0[3]); w8.y = pk4_fp8(v1[0], v1[1], v1[2], v1[3]); *(u32x2*)(x8 + o2) = w8; } }
                q += __shfl_xor(q, 16); q += __shfl_xor(q, 32);
                if (fq == 0) unsafeAtomicAdd(ss + row, q);
            }
            asm volatile("" ::: "memory");
        }
    }
};
struct EpiCross {
    static constexpr bool PERM = true, AFTER_DRAIN = false;
    bf16_t* QC; bf16_t* KC; bf16_t* VC; const float* ss; float sc;
    __device__ __forceinline__ void operator()(const f32x4 (&acc)[2][2][4][2], const Unit& u, int wr, int wc, int fr, int fq) const {
        const bool isq = u.pm < 64;
#pragma unroll
        for (int ai = 0; ai < 2; ++ai)
#pragma unroll
            for (int m = 0; m < 4; ++m) {
                const int rit = ai * HALF + wr * 64 + m * 16 + fr;
                float rs = sc; if (isq) rs = rsqrtf(ss[u.pm * 256 + rit] * (1.0f / 4096.0f) + RMS_EPS) * sc;
#pragma unroll
                for (int bj = 0; bj < 2; ++bj) {
                    const f32x4 v0 = acc[ai][bj][m][0] * rs, v1 = acc[ai][bj][m][1] * rs;
                    bf16_t* dst;
                    if (isq) { const int b = u.pm >> 4, s = (u.pm & 15) * 256 + rit, head = 2 * u.pn + bj; dst = QC + (((size_t)(b * 4 + head) * 4096 + s) * 128 + wc * 32 + 8 * fq); }
                    else { const int b = u.pm - 64, cp = 256 * (u.pn - 2) + 128 * bj, head = (cp & 511) >> 7; dst = ((cp >= 512) ? VC : KC) + (((size_t)(b * 4 + head) * 256 + rit) * 128 + wc * 32 + 8 * fq); }
                    u32x4 w; w.x = cvt_pk_bf16(v0[0], v0[1]); w.y = cvt_pk_bf16(v0[2], v0[3]); w.z = cvt_pk_bf16(v1[0], v1[1]); w.w = cvt_pk_bf16(v1[2], v1[3]);
                    *(u32x4*)dst = w;
                }
            }
    }
};
struct CrossOrder {
    int G, c;
    __device__ __forceinline__ bool next(int i, Unit& u) const { const int L = i * G + c; if (L >= 144) return false;
        if (L < 128) { u.pm = L & 63; u.pn = L >> 6; } else { const int j = L - 128; u.pm = 64 + (j >> 2); u.pn = 2 + (j & 3); } return true; }
    __device__ __forceinline__ void a_ready(const Unit&) const {}
    __device__ __forceinline__ void done(const Unit&) const {}
};
struct EpiUp {
    static constexpr bool PERM = true, AFTER_DRAIN = false;
    bf16_t* U; const float* ss;
    __device__ __forceinline__ void operator()(const f32x4 (&acc)[2][2][4][2], const Unit& u, int wr, int wc, int fr, int fq) const {
        const int row0 = u.pm * BM + wr * 64 + fr, col0 = u.pn * BM + wc * 32 + 8 * fq;
#pragma unroll
        for (int ai = 0; ai < 2; ++ai)
#pragma unroll
            for (int m = 0; m < 4; ++m) {
                const int row = row0 + ai * HALF + m * 16;
                const float rs = rsqrtf(ss[row] * (1.0f / 4096.0f) + RMS_EPS);
                bf16_t* rowp = U + (size_t)row * 16384 + col0;
#pragma unroll
                for (int bj = 0; bj < 2; ++bj) {
                    f32x4 v0 = acc[ai][bj][m][0] * rs, v1 = acc[ai][bj][m][1] * rs;
#pragma unroll
                    for (int j = 0; j < 4; ++j) { const float a = fmaxf(v0[j], 0.f), b = fmaxf(v1[j], 0.f); v0[j] = a * a; v1[j] = b * b; }
                    u32x4 w; w.x = cvt_pk_bf16(v0[0], v0[1]); w.y = cvt_pk_bf16(v0[2], v0[3]); w.z = cvt_pk_bf16(v1[0], v1[1]); w.w = cvt_pk_bf16(v1[2], v1[3]);
                    *(u32x4*)(rowp + bj * HALF) = w;
                }
            }
    }
};

struct EpiUp8 {
    static constexpr bool PERM = true, AFTER_DRAIN = false;
    unsigned char* U; const float* ss;
    __device__ __forceinline__ void operator()(const f32x4 (&acc)[2][2][4][2], const Unit& u, int wr, int wc, int fr, int fq) const {
        const int row0 = u.pm * BM + wr * 64 + fr, col0 = u.pn * BM + wc * 32 + 8 * fq;
#pragma unroll
        for (int ai = 0; ai < 2; ++ai)
#pragma unroll
            for (int m = 0; m < 4; ++m) {
                const int row = row0 + ai * HALF + m * 16;
                const float rs = rsqrtf(ss[row] * (1.0f / 4096.0f) + RMS_EPS) * (1.0f / 64.0f);
                unsigned char* rowp = U + ((size_t)(row >> 4) * 512 + (col0 >> 5)) * 512 + (row & 15) * 32 + (col0 & 31);
#pragma unroll
                for (int bj = 0; bj < 2; ++bj) {
                    f32x4 v0 = acc[ai][bj][m][0] * rs, v1 = acc[ai][bj][m][1] * rs;
#pragma unroll
                    for (int j = 0; j < 4; ++j) { const float a = fmaxf(v0[j], 0.f), b = fmaxf(v1[j], 0.f); v0[j] = a * a * 4.f; v1[j] = b * b * 4.f; }
                    u32x2 w; w.x = pk4_fp8(v0[0], v0[1], v0[2], v0[3]); w.y = pk4_fp8(v1[0], v1[1], v1[2], v1[3]);
                    *(u32x2*)(rowp + bj * (HALF / 32) * 512) = w;
                }
            }
    }
};

template <class Epi, class Sched, bool ALIGN_EPI = false, bool SP2 = false>
__device__ __forceinline__ void gemm_phase(PG8_LAS unsigned char* lds, const Gemm g, const Sched& S, const Epi& E) {
    int tid = threadIdx.x; asm volatile("" : "+v"(tid));
    const int wid = __builtin_amdgcn_readfirstlane(tid >> 6), lane = tid & 63, wr = wid >> 2, wc = wid & 3, fr = lane & 15, fq = lane >> 4;
    const int K = g.K, nt = K / BK;
    unsigned voffA[2], voffB[2];
#pragma unroll
    for (int i = 0; i < 2; ++i) { int R, C; stage_rc(tid * 16 + i * 8192, R, C); const int Rb = Epi::PERM ? ((R & ~31) + perm32(R & 31)) : R;
        voffA[i] = (unsigned)(R * K + C) * 2u; voffB[i] = (unsigned)(Rb * K + C) * 2u; }
    const size_t kstep = (size_t)(BK * 2);
    const size_t hstep = (size_t)HALF * K * 2;
    const size_t tstep = 2 * hstep;
    const unsigned ldsw = (unsigned)wid * 1024u;
    const int aoff = lds_byte(wr * 64 + fr, fq * 8), boff = lds_byte(wc * 32 + fr, fq * 8);
#define PG8_SA(b, h) (((b) * 2 + (h)) * HTB)
#define PG8_SB(b, h) ((4 + (b) * 2 + (h)) * HTB)
#define PG8_STAGE(bufoff, gbase, voff) do { _Pragma("unroll") for (int _i = 0; _i < 2; ++_i) \
        __builtin_amdgcn_global_load_lds((const unsigned*)((const char*)(gbase) + (voff)[_i]), (PG8_LAS unsigned*)(lds + (bufoff) + ldsw + _i * 8192), 16, 0, 0); } while (0)
#define PG8_LDA(dst, b, h) do { _Pragma("unroll") for (int m = 0; m < 4; ++m) _Pragma("unroll") for (int k = 0; k < 2; ++k) dst[m][k] = *(const PG8_LAS bf16x8*)(lds + PG8_SA(b, h) + aoff + m * 2048 + k * 1024); } while (0)
#define PG8_LDB(dst, b, h) do { _Pragma("unroll") for (int n = 0; n < 2; ++n) _Pragma("unroll") for (int k = 0; k < 2; ++k) dst[n][k] = *(const PG8_LAS bf16x8*)(lds + PG8_SB(b, h) + boff + n * 2048 + k * 1024); } while (0)
#define PG8_MMA(ai, bj, At, Bt) do { __builtin_amdgcn_s_setprio(1); _Pragma("unroll") for (int m = 0; m < 4; ++m) _Pragma("unroll") for (int n = 0; n < 2; ++n) _Pragma("unroll") for (int k = 0; k < 2; ++k) \
        acc[ai][bj][m][n] = __builtin_amdgcn_mfma_f32_16x16x32_bf16(Bt[n][k], At[m][k], acc[ai][bj][m][n], 0, 0, 0); __builtin_amdgcn_s_setprio(0); } while (0)
#define PG8_WAIT_V(n) asm volatile("s_waitcnt vmcnt(" #n ")" ::: "memory")
#define PG8_WAIT_L(n) asm volatile("s_waitcnt lgkmcnt(" #n ")" ::: "memory")
#define PG8_BAR __builtin_amdgcn_s_barrier()
#define PG8_SCHED __builtin_amdgcn_sched_barrier(0)
    Unit cur, nxt; int ui = 0;
    if (!S.next(0, cur)) return;
    f32x4 acc[2][2][4][2];
#pragma unroll
    for (int a = 0; a < 2; ++a)
#pragma unroll
        for (int b = 0; b < 2; ++b)
#pragma unroll
            for (int m = 0; m < 4; ++m)
#pragma unroll
                for (int n = 0; n < 2; ++n) acc[a][b][m][n] = (f32x4){0.f, 0.f, 0.f, 0.f};
    bf16x8 At[4][2], B0[2][2], B1[2][2];
    const char* cA = (const char*)g.A + (size_t)cur.pm * tstep; const char* cB = (const char*)g.Bt + (size_t)cur.pn * tstep;
    S.a_ready(cur);
    if constexpr (SP2) {
        PG8_STAGE(PG8_SB(0, 0), cB, voffB); PG8_STAGE(PG8_SB(0, 1), cB + hstep, voffB); PG8_STAGE(PG8_SA(0, 0), cA, voffA); PG8_STAGE(PG8_SA(0, 1), cA + hstep, voffA);
        if (wr == 1) PG8_BAR;
        PG8_WAIT_V(2); PG8_BAR;
        PG8_STAGE(PG8_SB(1, 0), cB + kstep, voffB); PG8_STAGE(PG8_SA(1, 0), cA + kstep, voffA); PG8_STAGE(PG8_SB(1, 1), cB + hstep + kstep, voffB);
        PG8_WAIT_V(6); PG8_BAR;
    } else {
        PG8_STAGE(PG8_SB(0, 0), cB, voffB); PG8_STAGE(PG8_SA(0, 0), cA, voffA); PG8_STAGE(PG8_SB(0, 1), cB + hstep, voffB); PG8_STAGE(PG8_SA(0, 1), cA + hstep, voffA);
        if (wr == 1) PG8_BAR;
        PG8_WAIT_V(4); PG8_BAR;
        PG8_STAGE(PG8_SB(1, 0), cB + kstep, voffB); PG8_STAGE(PG8_SA(1, 0), cA + kstep, voffA); PG8_STAGE(PG8_SB(1, 1), cB + hstep + kstep, voffB);
        PG8_WAIT_V(6); PG8_BAR;
    }
    for (;;) {
        const bool has_next = S.next(ui + 1, nxt);
        const char* nA = has_next ? (const char*)g.A + (size_t)nxt.pm * tstep : cA; const char* nB = has_next ? (const char*)g.Bt + (size_t)nxt.pn * tstep : cB;
        for (int t = 0; t < nt; t += 2) {
            const bool last = (t == nt - 2);
            const char* a1 = cA + (size_t)(t + 1) * kstep;
            const char* a2 = last ? nA : cA + (size_t)(t + 2) * kstep; const char* b2 = last ? nB : cB + (size_t)(t + 2) * kstep;
            const char* a3 = a2 + kstep; const char* b3 = b2 + kstep;
            if (last && has_next) S.a_ready(nxt);
            if constexpr (SP2) {
            PG8_LDB(B0, 0, 0); PG8_LDB(B1, 0, 1); PG8_SCHED; PG8_LDA(At, 0, 0); PG8_STAGE(PG8_SA(1, 1), a1 + hstep, voffA);
            PG8_WAIT_V(8); PG8_WAIT_L(0); PG8_BAR; PG8_MMA(0, 0, At, B0); PG8_MMA(0, 1, At, B1); PG8_BAR; PG8_SCHED;
            PG8_LDA(At, 0, 1); PG8_STAGE(PG8_SB(0, 0), b2, voffB); PG8_STAGE(PG8_SB(0, 1), b2 + hstep, voffB); PG8_STAGE(PG8_SA(0, 0), a2, voffA);
            PG8_WAIT_V(8); PG8_WAIT_L(0); PG8_BAR; PG8_MMA(1, 0, At, B0); PG8_MMA(1, 1, At, B1); PG8_BAR; PG8_SCHED;
            PG8_LDB(B0, 1, 0); PG8_LDB(B1, 1, 1); PG8_SCHED; PG8_LDA(At, 1, 0); PG8_STAGE(PG8_SA(0, 1), a2 + hstep, voffA);
            PG8_WAIT_V(8); PG8_WAIT_L(0); PG8_BAR; PG8_MMA(0, 0, At, B0); PG8_MMA(0, 1, At, B1); PG8_BAR; PG8_SCHED;
            PG8_LDA(At, 1, 1); PG8_STAGE(PG8_SB(1, 0), b3, voffB); PG8_STAGE(PG8_SB(1, 1), b3 + hstep, voffB); PG8_STAGE(PG8_SA(1, 0), a3, voffA);
            PG8_WAIT_V(8); PG8_WAIT_L(0); PG8_BAR; PG8_MMA(1, 0, At, B0); PG8_MMA(1, 1, At, B1); PG8_BAR; PG8_SCHED;
            } else {
            PG8_LDB(B0, 0, 0); PG8_SCHED; PG8_LDA(At, 0, 0); PG8_STAGE(PG8_SA(1, 1), a1 + hstep, voffA);
            PG8_WAIT_L(8); PG8_BAR; PG8_WAIT_L(0); PG8_MMA(0, 0, At, B0); PG8_BAR; PG8_SCHED;
            PG8_LDB(B1, 0, 1); PG8_STAGE(PG8_SB(0, 0), b2, voffB);
            PG8_BAR; PG8_WAIT_L(0); PG8_MMA(0, 1, At, B1); PG8_BAR;
            PG8_LDA(At, 0, 1); PG8_STAGE(PG8_SA(0, 0), a2, voffA);
            PG8_BAR; PG8_WAIT_L(0); PG8_MMA(1, 0, At, B0); PG8_BAR; PG8_SCHED;
            PG8_STAGE(PG8_SB(0, 1), b2 + hstep, voffB);
            PG8_WAIT_V(6); PG8_BAR; PG8_MMA(1, 1, At, B1); PG8_BAR;
            PG8_LDB(B0, 1, 0); PG8_SCHED; PG8_LDA(At, 1, 0); PG8_STAGE(PG8_SA(0, 1), a2 + hstep, voffA);
            PG8_WAIT_L(8); PG8_BAR; PG8_WAIT_L(0); PG8_MMA(0, 0, At, B0); PG8_BAR; PG8_SCHED;
            PG8_LDB(B1, 1, 1); PG8_STAGE(PG8_SB(1, 0), b3, voffB);
            PG8_BAR; PG8_WAIT_L(0); PG8_MMA(0, 1, At, B1); PG8_BAR;
            PG8_LDA(At, 1, 1); PG8_STAGE(PG8_SA(1, 0), a3, voffA);
            PG8_BAR; PG8_WAIT_L(0); PG8_MMA(1, 0, At, B0); PG8_BAR; PG8_SCHED;
            PG8_STAGE(PG8_SB(1, 1), b3 + hstep, voffB);
            PG8_WAIT_V(6); PG8_BAR; PG8_MMA(1, 1, At, B1); PG8_BAR;
            }
        }
        if constexpr (ALIGN_EPI) { if (wr == 0) PG8_BAR; }
        if constexpr (!Epi::AFTER_DRAIN) { E(acc, cur, wr, wc, fr, fq); S.done(cur); }
        if (!has_next) break;
#pragma unroll
        for (int a = 0; a < 2; ++a)
#pragma unroll
            for (int b = 0; b < 2; ++b)
#pragma unroll
                for (int m = 0; m < 4; ++m)
#pragma unroll
                    for (int n = 0; n < 2; ++n) acc[a][b][m][n] = (f32x4){0.f, 0.f, 0.f, 0.f};
        cur = nxt; cA = nA; cB = nB; ++ui;
        if constexpr (ALIGN_EPI) { if (wr == 1) PG8_BAR; }
    }
    PG8_WAIT_V(0);
    if constexpr (!ALIGN_EPI) { if (wr == 0) PG8_BAR; }
    PG8_BAR;
    if constexpr (Epi::AFTER_DRAIN) { E.fused(acc, cur, wr, wc, fr, fq, lds, wid, lane); S.done(cur); }
#undef PG8_SA
#undef PG8_SB
#undef PG8_STAGE
#undef PG8_LDA
#undef PG8_LDB
#undef PG8_MMA
#undef PG8_WAIT_V
#undef PG8_WAIT_L
#undef PG8_BAR
#undef PG8_SCHED
}
template <class Epi, class Sched, bool ALIGN_EPI = false, bool SP2 = false, bool ABLK = false, bool BBLK = false>
__device__ __forceinline__ void gemm_phase_f8(PG8_LAS unsigned char* lds, const Gemm g, const Sched& S, const Epi& E) {
    int tid = threadIdx.x; asm volatile("" : "+v"(tid));
    const int wid = __builtin_amdgcn_readfirstlane(tid >> 6), lane = tid & 63, wr = wid >> 2, wc = wid & 3, fr = lane & 15, fq = lane >> 4;
    const int K = g.K  , nt = K / 128;
    unsigned voffA[2], voffB[2];
#pragma unroll
    for (int i = 0; i < 2; ++i) { int R, C; stage_rc(tid * 16 + i * 8192, R, C); const int Rb = Epi::PERM ? ((R & ~31) + perm32(R & 31)) : R;
        voffA[i] = ABLK ? (unsigned)((R >> 4) * (K * 16) + ((2 * C) >> 5) * 512 + (R & 15) * 32 + ((2 * C) & 31)) : (unsigned)(R * K + 2 * C);
        voffB[i] = BBLK ? (unsigned)((Rb >> 4) * (K * 16) + ((2 * C) >> 5) * 512 + (Rb & 15) * 32 + ((2 * C) & 31)) : (unsigned)(Rb * K + 2 * C); }
    const size_t kstepA = ABLK ? (size_t)2048 : (size_t)(BK * 2), kstepB = BBLK ? (size_t)2048 : (size_t)(BK * 2);
    const size_t hstep = (size_t)HALF * K;
    const size_t tstep = 2 * hstep;
    const unsigned ldsw = (unsigned)wid * 1024u;
    const int aoff = lds_byte(wr * 64 + fr, fq * 8), boff = lds_byte(wc * 32 + fr, fq * 8);
#define PG8_SA(b, h) (((b) * 2 + (h)) * HTB)
#define PG8_SB(b, h) ((4 + (b) * 2 + (h)) * HTB)
#define PG8_STAGE(bufoff, gbase, voff) do { _Pragma("unroll") for (int _i = 0; _i < 2; ++_i) \
        __builtin_amdgcn_global_load_lds((const unsigned*)((const char*)(gbase) + (voff)[_i]), (PG8_LAS unsigned*)(lds + (bufoff) + ldsw + _i * 8192), 16, 0, 0); } while (0)
#define PG8_LD32(p) __builtin_bit_cast(i32x8, __builtin_shufflevector(*(const PG8_LAS bf16x8*)(p), *(const PG8_LAS bf16x8*)((p) + 1024), 0, 1, 2, 3, 4, 5, 6, 7, 8, 9, 10, 11, 12, 13, 14, 15))
#define PG8_LDA(dst, b, h) do { _Pragma("unroll") for (int m = 0; m < 4; ++m) dst[m] = PG8_LD32(lds + PG8_SA(b, h) + aoff + m * 2048); } while (0)
#define PG8_LDB(dst, b, h) do { _Pragma("unroll") for (int n = 0; n < 2; ++n) dst[n] = PG8_LD32(lds + PG8_SB(b, h) + boff + n * 2048); } while (0)
#define PG8_MMA(ai, bj, At, Bt) do { __builtin_amdgcn_s_setprio(1); _Pragma("unroll") for (int m = 0; m < 4; ++m) _Pragma("unroll") for (int n = 0; n < 2; ++n) \
        asm volatile("v_mfma_f32_16x16x128_f8f6f4 %0, %1, %2, %0" : "+v"(acc[ai][bj][m][n]) : "v"(Bt[n]), "v"(At[m])); __builtin_amdgcn_s_setprio(0); } while (0)
#define PG8_WAIT_V(n) asm volatile("s_waitcnt vmcnt(" #n ")" ::: "memory")
#define PG8_WAIT_L(n) asm volatile("s_waitcnt lgkmcnt(" #n ")" ::: "memory")
#define PG8_BAR __builtin_amdgcn_s_barrier()
#define PG8_SCHED __builtin_amdgcn_sched_barrier(0)
    Unit cur, nxt; int ui = 0;
    if (!S.next(0, cur)) return;
    f32x4 acc[2][2][4][2];
#pragma unroll
    for (int a = 0; a < 2; ++a)
#pragma unroll
        for (int b = 0; b < 2; ++b)
#pragma unroll
            for (int m = 0; m < 4; ++m)
#pragma unroll
                for (int n = 0; n < 2; ++n) acc[a][b][m][n] = (f32x4){0.f, 0.f, 0.f, 0.f};
    i32x8 At[4], B0[2], B1[2];
    const char* cA = (const char*)g.A + (size_t)cur.pm * tstep; const char* cB = (const char*)g.Bt + (size_t)cur.pn * tstep;
    S.a_ready(cur);
    if constexpr (SP2) {
        PG8_STAGE(PG8_SB(0, 0), cB, voffB); PG8_STAGE(PG8_SB(0, 1), cB + hstep, voffB); PG8_STAGE(PG8_SA(0, 0), cA, voffA); PG8_STAGE(PG8_SA(0, 1), cA + hstep, voffA);
        if (wr == 1) PG8_BAR;
        PG8_WAIT_V(2); PG8_BAR;
        PG8_STAGE(PG8_SB(1, 0), cB + kstepB, voffB); PG8_STAGE(PG8_SA(1, 0), cA + kstepA, voffA); PG8_STAGE(PG8_SB(1, 1), cB + hstep + kstepB, voffB);
        PG8_WAIT_V(6); PG8_BAR;
    } else {
        PG8_STAGE(PG8_SB(0, 0), cB, voffB); PG8_STAGE(PG8_SA(0, 0), cA, voffA); PG8_STAGE(PG8_SB(0, 1), cB + hstep, voffB); PG8_STAGE(PG8_SA(0, 1), cA + hstep, voffA);
        if (wr == 1) PG8_BAR;
        PG8_WAIT_V(4); PG8_BAR;
        PG8_STAGE(PG8_SB(1, 0), cB + kstepB, voffB); PG8_STAGE(PG8_SA(1, 0), cA + kstepA, voffA); PG8_STAGE(PG8_SB(1, 1), cB + hstep + kstepB, voffB);
        PG8_WAIT_V(6); PG8_BAR;
    }
    for (;;) {
        const bool has_next = S.next(ui + 1, nxt);
        const char* nA = has_next ? (const char*)g.A + (size_t)nxt.pm * tstep : cA; const char* nB = has_next ? (const char*)g.Bt + (size_t)nxt.pn * tstep : cB;
        for (int t = 0; t < nt; t += 2) {
            const bool last = (t == nt - 2);
            const char* a1 = cA + (size_t)(t + 1) * kstepA;
            const char* a2 = last ? nA : cA + (size_t)(t + 2) * kstepA; const char* b2 = last ? nB : cB + (size_t)(t + 2) * kstepB;
            const char* a3 = a2 + kstepA; const char* b3 = b2 + kstepB;
            if (last && has_next) S.a_ready(nxt);
            if constexpr (SP2) {
            PG8_LDB(B0, 0, 0); PG8_LDB(B1, 0, 1); PG8_SCHED; PG8_LDA(At, 0, 0); PG8_STAGE(PG8_SA(1, 1), a1 + hstep, voffA);
            PG8_WAIT_V(8); PG8_WAIT_L(0); PG8_BAR; PG8_MMA(0, 0, At, B0); PG8_MMA(0, 1, At, B1); PG8_BAR; PG8_SCHED;
            PG8_LDA(At, 0, 1); PG8_STAGE(PG8_SB(0, 0), b2, voffB); PG8_STAGE(PG8_SB(0, 1), b2 + hstep, voffB); PG8_STAGE(PG8_SA(0, 0), a2, voffA);
            PG8_WAIT_V(8); PG8_WAIT_L(0); PG8_BAR; PG8_MMA(1, 0, At, B0); PG8_MMA(1, 1, At, B1); PG8_BAR; PG8_SCHED;
            PG8_LDB(B0, 1, 0); PG8_LDB(B1, 1, 1); PG8_SCHED; PG8_LDA(At, 1, 0); PG8_STAGE(PG8_SA(0, 1), a2 + hstep, voffA);
            PG8_WAIT_V(8); PG8_WAIT_L(0); PG8_BAR; PG8_MMA(0, 0, At, B0); PG8_MMA(0, 1, At, B1); PG8_BAR; PG8_SCHED;
            PG8_LDA(At, 1, 1); PG8_STAGE(PG8_SB(1, 0), b3, voffB); PG8_STAGE(PG8_SB(1, 1), b3 + hstep, voffB); PG8_STAGE(PG8_SA(1, 0), a3, voffA);
            PG8_WAIT_V(8); PG8_WAIT_L(0); PG8_BAR; PG8_MMA(1, 0, At, B0); PG8_MMA(1, 1, At, B1); PG8_BAR; PG8_SCHED;
            } else {
            PG8_LDB(B0, 0, 0); PG8_SCHED; PG8_LDA(At, 0, 0); PG8_STAGE(PG8_SA(1, 1), a1 + hstep, voffA);
            PG8_WAIT_L(8); PG8_BAR; PG8_WAIT_L(0); PG8_MMA(0, 0, At, B0); PG8_BAR; PG8_SCHED;
            PG8_LDB(B1, 0, 1); PG8_STAGE(PG8_SB(0, 0), b2, voffB);
            PG8_BAR; PG8_WAIT_L(0); PG8_MMA(0, 1, At, B1); PG8_BAR;
            PG8_LDA(At, 0, 1); PG8_STAGE(PG8_SA(0, 0), a2, voffA);
            PG8_BAR; PG8_WAIT_L(0); PG8_MMA(1, 0, At, B0); PG8_BAR; PG8_SCHED;
            PG8_STAGE(PG8_SB(0, 1), b2 + hstep, voffB);
            PG8_WAIT_V(6); PG8_BAR; PG8_MMA(1, 1, At, B1); PG8_BAR;
            PG8_LDB(B0, 1, 0); PG8_SCHED; PG8_LDA(At, 1, 0); PG8_STAGE(PG8_SA(0, 1), a2 + hstep, voffA);
            PG8_WAIT_L(8); PG8_BAR; PG8_WAIT_L(0); PG8_MMA(0, 0, At, B0); PG8_BAR; PG8_SCHED;
            PG8_LDB(B1, 1, 1); PG8_STAGE(PG8_SB(1, 0), b3, voffB);
            PG8_BAR; PG8_WAIT_L(0); PG8_MMA(0, 1, At, B1); PG8_BAR;
            PG8_LDA(At, 1, 1); PG8_STAGE(PG8_SA(1, 0), a3, voffA);
            PG8_BAR; PG8_WAIT_L(0); PG8_MMA(1, 0, At, B0); PG8_BAR; PG8_SCHED;
            PG8_STAGE(PG8_SB(1, 1), b3 + hstep, voffB);
            PG8_WAIT_V(6); PG8_BAR; PG8_MMA(1, 1, At, B1); PG8_BAR;
            }
        }
        if constexpr (ALIGN_EPI) { if (wr == 0) PG8_BAR; }
        asm volatile("s_nop 15\n\ts_nop 15" ::: "memory");
        if constexpr (!Epi::AFTER_DRAIN) { E(acc, cur, wr, wc, fr, fq); S.done(cur); }
        if (!has_next) break;
#pragma unroll
        for (int a = 0; a < 2; ++a)
#pragma unroll
            for (int b = 0; b < 2; ++b)
#pragma unroll
                for (int m = 0; m < 4; ++m)
#pragma unroll
                    for (int n = 0; n < 2; ++n) acc[a][b][m][n] = (f32x4){0.f, 0.f, 0.f, 0.f};
        cur = nxt; cA = nA; cB = nB; ++ui;
        if constexpr (ALIGN_EPI) { if (wr == 1) PG8_BAR; }
    }
    PG8_WAIT_V(0);
    if constexpr (!ALIGN_EPI) { if (wr == 0) PG8_BAR; }
    PG8_BAR;
    if constexpr (Epi::AFTER_DRAIN) { E.fused(acc, cur, wr, wc, fr, fq, lds, wid, lane); S.done(cur); }
#undef PG8_SA
#undef PG8_SB
#undef PG8_STAGE
#undef PG8_LD32
#undef PG8_LDA
#undef PG8_LDB
#undef PG8_MMA
#undef PG8_WAIT_V
#undef PG8_WAIT_L
#undef PG8_BAR
#undef PG8_SCHED
}
}

namespace att {
typedef unsigned short bf16;
typedef short bf16x8 __attribute__((ext_vector_type(8)));
typedef short s16x4 __attribute__((ext_vector_type(4)));
typedef float f32x16 __attribute__((ext_vector_type(16)));
typedef float f32x4 __attribute__((ext_vector_type(4)));
typedef unsigned u32x4 __attribute__((ext_vector_type(4)));
template <class A, class Bt> struct same_t { static constexpr bool v = false; };
template <class A> struct same_t<A, A> { static constexpr bool v = true; };
constexpr int D = 128;
constexpr float SCALE = 0.08838834764831845f;
constexpr float THR = 8.f;
constexpr int NW = 8, QBLK = 32, KVBLK = 64, QB = NW * QBLK;
constexpr int SHM_V = KVBLK * D * 2, SHM_K = KVBLK * D * 2;
constexpr int LDS_WS = 2 * SHM_V + 2 * SHM_K;
constexpr int LDS_SSQ = LDS_WS + NW * 64 * 4;
constexpr int LDS_BYTES = LDS_SSQ + NW * 32 * 4;
typedef int i32x8 __attribute__((ext_vector_type(8)));
typedef int i32x4 __attribute__((ext_vector_type(4)));
#define KSWZ(row, colB) ((row) * 256 + ((colB) ^ (((row) & 15) << 4)))
#define SBAR() __builtin_amdgcn_sched_barrier(0)
__device__ __forceinline__ int v_st(int k, int c) { const int kk = (k & ~0xC) | ((k & 4) << 1) | ((k & 8) >> 1); return ((kk >> 3) * 4 + (c >> 5)) * 512 + ((kk & 7) * 32 + (c & 31)) * 2; }
__device__ __forceinline__ int v_rd_base(int lane) { return ((lane & 3) << 3) | (((lane >> 2) & 3) << 6) | (((lane >> 4) & 1) << 5) | (((lane >> 5) & 1) << 8); }
constexpr int v_rd_off(int d0, int ks, int half) { return d0 * 512 + ks * 4096 + half * 2048; }
__device__ __forceinline__ int crow(int r, int hi) { return (r & 3) + 8 * (r >> 2) + 4 * hi; }
__device__ __forceinline__ unsigned cvtpk(float lo, float hi) {
    unsigned r; asm volatile("v_cvt_pk_bf16_f32 %0, %1, %2" : "=v"(r) : "v"(lo), "v"(hi)); return r;
}
__device__ __forceinline__ bf16x8 pack8(f32x4 a, f32x4 b) {
    u32x4 w = {cvtpk(a[0], a[1]), cvtpk(a[2], a[3]), cvtpk(b[0], b[1]), cvtpk(b[2], b[3])};
    return *reinterpret_cast<bf16x8*>(&w);
}
template <class T> __device__ __forceinline__ bf16x8 load8(const T* p) {
    if constexpr (same_t<T, float>::v) { return pack8(*(const f32x4*)p, *(const f32x4*)(p + 4)); }
    else { return *reinterpret_cast<const bf16x8*>(p); }
}
__device__ __forceinline__ void mask_tile(f32x16& p0, f32x16& p1, int dq, unsigned W) {
    const float NEG = -__builtin_inff();
#pragma unroll
    for (int r = 0; r < 16; ++r) {
        const int c = (r & 3) + 8 * (r >> 2);
        if ((unsigned)(dq - c) >= W) p0[r] = NEG;
        if ((unsigned)(dq - c - 32) >= W) p1[r] = NEG;
    }
}
template <int SH = 0, int THRI = 8, int PSH = 0>
__device__ __forceinline__ void partialSM(f32x16& p0, f32x16& p1, float& m_reg, float& mn, float& alpha, bool dead = false) {
    float pmax;
    { float m0 = fmaxf(p0[0], p0[1]), m1 = fmaxf(p0[2], p0[3]), m2 = fmaxf(p1[0], p1[1]), m3 = fmaxf(p1[2], p1[3]);
#pragma unroll
      for (int r = 4; r < 16; r += 4) { m0 = fmaxf(fmaxf(m0, p0[r]), p0[r + 1]); m1 = fmaxf(fmaxf(m1, p0[r + 2]), p0[r + 3]); m2 = fmaxf(fmaxf(m2, p1[r]), p1[r + 1]); m3 = fmaxf(fmaxf(m3, p1[r + 2]), p1[r + 3]); }
      pmax = fmaxf(fmaxf(m0, m1), fmaxf(m2, m3)); }
    pmax = dead ? -__builtin_inff() : pmax;
    { auto rr = __builtin_amdgcn_permlane32_swap(__float_as_uint(pmax), __float_as_uint(pmax), false, false);
      pmax = fmaxf(__uint_as_float(rr[0]), __uint_as_float(rr[1])); }
    constexpr float SCL = SCALE / (float)(1 << SH), C2 = 1.4426950408889634f * SCL;
    if (__builtin_expect(__all((pmax - m_reg) * SCL <= (float)THRI), 1)) { mn = m_reg; alpha = 1.f; }
    else { mn = fmaxf(m_reg, pmax); alpha = __builtin_amdgcn_exp2f((m_reg - mn) * C2); m_reg = mn; }
    const float mnL = dead ? -__builtin_inff() : -mn * C2 + (float)PSH;
    for (int r = 0; r < 16; ++r) p0[r] = fmaf(p0[r], C2, mnL); for (int r = 0; r < 16; ++r) p1[r] = fmaf(p1[r], C2, mnL);
    for (int r = 0; r < 16; ++r) p0[r] = __builtin_amdgcn_exp2f(p0[r]);
}
__device__ __forceinline__ void finishSM(f32x16& p0, f32x16& p1, float alpha, float& l_reg, bf16x8& pa0, bf16x8& pa1, bf16x8& pa2, bf16x8& pa3) {
    for (int r = 0; r < 16; ++r) p1[r] = __builtin_amdgcn_exp2f(p1[r]);
    float ps;
    { float s0 = p0[0] + p0[1], s1 = p0[2] + p0[3], s2 = p1[0] + p1[1], s3 = p1[2] + p1[3];
#pragma unroll
      for (int r = 4; r < 16; r += 4) { s0 += p0[r]; s0 += p0[r + 1]; s1 += p0[r + 2]; s1 += p0[r + 3]; s2 += p1[r]; s2 += p1[r + 1]; s3 += p1[r + 2]; s3 += p1[r + 3]; }
      ps = (s0 + s1) + (s2 + s3); }
    { auto rr = __builtin_amdgcn_permlane32_swap(__float_as_uint(ps), __float_as_uint(ps), false, false);
      ps = __uint_as_float(rr[0]) + __uint_as_float(rr[1]); }
    l_reg = l_reg * alpha + ps;
#define PK4(P, B_, OUT) do { unsigned a0 = cvtpk(P[B_+0], P[B_+1]), a1 = cvtpk(P[B_+2], P[B_+3]);                          \
        unsigned b0 = cvtpk(P[B_+4], P[B_+5]), b1 = cvtpk(P[B_+6], P[B_+7]);                                             \
        auto r0 = __builtin_amdgcn_permlane32_swap(a0, b0, false, false); auto r1 = __builtin_amdgcn_permlane32_swap(a1, b1, false, false); \
        u32x4 w = {r0[0], r1[0], r0[1], r1[1]}; OUT = *reinterpret_cast<bf16x8*>(&w); } while (0)
    PK4(p0, 0, pa0); PK4(p0, 8, pa1); PK4(p1, 0, pa2); PK4(p1, 8, pa3);
#undef PK4
}
__device__ __forceinline__ void finishSM8(f32x16& p0, f32x16& p1, float alpha, float& l_reg, i32x8& pa) {
    for (int r = 0; r < 16; ++r) p1[r] = __builtin_amdgcn_exp2f(p1[r]);
    float ps;
    { float s0 = p0[0] + p0[1], s1 = p0[2] + p0[3], s2 = p1[0] + p1[1], s3 = p1[2] + p1[3];
#pragma unroll
      for (int r = 4; r < 16; r += 4) { s0 += p0[r]; s0 += p0[r + 1]; s1 += p0[r + 2]; s1 += p0[r + 3]; s2 += p1[r]; s2 += p1[r + 1]; s3 += p1[r + 2]; s3 += p1[r + 3]; }
      ps = (s0 + s1) + (s2 + s3); }
    { auto rr = __builtin_amdgcn_permlane32_swap(__float_as_uint(ps), __float_as_uint(ps), false, false);
      ps = __uint_as_float(rr[0]) + __uint_as_float(rr[1]); }
    l_reg = l_reg * alpha + ps;
#pragma unroll
    for (int d = 0; d < 4; ++d) { int w0 = 0, w1 = 0;
        w0 = __builtin_amdgcn_cvt_pk_fp8_f32(p0[4 * d], p0[4 * d + 1], w0, false); w0 = __builtin_amdgcn_cvt_pk_fp8_f32(p0[4 * d + 2], p0[4 * d + 3], w0, true);
        w1 = __builtin_amdgcn_cvt_pk_fp8_f32(p1[4 * d], p1[4 * d + 1], w1, false); w1 = __builtin_amdgcn_cvt_pk_fp8_f32(p1[4 * d + 2], p1[4 * d + 3], w1, true);
        pa[d] = w0; pa[4 + d] = w1; }
}
__device__ __forceinline__ void mask_tile_perm(f32x16& p0, f32x16& p1, int dq) {
    const float NEG = -__builtin_inff();
#pragma unroll
    for (int r = 0; r < 16; ++r) { const int c = 16 * (r & 3) + (r >> 2);
        if (dq - c < 0) p0[r] = NEG;
        if (dq - c - 4 < 0) p1[r] = NEG; }
}
template <int KB, bool SK>
__device__ __forceinline__ void qkt(f32x16& p0, f32x16& p1, const char* K_lds, int r32, int hi, const bf16x8* qr, bool act) {
    if (SK && !act) { const float NEG = -__builtin_inff();
#pragma unroll
        for (int r = 0; r < 16; ++r) { p0[r] = NEG; p1[r] = NEG; } return; }
    p0 = f32x16{}; p1 = f32x16{};
    typedef const __attribute__((address_space(3))) char* lds_cptr;
    lds_cptr kb[4];
#pragma unroll
    for (int dd = 0; dd < 4; ++dd) kb[dd] = (lds_cptr)(K_lds + KB * SHM_K + KSWZ(r32, (dd * 16 + hi * 8) * 2));
    unsigned flip = 128u; asm volatile("" : "+v"(flip));
#pragma unroll
    for (int d0 = 0; d0 < 8; ++d0) { lds_cptr a = (d0 < 4) ? kb[d0] : (lds_cptr)((unsigned)(__UINTPTR_TYPE__)kb[d0 & 3] ^ flip);
        bf16x8 b0 = *reinterpret_cast<const __attribute__((address_space(3))) bf16x8*>(a);
        bf16x8 b1 = *reinterpret_cast<const __attribute__((address_space(3))) bf16x8*>(a + 32 * 256);
        p0 = __builtin_amdgcn_mfma_f32_32x32x16_bf16(b0, qr[d0], p0, 0, 0, 0);
        p1 = __builtin_amdgcn_mfma_f32_32x32x16_bf16(b1, qr[d0], p1, 0, 0, 0); }
}
template <int KB>
__device__ __forceinline__ void qkt_p(f32x16& p0, f32x16& p1, const char* K_lds, int r32, int hi, const bf16x8* qr) {
    unsigned kb[4], kf[4];
    asm volatile("" : "+v"(r32), "+v"(hi));
#pragma unroll
    for (int dd = 0; dd < 4; ++dd) kb[dd] = (unsigned)(__UINTPTR_TYPE__)K_lds + (unsigned)KSWZ(r32, (dd * 16 + hi * 8) * 2);
    unsigned flip = 128u; asm volatile("" : "+v"(flip));
#pragma unroll
    for (int dd = 0; dd < 4; ++dd) kf[dd] = kb[dd] ^ flip;
    bf16x8 A0, A1, B0, B1, C0, C1;
#define KRD(d0_, d1_, addr) asm volatile("ds_read_b128 %0, %2 offset:%3\n\tds_read_b128 %1, %2 offset:%4" : "=&v"(d0_), "=&v"(d1_) : "v"(addr), "i"(KB * SHM_K), "i"(KB * SHM_K + 32 * 256) : "memory")
#define KWT(n) do { asm volatile("s_waitcnt lgkmcnt(" #n ")" ::: "memory"); SBAR(); } while (0)
#define KMM(f0_, f1_, d0) do { p0 = __builtin_amdgcn_mfma_f32_32x32x16_bf16(f0_, qr[d0], p0, 0, 0, 0); p1 = __builtin_amdgcn_mfma_f32_32x32x16_bf16(f1_, qr[d0], p1, 0, 0, 0); SBAR(); } while (0)
    p0 = f32x16{}; p1 = f32x16{};
    SBAR(); KRD(A0, A1, kb[0]); KRD(B0, B1, kb[1]);
    KRD(C0, C1, kb[2]); KWT(4); KMM(A0, A1, 0);
    KRD(A0, A1, kb[3]); KWT(4); KMM(B0, B1, 1);
    KRD(B0, B1, kf[0]); KWT(4); KMM(C0, C1, 2);
    KRD(C0, C1, kf[1]); KWT(4); KMM(A0, A1, 3);
    KRD(A0, A1, kf[2]); KWT(4); KMM(B0, B1, 4);
    KRD(B0, B1, kf[3]); KWT(4); KMM(C0, C1, 5);
    KWT(2); KMM(A0, A1, 6);
    KWT(0); KMM(B0, B1, 7);
#undef KRD
#undef KWT
#undef KMM
}
template <int KB, bool LOWREG = false>
__device__ __forceinline__ void qkt_f8(f32x16& p0, f32x16& p1, const char* K_lds, int r32, int hi, const i32x8 (&q8)[2]) {
    asm volatile("" : "+v"(r32), "+v"(hi));
    typedef const __attribute__((address_space(3))) bf16x8* lds_f;
    const unsigned sw = (unsigned)((r32 >> 1) & 7), base = (unsigned)(__UINTPTR_TYPE__)K_lds + (unsigned)(r32 * 128) + (unsigned)(KB * SHM_K);
    if constexpr (LOWREG) {
#define KF8(c_, hf_) __builtin_bit_cast(i32x8, __builtin_shufflevector(*(lds_f)(__UINTPTR_TYPE__)(base + ((((unsigned)(4 * (c_) + 2 * hi)) ^ sw) << 4) + (hf_) * 4096),          \
                                                                      *(lds_f)(__UINTPTR_TYPE__)(base + ((((unsigned)(4 * (c_) + 2 * hi + 1)) ^ sw) << 4) + (hf_) * 4096), 0, 1, 2, 3, 4, 5, 6, 7, 8, 9, 10, 11, 12, 13, 14, 15))
        i32x8 f0 = KF8(0, 0), f1 = KF8(0, 1);
        SBAR();
        asm volatile("v_mfma_f32_32x32x64_f8f6f4 %0, %1, %2, 0" : "=&v"(p0) : "v"(f0), "v"(q8[0]));
        asm volatile("v_mfma_f32_32x32x64_f8f6f4 %0, %1, %2, 0" : "=&v"(p1) : "v"(f1), "v"(q8[0]));
        SBAR();
        f0 = KF8(1, 0); f1 = KF8(1, 1);
        SBAR();
        asm volatile("v_mfma_f32_32x32x64_f8f6f4 %0, %1, %2, %0" : "+v"(p0) : "v"(f0), "v"(q8[1]));
        asm volatile("v_mfma_f32_32x32x64_f8f6f4 %0, %1, %2, %0" : "+v"(p1) : "v"(f1), "v"(q8[1]));
        asm volatile("s_nop 15\n\ts_nop 15" ::: "memory");
        SBAR();
#undef KF8
        return;
    }
    i32x8 kf[2][2];
#pragma unroll
    for (int c = 0; c < 2; ++c) { const unsigned a0 = base + ((((unsigned)(4 * c + 2 * hi)) ^ sw) << 4), a1 = base + ((((unsigned)(4 * c + 2 * hi + 1)) ^ sw) << 4);
#pragma unroll
        for (int hf = 0; hf < 2; ++hf)
            kf[c][hf] = __builtin_bit_cast(i32x8, __builtin_shufflevector(*(lds_f)(__UINTPTR_TYPE__)(a0 + hf * 4096), *(lds_f)(__UINTPTR_TYPE__)(a1 + hf * 4096), 0, 1, 2, 3, 4, 5, 6, 7, 8, 9, 10, 11, 12, 13, 14, 15)); }
    SBAR();
    asm volatile("v_mfma_f32_32x32x64_f8f6f4 %0, %1, %2, 0" : "=&v"(p0) : "v"(kf[0][0]), "v"(q8[0]));
    asm volatile("v_mfma_f32_32x32x64_f8f6f4 %0, %1, %2, 0" : "=&v"(p1) : "v"(kf[0][1]), "v"(q8[0]));
    asm volatile("v_mfma_f32_32x32x64_f8f6f4 %0, %1, %2, %0" : "+v"(p0) : "v"(kf[1][0]), "v"(q8[1]));
    asm volatile("v_mfma_f32_32x32x64_f8f6f4 %0, %1, %2, %0" : "+v"(p1) : "v"(kf[1][1]), "v"(q8[1]));
    asm volatile("s_nop 15\n\ts_nop 15" ::: "memory");
    SBAR();
}
template <int VB, bool SK>
__device__ __forceinline__ void pv_tile(f32x16* o, int vb0, bf16x8 pa0, bf16x8 pa1, bf16x8 pa2, bf16x8 pa3, bool act) {
    if (SK && !act) return;
#define TRRD(dst, off) asm volatile("ds_read_b64_tr_b16 %0, %1 offset:%2" : "=&v"(dst) : "v"(vb0), "i"(off) : "memory")
#define PV_D0(d0) do { s16x4 l0, l1, l2, l3, h0, h1, h2, h3; constexpr int b_ = VB * SHM_V + v_rd_off(d0, 0, 0);     \
        TRRD(l0, b_); TRRD(h0, b_ + 2048); TRRD(l1, b_ + 4096); TRRD(h1, b_ + 6144); TRRD(l2, b_ + 8192); TRRD(h2, b_ + 10240); TRRD(l3, b_ + 12288); TRRD(h3, b_ + 14336); \
        asm volatile("s_waitcnt lgkmcnt(0)" ::: "memory"); SBAR();                 \
        o[d0] = __builtin_amdgcn_mfma_f32_32x32x16_bf16(pa0, (bf16x8){l0[0], l0[1], l0[2], l0[3], h0[0], h0[1], h0[2], h0[3]}, o[d0], 0, 0, 0);   \
        o[d0] = __builtin_amdgcn_mfma_f32_32x32x16_bf16(pa1, (bf16x8){l1[0], l1[1], l1[2], l1[3], h1[0], h1[1], h1[2], h1[3]}, o[d0], 0, 0, 0);   \
        o[d0] = __builtin_amdgcn_mfma_f32_32x32x16_bf16(pa2, (bf16x8){l2[0], l2[1], l2[2], l2[3], h2[0], h2[1], h2[2], h2[3]}, o[d0], 0, 0, 0);   \
        o[d0] = __builtin_amdgcn_mfma_f32_32x32x16_bf16(pa3, (bf16x8){l3[0], l3[1], l3[2], l3[3], h3[0], h3[1], h3[2], h3[3]}, o[d0], 0, 0, 0); } while (0)
    PV_D0(0); PV_D0(1); PV_D0(2); PV_D0(3);
#undef PV_D0
#undef TRRD
}

struct BlockRef { const bf16* Q; const bf16* K; const bf16* V; int P0; };
struct Seam { bf16x8 qr[8]; bf16x8 st_v0, st_v1, st_k0, st_k1; i32x8 q8[2]; };
#define ROW(p, k0, rr) ((p) + (size_t)((k0) + (rr)) * D + sc)
#define VMW() asm volatile("s_waitcnt vmcnt(0)" ::: "memory")
#define SLOAD_H(Kp, Vp, k0) do { if constexpr (F8) { S.st_v0 = *reinterpret_cast<const bf16x8*>((const char*)(Vp) + (size_t)(k0) * 128 + tid * 16);                 \
                                             S.st_k0 = *reinterpret_cast<const bf16x8*>((const char*)(Kp) + (size_t)((k0) + kp8) * 128 + kc8); }                 \
                         else { S.st_v0 = load8<bf16>(ROW(Vp, k0, sr)); S.st_v1 = load8<bf16>(ROW(Vp, k0, 32 + sr));                                              \
                                S.st_k0 = load8<bf16>(ROW(Kp, k0, sr)); S.st_k1 = load8<bf16>(ROW(Kp, k0, 32 + sr)); } } while (0)
#define SWRITE_HK(bf) do { if constexpr (F8) { *(bf16x8*)(K_lds + (bf) * SHM_K + kws8) = S.st_k0; }                                                          \
                           else { *(bf16x8*)(K_lds + (bf) * SHM_K + kws) = S.st_k0; *(bf16x8*)(K_lds + (bf) * SHM_K + kws + 32 * 256) = S.st_k1; } } while (0)
#define SWRITE_HV(bf) do { if constexpr (F8) { *(bf16x8*)(V_lds + (bf) * SHM_V + vws8) = S.st_v0; }                                                          \
                           else { *(bf16x8*)(V_lds + (bf) * SHM_V + vst0) = S.st_v0; *(bf16x8*)(V_lds + (bf) * SHM_V + vst1) = S.st_v1; } } while (0)
#define SWRITE_H(bf) do { SWRITE_HV(bf); SWRITE_HK(bf); } while (0)
template <bool F8 = false>
__device__ __forceinline__ void prime(const BlockRef& cur, char* lds, Seam& S) {
    int tid = threadIdx.x; asm volatile("" : "+v"(tid));
    const int wid = __builtin_amdgcn_readfirstlane(tid >> 6), lane = tid & 63, r32 = lane & 31, hi = lane >> 5;
    const int sr = tid >> 4, sc = (tid & 15) * 8, kws = KSWZ(sr, sc * 2); char* K_lds = lds + 2 * SHM_V;
    const int kr8 = tid >> 3, kc8 = (tid & 7) * 16, kws8 = kr8 * 128 + (((tid & 7) ^ ((kr8 >> 1) & 7)) << 4);
    const int krp8 = kr8 & 31, kt8 = (krp8 & 3) + 4 * (krp8 >> 3) + 16 * (kr8 >> 5), kp8 = 16 * (kt8 & 3) + (kt8 >> 2) + 8 * ((krp8 >> 2) & 1);
#pragma unroll
    for (int d0 = 0; d0 < 8; ++d0) S.qr[d0] = load8<bf16>(cur.Q + (size_t)(wid * QBLK + r32) * D + d0 * 16 + hi * 8);
    SLOAD_H(cur.K, cur.V, 0); VMW(); SWRITE_HK(0);
    __syncthreads();
}
template <class Epi, bool F8 = false>
__device__ __forceinline__ void block(const BlockRef& cur, int skv, char* lds, Seam& S, bool moba, unsigned selmask, const Epi& E) {
    int tid = threadIdx.x; asm volatile("" : "+v"(tid));
    const int wid = __builtin_amdgcn_readfirstlane(tid >> 6), lane = tid & 63, r32 = lane & 31, hi = lane >> 5;
    int j_hi = (cur.P0 + QB - 1) / KVBLK + 1; if (j_hi > skv / KVBLK) j_hi = skv / KVBLK;
    const int NT = j_hi;
    const int qlo = cur.P0 + wid * QBLK, qm = qlo + r32 - 4 * hi;
    char* V_lds = lds; char* K_lds = lds + 2 * SHM_V;
    float* ws = (float*)(lds + LDS_WS) + wid * 64; float* li_l = ws, * al_l = ws + 32;
    float m_reg = -1e30f, l_reg = 0; f32x16 o[4] = {};
    const int sr = tid >> 4, sc = (tid & 15) * 8, vst0 = v_st(sr, sc), vst1 = v_st(32 + sr, sc), kws = KSWZ(sr, sc * 2);
    const int kr8 = tid >> 3, kc8 = (tid & 7) * 16, kws8 = kr8 * 128 + (((tid & 7) ^ ((kr8 >> 1) & 7)) << 4);
    const int krp8 = kr8 & 31, kt8 = (krp8 & 3) + 4 * (krp8 >> 3) + 16 * (kr8 >> 5), kp8 = 16 * (kt8 & 3) + (kt8 >> 2) + 8 * ((krp8 >> 2) & 1);
    const int vc8 = tid >> 2, vws8 = vc8 * 64 + (((tid & 3) ^ ((vc8 >> 2) & 3)) << 4), qm8 = qlo + r32 - 8 * hi;
    typedef const __attribute__((address_space(3))) bf16x8* lds_f;
    const unsigned vsw = (unsigned)((r32 >> 2) & 3), va0 = (unsigned)(__UINTPTR_TYPE__)V_lds + (unsigned)(r32 * 64) + (((unsigned)(2 * hi) ^ vsw) << 4), va1 = (unsigned)(__UINTPTR_TYPE__)V_lds + (unsigned)(r32 * 64) + (((unsigned)(2 * hi + 1) ^ vsw) << 4);
    i32x8 pa8;
#define VF8N(VB_, g) __builtin_bit_cast(i32x8, __builtin_shufflevector(*(lds_f)(__UINTPTR_TYPE__)(va0 + (VB_) * SHM_V + (g) * 2048), *(lds_f)(__UINTPTR_TYPE__)(va1 + (VB_) * SHM_V + (g) * 2048), 0, 1, 2, 3, 4, 5, 6, 7, 8, 9, 10, 11, 12, 13, 14, 15))
#define MM8(g, f_) asm volatile("v_mfma_f32_32x32x64_f8f6f4 %0, %1, %2, %0" : "+v"(o[g]) : "v"(pa8), "v"(f_))
#define PV8(VB_) do { SBAR(); i32x8 f0_ = VF8N(VB_, 0), f1_ = VF8N(VB_, 1); SBAR(); MM8(0, f0_); f0_ = VF8N(VB_, 2); SBAR(); MM8(1, f1_); f1_ = VF8N(VB_, 3); SBAR(); MM8(2, f0_); MM8(3, f1_);   \
        asm volatile("s_nop 15\n\ts_nop 15" ::: "memory"); SBAR(); } while (0)
#define FIN(PY0_, PY1_, alY_) do { if constexpr (F8) finishSM8(PY0_, PY1_, alY_, l_reg, pa8); else finishSM(PY0_, PY1_, alY_, l_reg, pa0, pa1, pa2, pa3); } while (0)
#define PVT(VB_) do { if constexpr (F8) PV8(VB_); else pv_tile<VB_, false>(o, vb0, pa0, pa1, pa2, pa3, true); } while (0)
#define PSM(P0_, P1_, mn_, al_) partialSM<F8 ? 8 : 0, F8 ? 2 : 8, F8 ? 5 : 0>(P0_, P1_, m_reg, mn_, al_, dead_)
    bool dead_ = false;
    const int vb0 = (int)(uintptr_t)V_lds + v_rd_base(lane);
    const bf16* Kh = cur.K; const bf16* Vh = cur.V;
#define RESC(a) do { if (__any((a) < 1.f)) { if (hi == 0) al_l[r32] = (a); asm volatile("s_waitcnt lgkmcnt(0)" ::: "memory");              \
                     for (int d_ = 0; d_ < 4; ++d_) for (int r = 0; r < 16; ++r) o[d_][r] *= al_l[crow(r, hi)]; } } while (0)
#define KBASE(t) ((t) * KVBLK)
#define QKT(KB_, P0_, P1_) do { if constexpr (F8) qkt_f8<KB_, true>(P0_, P1_, K_lds, r32, hi, S.q8); else qkt<KB_, false>(P0_, P1_, K_lds, r32, hi, S.qr, true); } while (0)
#define MASKT(P0_, P1_, t) do { const int kb_ = KBASE(t); if (kb_ + KVBLK - 1 > qlo) { if constexpr (F8) mask_tile_perm(P0_, P1_, qm8 - kb_); else mask_tile(P0_, P1_, qm - kb_, 0x7fffffffu); }   \
        dead_ = moba && kb_ < cur.P0 && (((selmask >> (kb_ >> 8)) & 1u) == 0u); } while (0)
    f32x16 pA0, pA1, pB0, pB1; float mnA, mnB, alA, alB; bf16x8 pa0, pa1, pa2, pa3;
    SWRITE_HV(0); SBAR();
    if (NT > 1) SLOAD_H(Kh, Vh, KBASE(1));
    SBAR(); QKT(0, pA0, pA1);
    MASKT(pA0, pA1, 0); PSM(pA0, pA1, mnA, alA);
    if (NT > 1) { VMW(); SWRITE_H(1); }
    __syncthreads();
#define HALF_STEP(PX0, PX1, mnX, alX, PY0, PY1, alY, t, KB, VB, SB) do {                                                      \
        SBAR(); QKT(KB, PX0, PX1);                                                         \
        FIN(PY0, PY1, alY); SBAR();                                                           \
        if ((t) + 1 < NT) { SLOAD_H(Kh, Vh, KBASE((t) + 1)); SBAR(); }                                                        \
        PVT(VB); MASKT(PX0, PX1, (t)); PSM(PX0, PX1, mnX, alX);     \
        __syncthreads();                                                                                                      \
        if ((t) + 1 < NT) { VMW(); SWRITE_H(SB); }                                                                            \
        RESC(alX); __syncthreads(); } while (0)
    for (int t = 1; t + 1 < NT; t += 2) {
        HALF_STEP(pB0, pB1, mnB, alB, pA0, pA1, alA, t, 1, 0, 0);
        HALF_STEP(pA0, pA1, mnA, alA, pB0, pB1, alB, t + 1, 0, 1, 1);
    }
    const bool even = (NT & 1) == 0;
    if (even) { SBAR(); QKT(1, pB0, pB1); SBAR(); }
    FIN(pA0, pA1, alA); SBAR();
    PVT(0);
    if (even) { MASKT(pB0, pB1, NT - 1); PSM(pB0, pB1, mnB, alB); __syncthreads(); RESC(alB);
        FIN(pB0, pB1, alB); SBAR(); PVT(1); }
    SBAR();
    if (hi == 0) li_l[r32] = l_reg; asm volatile("s_waitcnt lgkmcnt(0)" ::: "memory");
    float rli[16];
#pragma unroll
    for (int r = 0; r < 16; ++r) rli[r] = __builtin_amdgcn_rcpf(li_l[crow(r, hi)]) * (F8 ? 1.0f / 16.0f : 1.0f);
    E(o, rli, wid, lane, r32, hi);
    __syncthreads();
#undef RESC
#undef KBASE
#undef QKT
#undef VF8N
#undef MM8
#undef PV8
#undef FIN
#undef PVT
#undef PSM
#undef MASKT
#undef HALF_STEP
}
constexpr int WIDE_WS = 4 * SHM_V + 2 * SHM_K;
constexpr int WIDE_BYTES = WIDE_WS + NW * 64 * 4;
template <class Epi, int VAR = 0>
__device__ __forceinline__ void block_wide(const BlockRef& cur, const bf16* V2, int skv, char* lds, Seam& S, const Epi& E) {
    int tid = threadIdx.x; asm volatile("" : "+v"(tid));
    const int wid = __builtin_amdgcn_readfirstlane(tid >> 6), lane = tid & 63, r32 = lane & 31, hi = lane >> 5;
    int j_hi = (cur.P0 + QB - 1) / KVBLK + 1; if (j_hi > skv / KVBLK) j_hi = skv / KVBLK;
    const int NT = j_hi;
    const int qlo = cur.P0 + wid * QBLK, qm = qlo + r32 - 4 * hi;
    char* V_lds = lds; char* K_lds = lds + 4 * SHM_V;
    float* ws = (float*)(lds + WIDE_WS) + wid * 64; float* li_l = ws, * al_l = ws + 32;
    float m_reg = -1e30f, l_reg = 0; f32x16 o[8] = {};
    const int vb0 = (int)(uintptr_t)V_lds + v_rd_base(lane);
    const int krow = 8 * wid + (lane >> 3);
    const unsigned koff = (unsigned)(krow * 128 + (((lane & 7) ^ ((krow >> 1) & 7)) << 4));
    const int vkk = (wid >> 1) * 8 + ((lane >> 2) & 7), vkey = (vkk & ~0xC) | ((vkk & 4) << 1) | ((vkk & 8) >> 1);
    const unsigned voff = (unsigned)(vkey * 256 + ((((wid & 1) * 2 + (lane >> 5)) * 32 + (lane & 3) * 8) * 2));
    const char* Kh = (const char*)cur.K; const char* Va = (const char*)cur.V; const char* Vb = (const char*)V2;
    typedef __attribute__((address_space(3))) unsigned* lds_uptr;
#define WDMA(gb, ldsb) do { __builtin_amdgcn_global_load_lds((const unsigned*)((gb) + voff_), (lds_uptr)((ldsb) + wid * 1024), 16, 0, 0);                    \
                            __builtin_amdgcn_global_load_lds((const unsigned*)((gb) + 8192 + voff_), (lds_uptr)((ldsb) + 8192 + wid * 1024), 16, 0, 0); } while (0)
#define WLOADK(k0, par) do { if constexpr (VAR == 4) { if ((k0) > 0) break; } const size_t tb_ = (VAR == 5) ? (size_t)0 : (size_t)(k0) * D;                                            \
        __builtin_amdgcn_global_load_lds((const unsigned*)(Kh + tb_ + koff), (lds_uptr)(K_lds + (par) * SHM_K + wid * 1024), 16, 0, 0); } while (0)
#define WLOADV(k0, par) do { if constexpr (VAR == 4) { if ((k0) > 0) break; } const size_t tb_ = (VAR == 5) ? (size_t)0 : (size_t)(k0) * (D * 2); const unsigned voff_ = voff;                                \
        WDMA(Va + tb_, V_lds + (2 * (par)) * SHM_V); WDMA(Vb + tb_, V_lds + (2 * (par) + 1) * SHM_V); } while (0)
    i32x8 q8[2];
    { const i32x4* qp = (const i32x4*)((const char*)cur.Q + (size_t)(wid * QBLK + r32) * D + hi * 32);
#pragma unroll
      for (int c = 0; c < 2; ++c) { const i32x4 lo_ = qp[4 * c], hi_ = qp[4 * c + 1]; q8[c] = (i32x8){lo_[0], lo_[1], lo_[2], lo_[3], hi_[0], hi_[1], hi_[2], hi_[3]}; } }
    WLOADK(0, 0); WLOADV(0, 0); VMW();
    __syncthreads();
    f32x16 p0, p1; float mn, al; bf16x8 pa0, pa1, pa2, pa3;
#define WBAR() do { asm volatile("s_waitcnt vmcnt(0) lgkmcnt(0)" ::: "memory"); __builtin_amdgcn_s_barrier(); asm volatile("" ::: "memory"); } while (0)
#define WBARN(more, n) do { if (more) asm volatile("s_waitcnt vmcnt(" #n ") lgkmcnt(0)" ::: "memory"); else asm volatile("s_waitcnt vmcnt(0) lgkmcnt(0)" ::: "memory");                 \
        __builtin_amdgcn_s_barrier(); asm volatile("" ::: "memory"); } while (0)
#define WQKSM(t, PAR) do { __builtin_amdgcn_s_setprio(1);       \
        qkt_f8<PAR>(p0, p1, K_lds, r32, hi, q8);                                                                                                   \
        { const int kb_ = (t) * KVBLK; if (kb_ + KVBLK - 1 > qlo) mask_tile(p0, p1, qm - kb_, 0x7fffffffu); }                                      \
        if constexpr (VAR != 1) { partialSM<8>(p0, p1, m_reg, mn, al);                                                                               \
        if (__any(al < 1.f)) { if (hi == 0) al_l[r32] = al; asm volatile("s_waitcnt lgkmcnt(0)" ::: "memory");                                     \
            for (int d_ = 0; d_ < 8; ++d_) for (int r = 0; r < 16; ++r) o[d_][r] *= al_l[crow(r, hi)]; }                                            \
        finishSM(p0, p1, al, l_reg, pa0, pa1, pa2, pa3); }                                                                                         \
        else { pa0 = pack8(f32x4{p0[0], p0[1], p0[2], p0[3]}, f32x4{p0[4], p0[5], p0[6], p0[7]}); pa1 = pack8(f32x4{p0[8], p0[9], p0[10], p0[11]}, f32x4{p0[12], p0[13], p0[14], p0[15]});   \
               pa2 = pack8(f32x4{p1[0], p1[1], p1[2], p1[3]}, f32x4{p1[4], p1[5], p1[6], p1[7]}); pa3 = pack8(f32x4{p1[8], p1[9], p1[10], p1[11]}, f32x4{p1[12], p1[13], p1[14], p1[15]}); l_reg += p0[0]; } \
        __builtin_amdgcn_s_setprio(0); SBAR(); } while (0)
    s16x4 Xl0, Xl1, Xl2, Xl3, Xh0, Xh1, Xh2, Xh3, Yl0, Yl1, Yl2, Yl3, Yh0, Yh1, Yh2, Yh3;
#define TRRD(dst, off) asm volatile("ds_read_b64_tr_b16 %0, %1 offset:%2" : "=&v"(dst) : "v"(vb0), "i"(off) : "memory")
#define WRD(S_, PAR, g) do { constexpr int b_ = (2 * (PAR) + ((g) >> 2)) * SHM_V + ((g) & 3) * 512;                                                \
        TRRD(S_##l0, b_); TRRD(S_##h0, b_ + 2048); TRRD(S_##l1, b_ + 4096); TRRD(S_##h1, b_ + 6144);                                             \
        TRRD(S_##l2, b_ + 8192); TRRD(S_##h2, b_ + 10240); TRRD(S_##l3, b_ + 12288); TRRD(S_##h3, b_ + 14336); } while (0)
#define WMM(S_, g) do {                                                                                                                            \
        o[g] = __builtin_amdgcn_mfma_f32_32x32x16_bf16(pa0, (bf16x8){S_##l0[0], S_##l0[1], S_##l0[2], S_##l0[3], S_##h0[0], S_##h0[1], S_##h0[2], S_##h0[3]}, o[g], 0, 0, 0);   \
        o[g] = __builtin_amdgcn_mfma_f32_32x32x16_bf16(pa1, (bf16x8){S_##l1[0], S_##l1[1], S_##l1[2], S_##l1[3], S_##h1[0], S_##h1[1], S_##h1[2], S_##h1[3]}, o[g], 0, 0, 0);   \
        o[g] = __builtin_amdgcn_mfma_f32_32x32x16_bf16(pa2, (bf16x8){S_##l2[0], S_##l2[1], S_##l2[2], S_##l2[3], S_##h2[0], S_##h2[1], S_##h2[2], S_##h2[3]}, o[g], 0, 0, 0);   \
        o[g] = __builtin_amdgcn_mfma_f32_32x32x16_bf16(pa3, (bf16x8){S_##l3[0], S_##l3[1], S_##l3[2], S_##l3[3], S_##h3[0], S_##h3[1], S_##h3[2], S_##h3[3]}, o[g], 0, 0, 0); SBAR(); } while (0)
#define WW8() do { asm volatile("s_waitcnt lgkmcnt(8)" ::: "memory"); SBAR(); } while (0)
#define WPV(PAR) do { if constexpr (VAR == 2) { o[0][0] += (float)pa0[0] + (float)pa1[0] + (float)pa2[0] + (float)pa3[0]; break; } SBAR(); WRD(X, PAR, 0); WRD(Y, PAR, 1); WW8(); WMM(X, 0); WRD(X, PAR, 2); WW8(); WMM(Y, 1); WRD(Y, PAR, 3); WW8(); WMM(X, 2); WRD(X, PAR, 4); WW8(); WMM(Y, 3);    \
        WRD(Y, PAR, 5); WW8(); WMM(X, 4); WRD(X, PAR, 6); WW8(); WMM(Y, 5); WRD(Y, PAR, 7); WW8(); WMM(X, 6); asm volatile("s_waitcnt lgkmcnt(0)" ::: "memory"); SBAR(); WMM(Y, 7); } while (0)
    if (wid < 4) {
#define WSTEP_L(t, PAR) do { const bool more_ = (t) + 1 < NT; if (more_) WLOADK(((t) + 1) * KVBLK, 1 - PAR); WQKSM(t, PAR); WBARN(more_, 1); if (more_) WLOADV(((t) + 1) * KVBLK, 1 - PAR); WPV(PAR); WBARN(more_, 4); } while (0)
        for (int t = 0; t < NT; t += 2) { WSTEP_L(t, 0); WSTEP_L(t + 1, 1); }
        WBAR();
#undef WSTEP_L
    } else {
#define WSTEP_T(t, PAR) do { const bool more_ = (t) + 1 < NT; if (more_) WLOADK(((t) + 1) * KVBLK, 1 - PAR); if ((t) > 0) WPV(1 - PAR); WBARN(more_, 1); if (more_) WLOADV(((t) + 1) * KVBLK, 1 - PAR); WQKSM(t, PAR); WBARN(more_, 4); } while (0)
        for (int t = 0; t < NT; t += 2) { WSTEP_T(t, 0); WSTEP_T(t + 1, 1); }
        WPV(1); WBAR();
#undef WSTEP_T
    }
    if (hi == 0) li_l[r32] = l_reg; asm volatile("s_waitcnt lgkmcnt(0)" ::: "memory");
    float rli[16];
#pragma unroll
    for (int r = 0; r < 16; ++r) rli[r] = __builtin_amdgcn_rcpf(li_l[crow(r, hi)]);
    E(o, rli, wid, lane, r32, hi);
    __syncthreads();
#undef WBAR
#undef WBARN
#undef WQKSM
#undef WPV
#undef TRRD
#undef WRD
#undef WMM
#undef WW8
#undef WDMA
#undef WLOADK
#undef WLOADV
}
template <class Epi>
__device__ __forceinline__ void block_wide8(const BlockRef& cur, const bf16* V2, int skv, char* lds, Seam& S, const Epi& E) {
    int tid = threadIdx.x; asm volatile("" : "+v"(tid));
    const int wid = __builtin_amdgcn_readfirstlane(tid >> 6), lane = tid & 63, r32 = lane & 31, hi = lane >> 5;
    int j_hi = (cur.P0 + QB - 1) / KVBLK + 1; if (j_hi > skv / KVBLK) j_hi = skv / KVBLK;
    const int NT = j_hi;
    const int qlo = cur.P0 + wid * QBLK, qm = qlo + r32 - 8 * hi;
    char* V_lds = lds; char* K_lds = lds + 4 * SHM_V;
    float* ws = (float*)(lds + WIDE_WS) + wid * 64; float* li_l = ws, * al_l = ws + 32;
    float m_reg = -1e30f, l_reg = 0; f32x16 o[8] = {};
    const int krow = 8 * wid + (lane >> 3), krp = krow & 31, kt = (krp & 3) + 4 * (krp >> 3) + 16 * (krow >> 5), kkey = 16 * (kt & 3) + (kt >> 2) + 8 * ((krp >> 2) & 1);
    const unsigned koff = (unsigned)(kkey * 128 + (((lane & 7) ^ ((krow >> 1) & 7)) << 4));
    const int vc = 16 * wid + (lane >> 2);
    const unsigned voff = (unsigned)(vc * 64 + (((lane & 3) ^ ((vc >> 2) & 3)) << 4));
    const char* Kh = (const char*)cur.K; const char* Va = (const char*)cur.V; const char* Vb = (const char*)V2;
    typedef __attribute__((address_space(3))) unsigned* lds_uptr;
#define WLOADK(t_, par) __builtin_amdgcn_global_load_lds((const unsigned*)(Kh + (size_t)(t_) * (KVBLK * D) + koff), (lds_uptr)(K_lds + (par) * SHM_K + wid * 1024), 16, 0, 0)
#define WLOADV(t_, par) do { __builtin_amdgcn_global_load_lds((const unsigned*)(Va + (size_t)(t_) * 8192 + voff), (lds_uptr)(V_lds + (2 * (par)) * SHM_V + wid * 1024), 16, 0, 0);      \
                             __builtin_amdgcn_global_load_lds((const unsigned*)(Vb + (size_t)(t_) * 8192 + voff), (lds_uptr)(V_lds + (2 * (par) + 1) * SHM_V + wid * 1024), 16, 0, 0); } while (0)
    i32x8 q8[2];
    { const i32x4* qp = (const i32x4*)((const char*)cur.Q + (size_t)(wid * QBLK + r32) * D + hi * 32);
#pragma unroll
      for (int c = 0; c < 2; ++c) { const i32x4 lo_ = qp[4 * c], hi_ = qp[4 * c + 1]; q8[c] = (i32x8){lo_[0], lo_[1], lo_[2], lo_[3], hi_[0], hi_[1], hi_[2], hi_[3]}; } }
    WLOADK(0, 0); WLOADV(0, 0); VMW();
    __syncthreads();
    f32x16 p0, p1; float mn, al; i32x8 pa8;
    typedef const __attribute__((address_space(3))) bf16x8* lds_f;
    const unsigned vsw = (unsigned)((r32 >> 2) & 3), va0 = (unsigned)(__UINTPTR_TYPE__)V_lds + (unsigned)(r32 * 64) + (((unsigned)(2 * hi) ^ vsw) << 4), va1 = (unsigned)(__UINTPTR_TYPE__)V_lds + (unsigned)(r32 * 64) + (((unsigned)(2 * hi + 1) ^ vsw) << 4);
#define VF8(PAR, g) __builtin_bit_cast(i32x8, __builtin_shufflevector(*(lds_f)(__UINTPTR_TYPE__)(va0 + (2 * (PAR) + ((g) >> 2)) * SHM_V + ((g) & 3) * 2048),                       \
                                                                      *(lds_f)(__UINTPTR_TYPE__)(va1 + (2 * (PAR) + ((g) >> 2)) * SHM_V + ((g) & 3) * 2048), 0, 1, 2, 3, 4, 5, 6, 7, 8, 9, 10, 11, 12, 13, 14, 15))
#define MM8(g, f_) asm volatile("v_mfma_f32_32x32x64_f8f6f4 %0, %1, %2, %0" : "+v"(o[g]) : "v"(pa8), "v"(f_))
#define WBAR() do { asm volatile("s_waitcnt vmcnt(0) lgkmcnt(0)" ::: "memory"); __builtin_amdgcn_s_barrier(); asm volatile("" ::: "memory"); } while (0)
#define WBARN(more, n) do { if (more) asm volatile("s_waitcnt vmcnt(" #n ") lgkmcnt(0)" ::: "memory"); else asm volatile("s_waitcnt vmcnt(0) lgkmcnt(0)" ::: "memory");                 \
        __builtin_amdgcn_s_barrier(); asm volatile("" ::: "memory"); } while (0)
#define WQKSM(t, PAR) do { __builtin_amdgcn_s_setprio(1);                                                                                          \
        qkt_f8<PAR, true>(p0, p1, K_lds, r32, hi, q8);                                                                                                   \
        { const int kb_ = (t) * KVBLK; if (kb_ + KVBLK - 1 > qlo) mask_tile_perm(p0, p1, qm - kb_); }                                              \
        partialSM<8, 2, 5>(p0, p1, m_reg, mn, al);                                                                                                 \
        if (__any(al < 1.f)) { if (hi == 0) al_l[r32] = al; asm volatile("s_waitcnt lgkmcnt(0)" ::: "memory");                                     \
            for (int d_ = 0; d_ < 8; ++d_) for (int r = 0; r < 16; ++r) o[d_][r] *= al_l[crow(r, hi)]; }                                            \
        finishSM8(p0, p1, al, l_reg, pa8);                                                                                                         \
        __builtin_amdgcn_s_setprio(0); SBAR(); } while (0)
#define WPV(PAR) do { SBAR(); i32x8 f0_ = VF8(PAR, 0), f1_ = VF8(PAR, 1); SBAR(); MM8(0, f0_); f0_ = VF8(PAR, 2); SBAR(); MM8(1, f1_); f1_ = VF8(PAR, 3); SBAR(); MM8(2, f0_); f0_ = VF8(PAR, 4); SBAR();   \
        MM8(3, f1_); f1_ = VF8(PAR, 5); SBAR(); MM8(4, f0_); f0_ = VF8(PAR, 6); SBAR(); MM8(5, f1_); f1_ = VF8(PAR, 7); SBAR(); MM8(6, f0_); MM8(7, f1_);                                                  \
        asm volatile("s_nop 15\n\ts_nop 15" ::: "memory"); SBAR(); } while (0)
    if (wid < 4) {
#define WSTEP_L(t, PAR) do { const bool more_ = (t) + 1 < NT; if (more_) WLOADK((t) + 1, 1 - PAR); WQKSM(t, PAR); WBARN(more_, 1); if (more_) WLOADV((t) + 1, 1 - PAR); WPV(PAR); WBARN(more_, 2); } while (0)
        for (int t = 0; t < NT; t += 2) { WSTEP_L(t, 0); WSTEP_L(t + 1, 1); }
        WBAR();
#undef WSTEP_L
    } else {
#define WSTEP_T(t, PAR) do { const bool more_ = (t) + 1 < NT; if (more_) WLOADK((t) + 1, 1 - PAR); if ((t) > 0) WPV(1 - PAR); WBARN(more_, 1); if (more_) WLOADV((t) + 1, 1 - PAR); WQKSM(t, PAR); WBARN(more_, 2); } while (0)
        for (int t = 0; t < NT; t += 2) { WSTEP_T(t, 0); WSTEP_T(t + 1, 1); }
        WPV(1); WBAR();
#undef WSTEP_T
    }
    if (hi == 0) li_l[r32] = l_reg; asm volatile("s_waitcnt lgkmcnt(0)" ::: "memory");
    float rli[16];
#pragma unroll
    for (int r = 0; r < 16; ++r) rli[r] = __builtin_amdgcn_rcpf(li_l[crow(r, hi)]) * (1.0f / 16.0f);
    E(o, rli, wid, lane, r32, hi);
    __syncthreads();
#undef WLOADK
#undef WLOADV
#undef VF8
#undef MM8
#undef WBAR
#undef WBARN
#undef WQKSM
#undef WPV
}
#undef ROW
#undef VMW
#undef SLOAD_H
#undef SWRITE_HK
#undef SWRITE_HV
#undef SWRITE_H

template <int X> __device__ __forceinline__ float swz_xor(float v) {
    return __int_as_float(__builtin_amdgcn_ds_swizzle(__float_as_int(v), (X << 10) | 0x1f));
}
__device__ __forceinline__ float half_sum(float s) {
    s += swz_xor<1>(s); s += swz_xor<2>(s); s += swz_xor<4>(s); s += swz_xor<8>(s); s += swz_xor<16>(s); return s;
}
__device__ __forceinline__ void store_pair(bf16* p, float v, int r32) {
    const float vn = swz_xor<1>(v);
    if ((r32 & 1) == 0) *(unsigned*)p = cvtpk(v, vn);
}
__device__ __forceinline__ void store_quad8(unsigned char* p, float v, int r32) {
    v = fminf(fmaxf(v, -448.f), 448.f);
    const float v1 = swz_xor<1>(v);
    const int w = __builtin_amdgcn_cvt_pk_fp8_f32(v, v1, 0, false);
    const int w2 = __builtin_amdgcn_ds_swizzle(w, (2 << 10) | 0x1f);
    if ((r32 & 3) == 0) *(unsigned*)p = ((unsigned)w & 0xffffu) | ((unsigned)w2 << 16);
}
struct EpiSelf {
    int mode, vh;
    unsigned char* out;
    const float* gain;
    float* scr;
    float* ssq;
    float lam;
    __device__ __forceinline__ void operator()(f32x16 (&o)[4], const float (&rli)[16], int wid, int lane, int r32, int hi) const {
        asm volatile("" : "+v"(lane), "+v"(r32), "+v"(hi));
        unsigned char* base = out + (size_t)(wid * QBLK) * 4096;
        if (mode == 0) {
            float rn[16];
#pragma unroll
            for (int r = 0; r < 16; ++r) { float s = 0.f;
#pragma unroll
                for (int d0 = 0; d0 < 4; ++d0) { const float v = o[d0][r] * rli[r]; o[d0][r] = v; s += v * v; }
                s = half_sum(s); rn[r] = rsqrtf(s * (1.0f / 128.0f) + 1e-5f); }
            float g[4];
#pragma unroll
            for (int d0 = 0; d0 < 4; ++d0) g[d0] = gain[d0 * 32 + r32];
#pragma unroll
            for (int r = 0; r < 16; ++r)
#pragma unroll
                for (int d0 = 0; d0 < 4; ++d0) store_quad8(base + (size_t)crow(r, hi) * 4096 + d0 * 32 + r32, o[d0][r] * rn[r] * g[d0], r32);
        } else if (mode == 1) {
            float* p = scr + vh * 4096 + lane;
#pragma unroll
            for (int r = 0; r < 16; ++r)
#pragma unroll
                for (int d0 = 0; d0 < 4; ++d0) p[(r * 4 + d0) * 64] = o[d0][r] * rli[r];
        } else {
            float* p = scr + vh * 4096 + lane;
            float rn[16];
#pragma unroll
            for (int r = 0; r < 16; ++r) { float s = 0.f;
#pragma unroll
                for (int d0 = 0; d0 < 4; ++d0) { const float t = p[(r * 4 + d0) * 64]; const float dd = t - lam * (o[d0][r] * rli[r]); o[d0][r] = dd; s += dd * dd;
                    if (vh == 0) p[(r * 4 + d0) * 64] = dd; }
                s = half_sum(s);
                if (vh == 0) { if (r32 == 0) ssq[crow(r, hi)] = s; rn[r] = 0.f; }
                else rn[r] = rsqrtf((s + ssq[crow(r, hi)]) * (1.0f / 256.0f) + 1e-5f) * 0.8f; }
            if (vh == 1) {
                float g[4];
#pragma unroll
                for (int d0 = 0; d0 < 4; ++d0) g[d0] = gain[128 + d0 * 32 + r32];
#pragma unroll
                for (int r = 0; r < 16; ++r)
#pragma unroll
                    for (int d0 = 0; d0 < 4; ++d0) store_quad8(base + (size_t)crow(r, hi) * 4096 + 128 + d0 * 32 + r32, o[d0][r] * rn[r] * g[d0], r32);
                const float* pa = scr + lane;
#pragma unroll
                for (int d0 = 0; d0 < 4; ++d0) g[d0] = gain[d0 * 32 + r32];
#pragma unroll
                for (int r = 0; r < 16; ++r)
#pragma unroll
                    for (int d0 = 0; d0 < 4; ++d0) store_quad8(base + (size_t)crow(r, hi) * 4096 + d0 * 32 + r32, pa[(r * 4 + d0) * 64] * rn[r] * g[d0], r32);
            }
        }
    }
};
__device__ __forceinline__ float mul_ns(float a, float b) { float r; asm("v_mul_f32 %0, %1, %2" : "=v"(r) : "v"(a), "v"(b)); return r; }
__device__ __forceinline__ float fma_ns(float a, float b, float c) { float r; asm("v_fma_f32 %0, %1, %2, %3" : "=v"(r) : "v"(a), "v"(b), "v"(c)); return r; }
struct EpiWide {
    int mode;
    unsigned char* out;
    const float* gain;
    float* scr;
    float lam;
    __device__ __forceinline__ void operator()(f32x16 (&o)[8], const float (&rli)[16], int wid, int lane, int r32, int hi) const {
        asm volatile("" : "+v"(lane), "+v"(r32), "+v"(hi));
        const unsigned ul = (unsigned)lane;
        unsigned* const scw = (unsigned*)scr;
        if (mode == 1) {
#pragma unroll
            for (int r = 0; r < 16; ++r)
#pragma unroll
                for (int k = 0; k < 4; ++k) (scw + (r * 4 + k) * 64)[ul] = cvtpk(mul_ns(o[2 * k][r], rli[r]), mul_ns(o[2 * k + 1][r], rli[r]));
        } else {
            unsigned char* base = out + (size_t)(wid * QBLK) * 4096; const unsigned uo = (unsigned)(hi * 4 * 4096 + r32);
            const float nlam = -lam;
            float rn[16];
#pragma unroll
            for (int rb = 0; rb < 16; rb += 4) { unsigned tw[4][4];
#pragma unroll
                for (int q = 0; q < 4; ++q)
#pragma unroll
                    for (int k = 0; k < 4; ++k) tw[q][k] = (scw + ((rb + q) * 4 + k) * 64)[ul];
                asm volatile("" ::: "memory"); SBAR();
#pragma unroll
                for (int q = 0; q < 4; ++q) { const int r = rb + q; float s = 0.f;
#pragma unroll
                    for (int d0 = 0; d0 < 8; ++d0) { const float t = __uint_as_float((d0 & 1) ? (tw[q][d0 >> 1] & 0xffff0000u) : (tw[q][d0 >> 1] << 16));
                        const float dd = fma_ns(nlam, mul_ns(o[d0][r], rli[r]), t); s = fma_ns(dd, dd, s); }
                    s = half_sum(s); rn[r] = rsqrtf(s * (1.0f / 256.0f) + 1e-5f) * 0.8f; }
                asm volatile("" ::: "memory"); SBAR(); }
            float g[8];
#pragma unroll
            for (int d0 = 0; d0 < 8; ++d0) g[d0] = gain[d0 * 32 + r32];
#pragma unroll
            for (int rb = 0; rb < 16; rb += 4) { unsigned tw[4][4];
#pragma unroll
                for (int q = 0; q < 4; ++q)
#pragma unroll
                    for (int k = 0; k < 4; ++k) tw[q][k] = (scw + ((rb + q) * 4 + k) * 64)[ul];
                asm volatile("" ::: "memory"); SBAR();
#pragma unroll
                for (int q = 0; q < 4; ++q) { const int r = rb + q;
#pragma unroll
                    for (int d0 = 0; d0 < 8; ++d0) { const float t = __uint_as_float((d0 & 1) ? (tw[q][d0 >> 1] & 0xffff0000u) : (tw[q][d0 >> 1] << 16));
                        const float dd = fma_ns(nlam, mul_ns(o[d0][r], rli[r]), t);
                        store_quad8(base + (crow(r, 0) * 4096 + d0 * 32) + uo, mul_ns(mul_ns(dd, rn[r]), g[d0]), r32); } }
                asm volatile("" ::: "memory"); SBAR(); }
        }
    }
};
struct EpiNull {
    float* scr;
    __device__ __forceinline__ void operator()(f32x16 (&o)[8], const float (&rli)[16], int wid, int lane, int r32, int hi) const {
        float a = 0.f;
#pragma unroll
        for (int d0 = 0; d0 < 8; ++d0)
#pragma unroll
            for (int r = 0; r < 16; ++r) a += o[d0][r] * rli[r];
        if (a == 123.456f) scr[lane] = a;
    }
};
struct EpiMem {
    unsigned char* out;
    __device__ __forceinline__ void operator()(f32x16 (&o)[4], const float (&rli)[16], int wid, int lane, int r32, int hi) const {
        asm volatile("" : "+v"(lane), "+v"(r32), "+v"(hi));
        unsigned char* base = out + (size_t)(wid * QBLK) * 512;
#pragma unroll
        for (int r = 0; r < 16; ++r)
#pragma unroll
            for (int d0 = 0; d0 < 4; ++d0) store_quad8(base + (size_t)crow(r, hi) * 512 + d0 * 32 + r32, o[d0][r] * rli[r] * 16.f, r32);
    }
};
__device__ __forceinline__ unsigned moba_select(const Seam& S, const float* KM, int qb, int r32, int hi) {
    asm volatile("" : "+v"(r32), "+v"(hi));
    f32x16 g = f32x16{};
#pragma unroll
    for (int d0 = 0; d0 < 8; ++d0) { const float* kp = KM + (size_t)(r32 & 15) * 128 + d0 * 16 + hi * 8; const bf16x8 kf = pack8(*(const f32x4*)kp * (1.0f / 256.0f), *(const f32x4*)(kp + 4) * (1.0f / 256.0f));
        g = __builtin_amdgcn_mfma_f32_32x32x16_bf16(kf, S.qr[d0], g, 0, 0, 0); }
    const float NEG = -__builtin_inff();
    float gate[16];
#pragma unroll
    for (int r = 0; r < 8; ++r) { const float own = g[r]; const auto sw = __builtin_amdgcn_permlane32_swap(__float_as_uint(own), __float_as_uint(own), false, false);
        const float oth = __uint_as_float(hi ? sw[0] : sw[1]);
        const int blk = (r & 3) + 8 * (r >> 2);
        gate[blk] = hi ? oth : own; gate[blk + 4] = hi ? own : oth; }
#pragma unroll
    for (int blk = 0; blk < 16; ++blk) gate[blk] = (blk < qb) ? gate[blk] : NEG;
    unsigned sel = 0u;
#pragma unroll
    for (int k = 0; k < 3; ++k) { float best = NEG; int bi = 16;
#pragma unroll
        for (int blk = 0; blk < 16; ++blk) if (gate[blk] > best) { best = gate[blk]; bi = blk; }
        sel |= (bi < 16) ? (1u << bi) : 0u;
#pragma unroll
        for (int blk = 0; blk < 16; ++blk) gate[blk] = (blk == bi) ? NEG : gate[blk]; }
    return sel;
}
__device__ __forceinline__ void q8_from_qr(Seam& S) {
#pragma unroll
    for (int c = 0; c < 2; ++c)
#pragma unroll
        for (int dd = 0; dd < 4; ++dd) { const bf16x8 v = S.qr[4 * c + dd]; float f[8];
#pragma unroll
            for (int j = 0; j < 8; ++j) f[j] = __builtin_amdgcn_fmed3f(__uint_as_float(((unsigned)(unsigned short)v[j]) << 16) * 16.f, -448.f, 448.f);
            int w0 = 0, w1 = 0;
            w0 = __builtin_amdgcn_cvt_pk_fp8_f32(f[0], f[1], w0, false); w0 = __builtin_amdgcn_cvt_pk_fp8_f32(f[2], f[3], w0, true);
            w1 = __builtin_amdgcn_cvt_pk_fp8_f32(f[4], f[5], w1, false); w1 = __builtin_amdgcn_cvt_pk_fp8_f32(f[6], f[7], w1, true);
            S.q8[c][2 * dd] = w0; S.q8[c][2 * dd + 1] = w1; }
}
}

#ifndef MK_N_LAUNCHES
#define MK_N_LAUNCHES 1
#endif
constexpr int NWAVES = 8;
constexpr int NPHASE = 11;
constexpr int N_LAUNCHES = MK_N_LAUNCHES;
constexpr int BATCH = 4, SEQ = 4096, DMODEL = 4096, MTOK = BATCH * SEQ, NPROJ = 12288, MEMLEN = 256, MEMW = 512, DFF = 16384;
constexpr size_t MiB = 1u << 20;
constexpr size_t WS_CTL = 0, CTL_ZERO_BYTES = 1 * MiB;
constexpr size_t WS_ROPE = 1 * MiB;
constexpr size_t WS_SS0 = WS_ROPE + 512 * 1024;
constexpr size_t WS_KMEAN = WS_SS0 + 128 * 1024;
constexpr size_t WS_WUP = 4 * MiB, WS_WDOWN = 136 * MiB;
constexpr size_t WS_XB8 = 68 * MiB;
constexpr size_t WS_XB = 260 * MiB;
constexpr size_t WS_WOUT = 396 * MiB, WS_WCQKV = 428 * MiB, WS_WCO = 440 * MiB;
constexpr size_t WS_QKV = 444 * MiB;
constexpr size_t WS_MERGED = 828 * MiB, WS_WIN = 828 * MiB;
constexpr size_t WS_QC = 444 * MiB, WS_KC = 460 * MiB, WS_VC = 461 * MiB, WS_OC = 462 * MiB;
constexpr size_t WS_SCR = 892 * MiB;
constexpr size_t WS_U = 444 * MiB;
constexpr size_t WS_END = 956 * MiB;
constexpr int CW_TMO = 0, CW_CODE = 1, CW_QUEUE = 64, CW_BAR = 4096, CW_SS1 = 8192, CW_SS2 = CW_SS1 + 16384, CW_SS3 = CW_SS2 + 16384, CW_KMF = 81920;
static_assert(CW_SS3 + 2 * 16384 <= CW_KMF && (CW_KMF + 131072) * 4 <= (int)CTL_ZERO_BYTES, "CTL words inside the memset region");
constexpr int RING_OFF = 0, RING_BYTES = 131072;
constexpr int LDSCTL_OFF = 135168, MISC_OFF = LDSCTL_OFF + 320;
constexpr int LDS_BYTES = 147456;
static_assert(att::LDS_BYTES <= RING_BYTES && att::WIDE_BYTES <= RING_BYTES, "attention LDS");

#define GAS __attribute__((address_space(1)))
#define LAS __attribute__((address_space(3)))
typedef unsigned short bf16;
typedef unsigned v4u __attribute__((ext_vector_type(4)));
typedef unsigned v2u __attribute__((ext_vector_type(2)));
typedef float f32x4 __attribute__((ext_vector_type(4)));
typedef GAS unsigned gu32;
#define RLX_AGENT __ATOMIC_RELAXED, __HIP_MEMORY_SCOPE_AGENT
#define LDS_WAIT() asm volatile("s_waitcnt lgkmcnt(0)" ::: "memory")
#define VM_WAIT() asm volatile("s_waitcnt vmcnt(0)" ::: "memory")
__device__ __forceinline__ unsigned f2bf(float f) { unsigned u = __builtin_bit_cast(unsigned, f); return (u + 0x7fffu + ((u >> 16) & 1u)) >> 16; }
__device__ __forceinline__ unsigned pk2(float lo, float hi) { return f2bf(lo) | (f2bf(hi) << 16); }

#define XB_TMO      128
#define XB_XCNT(j)  (256  + 64 * (j))
#define XB_XSUB(j)  (1280 + 64 * (j))
#define XB_XGEN(j)  (2304 + 64 * (j))
#define XB_TOP      3328
#define XB_TOPGEN   3392
#define XCD_BAR_WORDS 3456
#define XB_SPIN_CAP (1u << 18)

__device__ __forceinline__ unsigned xb_ld(unsigned* p)              { return __hip_atomic_load(p, __ATOMIC_RELAXED, __HIP_MEMORY_SCOPE_AGENT); }
__device__ __forceinline__ unsigned xb_add(unsigned* p, unsigned v) { return __hip_atomic_fetch_add(p, v, __ATOMIC_RELAXED, __HIP_MEMORY_SCOPE_AGENT); }
__device__ __forceinline__ unsigned xb_xcc_id() { return (unsigned)__builtin_amdgcn_s_getreg((3 << 11) | 20) & 0xFu; }
#define XB_SPIN(cond, bar) do { unsigned _sp = 0; while (cond) { __builtin_amdgcn_s_sleep(1); \
    if ((++_sp & 255u) == 0u) { if (xb_ld(&(bar)[XB_TMO])) break; if (_sp > XB_SPIN_CAP) { atomicAdd(&(bar)[XB_TMO], 1u); break; } } } } while (0)

struct XcdBarrier {
    unsigned* bar; unsigned x;
    volatile LAS unsigned* st;
};

__device__ __forceinline__ XcdBarrier xcd_barrier_post(unsigned* bar, volatile LAS unsigned* st) {
    XcdBarrier b; b.bar = bar; b.x = xb_xcc_id(); b.st = st;
    if (threadIdx.x == 0) (void)xb_add(&bar[XB_XCNT(b.x)], 1u);
    return b;
}
__device__ __forceinline__ void xcd_barrier_complete(unsigned* bar, unsigned x, unsigned& nloc, unsigned& nx) {
    const unsigned G = gridDim.x * gridDim.y * gridDim.z;
    unsigned sum, cnt, mine, sp = 0u;
    for (;;) {
        sum = 0u; cnt = 0u; mine = 0u;
#pragma unroll
        for (unsigned j = 0; j < 16; ++j) { const unsigned c = xb_ld(&bar[XB_XCNT(j)]); sum += c; cnt += (c > 0u) ? 1u : 0u; mine = (j == x) ? c : mine; }
        if (sum == G) break;
        __builtin_amdgcn_s_sleep(1);
        if ((++sp & 255u) == 0u) { if (xb_ld(&bar[XB_TMO])) break; if (sp > XB_SPIN_CAP) { atomicAdd(&bar[XB_TMO], 1u); break; } }
    }
    nloc = mine > 0u ? mine : 1u; nx = cnt > 0u ? cnt : 1u;
}

__device__ __forceinline__ void xcd_barrier(const XcdBarrier& b) {
    asm volatile("s_waitcnt vmcnt(0)" ::: "memory");
    __syncthreads();
    if (threadIdx.x == 0) {
        unsigned* bar = b.bar;
        __builtin_amdgcn_s_waitcnt(0);
        unsigned nloc = b.st[0], nx = b.st[1];
        if (nloc == 0u) { xcd_barrier_complete(bar, b.x, nloc, nx); b.st[0] = nloc; b.st[1] = nx; }
        const unsigned old = xb_add(&bar[XB_XSUB(b.x)], 1u);
        const unsigned gen = old / nloc;
        if (old + 1u == (gen + 1u) * nloc) {
            __builtin_amdgcn_fence(__ATOMIC_RELEASE, "agent");
            asm volatile("s_waitcnt vmcnt(0)" ::: "memory");
            const unsigned og = xb_add(&bar[XB_TOP], 1u);
            const unsigned tg = og / nx;
            if (og + 1u == (tg + 1u) * nx) xb_add(&bar[XB_TOPGEN], 1u);
            else XB_SPIN(xb_ld(&bar[XB_TOPGEN]) == tg, bar);
            __builtin_amdgcn_fence(__ATOMIC_ACQUIRE, "agent");
            xb_add(&bar[XB_XGEN(b.x)], 1u);
            asm volatile("s_waitcnt vmcnt(0)" ::: "memory");
        } else {
            XB_SPIN(xb_ld(&bar[XB_XGEN(b.x)]) == gen, bar);
            __builtin_amdgcn_fence(__ATOMIC_ACQUIRE, "agent");
            asm volatile("s_waitcnt vmcnt(0)" ::: "memory");
        }
    }
    __syncthreads();
}


__device__ __forceinline__ float wave_sum(float v) {
#pragma unroll
    for (int o = 1; o < 64; o <<= 1) v += __shfl_xor(v, o);
    return v;
}
__device__ __forceinline__ void p0_transpose_item(const float* W, int K, int N, const float* gk, bf16* WT, int row_off, LAS float* scr, int item, int lane, int ldw = 0) {
    const int nblk = N / 64, kb = item / nblk, nb = item - kb * nblk, k0 = 64 * kb, n0 = 64 * nb; if (ldw == 0) ldw = N;
    const int c4 = lane & 15, kq = lane >> 4;
#pragma unroll 4
    for (int i = 0; i < 16; ++i) { const int kk = 4 * i + kq;
        f32x4 v = __builtin_nontemporal_load((const GAS f32x4*)(W + (size_t)(k0 + kk) * ldw + n0 + 4 * c4));
        if (gk) v = v * gk[k0 + kk];
        LAS float* d = scr + kk * 65 + 4 * c4; d[0] = v[0]; d[1] = v[1]; d[2] = v[2]; d[3] = v[3]; }
    LDS_WAIT(); asm volatile("" ::: "memory");
    const int c = lane & 7;
#pragma unroll
    for (int j = 0; j < 8; ++j) { const int n = (lane >> 3) + 8 * j; const LAS float* s = scr + (8 * c) * 65 + n;
        v4u o; o.x = pk2(s[0 * 65], s[1 * 65]); o.y = pk2(s[2 * 65], s[3 * 65]); o.z = pk2(s[4 * 65], s[5 * 65]); o.w = pk2(s[6 * 65], s[7 * 65]);
        *(GAS v4u*)(WT + (size_t)(row_off + n0 + n) * K + k0 + 8 * c) = o; }
    LDS_WAIT(); asm volatile("" ::: "memory");
}
__device__ __forceinline__ void p0_transpose_item_f8(const float* W, int K, int N, const float* gk, float scale, unsigned char* WT, LAS float* scr, int item, int lane, int ldw = 0) {
    const int nblk = N / 64, kb = item / nblk, nb = item - kb * nblk, k0 = 64 * kb, n0 = 64 * nb; if (ldw == 0) ldw = N;
    const int c4 = lane & 15, kq = lane >> 4;
#pragma unroll 4
    for (int i = 0; i < 16; ++i) { const int kk = 4 * i + kq;
        f32x4 v = __builtin_nontemporal_load((const GAS f32x4*)(W + (size_t)(k0 + kk) * ldw + n0 + 4 * c4));
        v = v * (gk ? gk[k0 + kk] * scale : scale);
        LAS float* d = scr + kk * 65 + 4 * c4; d[0] = v[0]; d[1] = v[1]; d[2] = v[2]; d[3] = v[3]; }
    LDS_WAIT(); asm volatile("" ::: "memory");
    const int c = lane & 3;
#pragma unroll
    for (int j = 0; j < 4; ++j) { const int n = (lane >> 2) + 16 * j; const LAS float* s = scr + (16 * c) * 65 + n;
        v4u o; o.x = pg8::pk4_fp8(s[0 * 65], s[1 * 65], s[2 * 65], s[3 * 65]); o.y = pg8::pk4_fp8(s[4 * 65], s[5 * 65], s[6 * 65], s[7 * 65]);
        o.z = pg8::pk4_fp8(s[8 * 65], s[9 * 65], s[10 * 65], s[11 * 65]); o.w = pg8::pk4_fp8(s[12 * 65], s[13 * 65], s[14 * 65], s[15 * 65]);
        *(GAS v4u*)(WT + ((size_t)((n0 + n) >> 4) * (K >> 5) + ((k0 + 16 * c) >> 5)) * 512 + ((n0 + n) & 15) * 32 + ((16 * c) & 31)) = o; }
    LDS_WAIT(); asm volatile("" ::: "memory");
}
__device__ __forceinline__ void cos_sin_d(float angf, float& co, float& si) {
    const double a = (double)angf;
    const double kd = __builtin_rint(a * 0.6366197723675814);
    const double r = __builtin_fma(-kd, 1.5707963267948966, a) - kd * 6.123233995736766e-17;
    const double r2 = r * r;
    const double sp = r * (1.0 + r2 * (-1.0 / 6 + r2 * (1.0 / 120 + r2 * (-1.0 / 5040 + r2 * (1.0 / 362880 + r2 * (-1.0 / 39916800 + r2 * (1.0 / 6227020800.0)))))));
    const double cp = 1.0 + r2 * (-0.5 + r2 * (1.0 / 24 + r2 * (-1.0 / 720 + r2 * (1.0 / 40320 + r2 * (-1.0 / 3628800 + r2 * (1.0 / 479001600 + r2 * (-1.0 / 87178291200.0)))))));
    const int q = (int)((long long)kd & 3);
    const double c = (q == 0) ? cp : (q == 1) ? -sp : (q == 2) ? -cp : sp;
    const double s = (q == 0) ? sp : (q == 1) ? cp : (q == 2) ? -sp : -cp;
    co = (float)c; si = (float)s;
}

struct Args { const float* in[20]; float* out; unsigned char* ws; int ph_lo, ph_hi; };
__global__ void __launch_bounds__(NWAVES * 64, 2) mk_fwd(Args args) {
    extern __shared__ __attribute__((aligned(16))) unsigned char lds[];
    LAS unsigned char* const ldsl = (LAS unsigned char*)lds;
    volatile LAS unsigned* const MISC = (volatile LAS unsigned*)(ldsl + MISC_OFF);
    const int tid = threadIdx.x, lane = tid & 63, wave = __builtin_amdgcn_readfirstlane(tid >> 6);
    const int G = gridDim.x; const int bx = blockIdx.x;
    const int vcu = (G % 8 == 0) ? (bx % 8) * (G / 8) + bx / 8 : bx;
    unsigned char* const ws = args.ws;
    gu32* const ctl = (gu32*)(ws + WS_CTL);
    const float* x = args.in[0]; const float* mem = args.in[1]; const float* ln_mix_g = args.in[2]; const float* w_in = args.in[3]; const float* moba_out_g = args.in[4];
    const float* lq1 = args.in[5]; const float* lk1 = args.in[6]; const float* lq2 = args.in[7]; const float* lk2 = args.in[8]; const float* subln_g = args.in[9];
    const float* w_out = args.in[10]; const float* ln_cross_g = args.in[11]; const float* ln_mem_g = args.in[12]; const float* w_cq = args.in[13]; const float* w_ckv = args.in[14];
    const float* w_co = args.in[15]; const float* ln_mlp_g = args.in[16]; const float* w_up = args.in[17]; const float* w_down = args.in[18]; const float* final_g = args.in[19];
    float* const out = args.out;
    bf16* const W_INA_T = (bf16*)(ws + WS_WIN); unsigned char* const W_IN8 = ws + WS_WIN + 32 * MiB; unsigned char* const X8 = ws + WS_XB8; unsigned char* const W_OUT8 = ws + WS_WOUT; unsigned char* const W_CQKV8 = ws + WS_WCQKV; bf16* const W_CO_T = (bf16*)(ws + WS_WCO);
    unsigned char* const W_UP8 = ws + WS_WUP; unsigned char* const W_DN8 = ws + WS_WDOWN; unsigned char* const XB8 = ws + WS_XB8; unsigned char* const U8 = ws + WS_U;
    bf16* const XB = (bf16*)(ws + WS_XB); bf16* const QKV = (bf16*)(ws + WS_QKV); unsigned char* const MERGED8 = ws + WS_MERGED;
    bf16* const QC = (bf16*)(ws + WS_QC); bf16* const KC = (bf16*)(ws + WS_KC); bf16* const VC = (bf16*)(ws + WS_VC); bf16* const OC = (bf16*)(ws + WS_OC);
    float* const KMF = (float*)(ws + WS_CTL) + CW_KMF;
    float* const ROPE = (float*)(ws + WS_ROPE); float* const SS0 = (float*)(ws + WS_SS0);
    float* const SS1 = (float*)(ws + WS_CTL) + CW_SS1; float* const SS2 = (float*)(ws + WS_CTL) + CW_SS2; float* const SS3 = (float*)(ws + WS_CTL) + CW_SS3;
    float* const SCR = (float*)(ws + WS_SCR);

    for (int u = tid; u < (LDS_BYTES - LDSCTL_OFF) / 4; u += NWAVES * 64) ((LAS unsigned*)(ldsl + LDSCTL_OFF))[u] = 0u;
    __syncthreads();
    const int lo = args.ph_lo, hi_ph = args.ph_hi;
    XcdBarrier bar; bar.bar = (unsigned*)(ctl + CW_BAR); bar.x = 0; bar.st = nullptr;
    if (hi_ph - lo > 1) bar = xcd_barrier_post((unsigned*)(ctl + CW_BAR), MISC + 8);
#ifndef REPEAT_MASK
#define REPEAT_MASK 0
#endif
#define NREP(k) (1 + ((REPEAT_MASK >> (k)) & 1))
#ifndef PHASE_MASK
#define PHASE_MASK 0x7ff
#endif
#define IN(k) (((PHASE_MASK >> (k)) & 1) && lo <= (k) && (k) < hi_ph)
#define BOTH(k) (IN(k) && IN((k) + 1))
#define GRID_BAR(k) do { if (BOTH(k)) xcd_barrier(bar); } while (0)
    const int gw = vcu * NWAVES + wave, NGW = G * NWAVES;
    constexpr int I_INA = 64 * 64, I_INB = 64 * 128, I_OUT = 64 * 64, I_CQ = 64 * 8, I_CKV = 64 * 16, I_CO = 8 * 64, I_UP = 64 * 256, I_DN = 256 * 64;
    constexpr int ND = I_OUT + I_CQ + I_CKV + I_CO + I_UP + I_DN;

    if (IN(0)) for (int rep = 0; rep < NREP(0); ++rep) {
        LAS float* scr = (LAS float*)(ldsl + RING_OFF + wave * 16640);
        constexpr int NITEMS = I_INA + I_INB;
        for (int it = gw; it < NITEMS; it += NGW) {
            int r = it;
            if (r < I_INA) { p0_transpose_item(w_in, DMODEL, 4096, ln_mix_g, W_INA_T, 0, scr, r, lane, NPROJ); continue; } r -= I_INA;
            p0_transpose_item_f8(w_in + 4096, DMODEL, 8192, ln_mix_g, 64.f, W_IN8, scr, r, lane, NPROJ);
        }
        for (int m = gw; m < MTOK; m += NGW) {
            const GAS f32x4* xr = (const GAS f32x4*)(x + (size_t)m * DMODEL) + lane;
            f32x4 v[16]; float s = 0.f;
#pragma unroll
            for (int j = 0; j < 16; ++j) { v[j] = __builtin_nontemporal_load(xr + 64 * j); s += (v[j].x * v[j].x + v[j].y * v[j].y) + (v[j].z * v[j].z + v[j].w * v[j].w); }
            s = wave_sum(s);
            if (lane == 0) SS0[m] = s;
            GAS v2u* o8 = (GAS v2u*)(XB + (size_t)m * DMODEL) + lane; GAS unsigned* o4 = (GAS unsigned*)(X8 + (size_t)m * DMODEL) + lane;
#pragma unroll
            for (int j = 0; j < 16; ++j) { v2u w; w.x = pk2(v[j].x, v[j].y); w.y = pk2(v[j].z, v[j].w); o8[64 * j] = w; o4[64 * j] = pg8::pk4_fp8(v[j].x, v[j].y, v[j].z, v[j].w); }
        }
        for (int m = gw; m < BATCH * MEMLEN; m += NGW) {
            const GAS f32x4* xr = (const GAS f32x4*)(mem + (size_t)m * DMODEL) + lane;
            const GAS f32x4* gr = (const GAS f32x4*)ln_mem_g + lane;
            f32x4 v[16]; float s = 0.f;
#pragma unroll
            for (int j = 0; j < 16; ++j) { v[j] = xr[64 * j]; s += (v[j].x * v[j].x + v[j].y * v[j].y) + (v[j].z * v[j].z + v[j].w * v[j].w); }
            const float rs = rsqrtf(wave_sum(s) * (1.0f / DMODEL) + 1e-5f);
            GAS unsigned* o4 = (GAS unsigned*)(XB8 + (size_t)(MTOK + m) * DMODEL) + lane;
#pragma unroll
            for (int j = 0; j < 16; ++j) { const f32x4 g = gr[64 * j]; o4[64 * j] = pg8::pk4_fp8(v[j].x * rs * g.x, v[j].y * rs * g.y, v[j].z * rs * g.z, v[j].w * rs * g.w); }
        }
        for (int e = gw * 64 + lane; e < SEQ * 16; e += NGW * 64) {
            const int pos = e >> 4, i = e & 15;
            const double invd = (i == 0) ? 1.0 : (i == 1) ? 0.44036660267178046 : (i == 2) ? 0.19392274474868576 : (i == 3) ? 0.08539710028576561 : (i == 4) ? 0.03760603093086393
                : (i == 5) ? 0.016560440080994446 : (i == 6) ? 0.007292664737217109 : (i == 7) ? 0.003211445994752591 : (i == 8) ? 0.001414213562373095 : (i == 9) ? 0.000622772421914596
                : (i == 10) ? 0.0002742481756762073 : (i == 11) ? 0.00012076973741146504 : (i == 12) ? 5.318295896944988e-05 : (i == 13) ? 2.341999896140934e-05
                : (i == 14) ? 1.031338537721246e-05 : 4.5416704806078695e-06;
            const float ang = (float)pos * (float)invd;
            float co, si; cos_sin_d(ang, co, si);
            ROPE[pos * 32 + i] = co; ROPE[pos * 32 + 16 + i] = si;
        }
        if (rep == NREP(0) - 1) GRID_BAR(0);
    }

    if (IN(1)) {
        { pg8::Gemm g{XB, W_INA_T, MTOK, 4096, DMODEL}; pg8::StaticOrder S; S.init(MTOK, 4096, G, bx);
          pg8::EpiProj E{QKV, SS0, ROPE, 0, 1.f, KMF};
          pg8::gemm_phase<pg8::EpiProj, pg8::StaticOrder, true, true>(ldsl + RING_OFF, g, S, E);
          if (NREP(1) == 2) pg8::gemm_phase<pg8::EpiProj, pg8::StaticOrder, true, true>(ldsl + RING_OFF, g, S, E); }
        { pg8::Gemm g{(const bf16*)X8, (const bf16*)(W_IN8 + (size_t)2048 * DMODEL), MTOK, 4096, DMODEL  }; pg8::StaticOrder S; S.init(MTOK, 4096, G, bx);
          pg8::EpiProj E{QKV, SS0, ROPE, 3, 1.0f / 64.0f, KMF};
          pg8::gemm_phase_f8<pg8::EpiProj, pg8::StaticOrder, true, true, false, true>(ldsl + RING_OFF, g, S, E);
          if (NREP(1) == 2) pg8::gemm_phase_f8<pg8::EpiProj, pg8::StaticOrder, true, true, false, true>(ldsl + RING_OFF, g, S, E); }
#pragma unroll
        for (int vg = 0; vg < 2; ++vg) {
          pg8::Gemm g{(const bf16*)X8, (const bf16*)(W_IN8 + (size_t)(vg ? 6144 : 0) * DMODEL), MTOK, 2048, DMODEL}; pg8::StaticOrder S; S.init(MTOK, 2048, G, bx);
          pg8::EpiVT E{(unsigned char*)(QKV + (size_t)(vg ? 5 : 2) * 64 * 4096 * 128), SS0, 1.0f / 64.0f};
          pg8::gemm_phase_f8<pg8::EpiVT, pg8::StaticOrder, true, true, false, true>(ldsl + RING_OFF, g, S, E);
          if (NREP(1) == 2) pg8::gemm_phase_f8<pg8::EpiVT, pg8::StaticOrder, true, true, false, true>(ldsl + RING_OFF, g, S, E); }
        GRID_BAR(1);
    }


    if (IN(3)) {
        float lam;
        { const float s1 = wave_sum(lq1[lane] * lk1[lane] + lq1[lane + 64] * lk1[lane + 64]), s2 = wave_sum(lq2[lane] * lk2[lane] + lq2[lane + 64] * lk2[lane + 64]);
          lam = __expf(s1) - __expf(s2) + 0.2f; lam = __uint_as_float(__builtin_amdgcn_readfirstlane(__float_as_uint(lam))); }
        att::Seam S;
        float* const scrw = SCR + ((size_t)bx * NWAVES + wave) * 8192;
        float* const ssqw = (float*)((char*)lds + RING_OFF + att::LDS_SSQ) + wave * 32;
        constexpr size_t GRP = (size_t)64 * 4096 * 128;
        for (int rep = 0; rep < NREP(3); ++rep) {
#define P3_DEFERRED(it_) do { int r_ = (it_); int lane = (int)(threadIdx.x & 63u); asm volatile("" : "+v"(lane));     \
            LAS float* scr_ = (LAS float*)(ldsl + RING_OFF + wave * 16640);                                             \
            if (r_ < I_OUT) { p0_transpose_item_f8(w_out, DMODEL, DMODEL, nullptr, 64.f, W_OUT8, scr_, r_, lane); break; } r_ -= I_OUT;                          \
            if (r_ < I_CQ) { p0_transpose_item_f8(w_cq, DMODEL, MEMW, ln_cross_g, 64.f, W_CQKV8, scr_, r_, lane); break; } r_ -= I_CQ;                          \
            if (r_ < I_CKV) { p0_transpose_item_f8(w_ckv, DMODEL, 2 * MEMW, nullptr, 64.f, W_CQKV8 + (size_t)MEMW * DMODEL, scr_, r_, lane); break; } r_ -= I_CKV; \
            if (r_ < I_CO) { p0_transpose_item_f8(w_co, MEMW, DMODEL, nullptr, 64.f, (unsigned char*)W_CO_T, scr_, r_, lane); break; } r_ -= I_CO;                                    \
            if (r_ < I_UP) { p0_transpose_item_f8(w_up, DMODEL, DFF, ln_mlp_g, 64.f, W_UP8, scr_, r_, lane); break; } r_ -= I_UP;                              \
            p0_transpose_item_f8(w_down, DFF, DMODEL, nullptr, 128.f, W_DN8, scr_, r_, lane); } while (0)
        int cd = (rep == 0) ? 0 : 100000;
        constexpr int ND_Q = 512, NM_Q = 1024;
        int t = 0, pass = 0, npass = 0;
        for (;;) {
            if (pass == npass) {
                for (int k = 0; k < 4 && cd * NGW < ND; ++k, ++cd) { const int it = cd * NGW + gw; if (it < ND) P3_DEFERRED(it); }
                if (tid == 0) MISC[16] = __hip_atomic_fetch_add(ctl + CW_QUEUE + 64 * rep, 1u, RLX_AGENT);
                __syncthreads();
                t = __builtin_amdgcn_readfirstlane((int)MISC[16]);
#ifdef P3_REP_KIND
                if (rep == 1) { if (P3_REP_KIND == 1 && t >= ND_Q) break; if (P3_REP_KIND == 2) t += ND_Q; }
#endif
                if (t >= ND_Q + NM_Q) break;
                pass = 0; npass = (t < ND_Q) ? 2 : 1;
            }
            att::BlockRef r;
            if (t < ND_Q) {
                const int lvl = t >> 5, idx = t & 31, b = idx >> 3, h = idx & 7, s = pass, qb = 15 - lvl;
                r.Q = (const bf16*)((const unsigned char*)(QKV + 3 * GRP) + ((size_t)(b * 16 + 2 * h + s) * 4096 + qb * 256) * 128);
                r.K = (const bf16*)((const unsigned char*)(QKV + 4 * GRP) + (size_t)(b * 16 + 2 * h + s) * 4096 * 128);
                r.V = (const bf16*)((const unsigned char*)(QKV + 5 * GRP) + (size_t)(b * 16 + 2 * h) * 4096 * 128); r.P0 = qb * 256;
                att::EpiWide E; E.mode = s ? 2 : 1; E.out = MERGED8 + (size_t)(b * 4096 + qb * 256) * 4096 + 2048 + h * 256; E.gain = subln_g; E.scr = scrw; E.lam = lam;
#ifdef P3_WIDE_VAR
                if (rep == 1) { att::EpiNull EN; EN.scr = scrw; att::block_wide<att::EpiNull, P3_WIDE_VAR>(r, r.V + (size_t)4096 * 128, SEQ, (char*)lds + RING_OFF, S, EN); } else
#endif
                att::block_wide8<att::EpiWide>(r, (const bf16*)((const unsigned char*)r.V + (size_t)4096 * 128), SEQ, (char*)lds + RING_OFF, S, E);
            } else {
                const int u = t - ND_Q, lvl = u >> 6, idx = u & 63, b = idx >> 4, h = idx & 15, qb = 15 - lvl;
                r.Q = QKV + ((size_t)(b * 16 + h) * 4096 + qb * 256) * 128; r.K = (const bf16*)((const unsigned char*)(QKV + 1 * GRP) + (size_t)(b * 16 + h) * 4096 * 128);
                r.V = (const bf16*)((const unsigned char*)(QKV + 2 * GRP) + (size_t)(b * 16 + h) * 4096 * 128); r.P0 = qb * 256;
                att::EpiSelf E; E.mode = 0; E.vh = 0; E.out = MERGED8 + (size_t)(b * 4096 + qb * 256) * 4096 + h * 128; E.gain = moba_out_g + h * 128; E.scr = scrw; E.ssq = ssqw; E.lam = lam;
                const float* KMp = KMF + (size_t)(b * 16 + h) * 16 * 128;
                att::prime<true>(r, (char*)lds + RING_OFF, S);
                unsigned sel = 0u;
                if (qb > 0) { int ln_ = (int)(threadIdx.x & 63u); asm volatile("" : "+v"(ln_)); sel = att::moba_select(S, KMp, qb, ln_ & 31, ln_ >> 5); }
                att::q8_from_qr(S);
                att::block<att::EpiSelf, true>(r, SEQ, (char*)lds + RING_OFF, S, true, sel, E);
            }
            ++pass;
        }
        for (; cd * NGW < ND; ++cd) { const int it = cd * NGW + gw; if (it < ND) P3_DEFERRED(it); }
#undef P3_DEFERRED
        }
        GRID_BAR(3);
    }

    if (IN(4)) {
        pg8::Gemm g{(const bf16*)MERGED8, (const bf16*)W_OUT8, MTOK, DMODEL, DMODEL  }; pg8::StaticOrder S; S.init(MTOK, DMODEL, G, bx);
        pg8::EpiRes<false> E{XB, XB, XB8, SS1, 1.0f / 64.0f};
        pg8::gemm_phase_f8<pg8::EpiRes<false>, pg8::StaticOrder, true, true, false, true>(ldsl + RING_OFF, g, S, E);
        if (NREP(4) == 2) { E.ss = SS1 + 3 * 16384; E.sc = 0.f; pg8::gemm_phase_f8<pg8::EpiRes<false>, pg8::StaticOrder, true, true, false, true>(ldsl + RING_OFF, g, S, E); }
        GRID_BAR(4);
    }

    if (IN(5)) {
        pg8::Gemm g{(const bf16*)XB8, (const bf16*)W_CQKV8, MTOK + BATCH * MEMLEN, 3 * MEMW, DMODEL  }; pg8::CrossOrder S{G, bx};
        pg8::EpiCross E{QC, KC, VC, SS1, 1.0f / 64.0f};
        pg8::gemm_phase_f8<pg8::EpiCross, pg8::CrossOrder, true, true, false, true>(ldsl + RING_OFF, g, S, E);
        if (NREP(5) == 2) pg8::gemm_phase_f8<pg8::EpiCross, pg8::CrossOrder, true, true, false, true>(ldsl + RING_OFF, g, S, E);
        GRID_BAR(5);
    }

    if (IN(6)) {
        att::Seam S;
        for (int rep = 0; rep < NREP(6); ++rep)
        for (int u = bx; u < 256; u += G) {
            const int b = u >> 6, hh = (u >> 4) & 3, qb = u & 15;
            att::BlockRef r; r.Q = QC + ((size_t)(b * 4 + hh) * 4096 + qb * 256) * 128; r.K = KC + (size_t)(b * 4 + hh) * 256 * 128; r.V = VC + (size_t)(b * 4 + hh) * 256 * 128; r.P0 = 1 << 20;
            att::EpiMem E{(unsigned char*)OC + (size_t)(b * 4096 + qb * 256) * 512 + hh * 128};
            att::prime(r, (char*)lds + RING_OFF, S);
            att::block<att::EpiMem>(r, MEMLEN, (char*)lds + RING_OFF, S, false, 0u, E);
        }
        GRID_BAR(6);
    }

    if (IN(7)) {
        pg8::Gemm g{OC, W_CO_T, MTOK, DMODEL, MEMW  }; pg8::StaticOrder S; S.init(MTOK, DMODEL, G, bx);
        pg8::EpiRes<false> E{XB, XB, XB8, SS2, 1.0f / 1024.0f};
        pg8::gemm_phase_f8<pg8::EpiRes<false>, pg8::StaticOrder, true, true, false, true>(ldsl + RING_OFF, g, S, E);
        if (NREP(7) == 2) { E.ss = SS1 + 3 * 16384; E.sc = 0.f; pg8::gemm_phase_f8<pg8::EpiRes<false>, pg8::StaticOrder, true, true, false, true>(ldsl + RING_OFF, g, S, E); }
        GRID_BAR(7);
    }

    if (IN(8)) {
        pg8::Gemm g{(const bf16*)XB8, (const bf16*)W_UP8, MTOK, DFF, DMODEL  }; pg8::StaticOrder S; S.init(MTOK, DFF, G, bx);
        pg8::EpiUp8 E{U8, SS2};
        pg8::gemm_phase_f8<pg8::EpiUp8, pg8::StaticOrder, true, true, false, true>(ldsl + RING_OFF, g, S, E);
        if (NREP(8) == 2) pg8::gemm_phase_f8<pg8::EpiUp8, pg8::StaticOrder, true, true, false, true>(ldsl + RING_OFF, g, S, E);
        GRID_BAR(8);
    }

    if (IN(9)) {
        pg8::Gemm g{(const bf16*)U8, (const bf16*)W_DN8, MTOK, DMODEL, DFF  }; pg8::StaticOrder S; S.init(MTOK, DMODEL, G, bx);
        pg8::EpiRes<false> E{XB, XB, nullptr, SS3, 1.0f / 512.0f};
        pg8::gemm_phase_f8<pg8::EpiRes<false>, pg8::StaticOrder, true, true, true, true>(ldsl + RING_OFF, g, S, E);
        if (NREP(9) == 2) { E.ss = SS1 + 3 * 16384; E.sc = 0.f; pg8::gemm_phase_f8<pg8::EpiRes<false>, pg8::StaticOrder, true, true, true, true>(ldsl + RING_OFF, g, S, E); }
        GRID_BAR(9);
    }

    if (IN(10)) {
        const GAS f32x4* gr = (const GAS f32x4*)final_g + 2 * lane;
        for (int m = gw; m < MTOK; m += NGW) {
            const GAS v4u* xr = (const GAS v4u*)(XB + (size_t)m * DMODEL) + lane;
            GAS f32x4* orow = (GAS f32x4*)(out + (size_t)m * DMODEL) + 2 * lane;
            const float rs = rsqrtf(__hip_atomic_load(SS3 + m, __ATOMIC_RELAXED, __HIP_MEMORY_SCOPE_AGENT) * (1.0f / DMODEL) + 1e-5f);
#pragma unroll
            for (int j = 0; j < 8; ++j) { const v4u w = __builtin_nontemporal_load(xr + 64 * j); const f32x4 g0 = gr[128 * j], g1 = gr[128 * j + 1];
                const f32x4 a0 = {__uint_as_float(w.x << 16), __uint_as_float(w.x & 0xffff0000u), __uint_as_float(w.y << 16), __uint_as_float(w.y & 0xffff0000u)};
                const f32x4 a1 = {__uint_as_float(w.z << 16), __uint_as_float(w.z & 0xffff0000u), __uint_as_float(w.w << 16), __uint_as_float(w.w & 0xffff0000u)};
                __builtin_nontemporal_store(a0 * rs * g0, orow + 128 * j); __builtin_nontemporal_store(a1 * rs * g1, orow + 128 * j + 1); }
        }
    }
#undef IN
#undef BOTH
#undef GRID_BAR
}

extern "C" void kernel_launch(void* const* d_in, const int* in_sizes, int n_in, void* d_out, int out_size, void* d_ws, size_t ws_size, hipStream_t stream) {
    static int grid = 0;
    if (grid == 0) {
        if (n_in != 20 || in_sizes[0] != MTOK * DMODEL || out_size != MTOK * DMODEL || ws_size < WS_END) {
            fprintf(stderr, "kernel_launch: built for 20 inputs, x/out of %d floats, >= %zu bytes of workspace; got n_in %d, in0 %d, out %d, ws %zu; nothing launched\n", MTOK * DMODEL, (size_t)WS_END, n_in, n_in > 0 ? in_sizes[0] : -1, out_size, ws_size);
            grid = -1; return; }
        int dev = 0, cus = 0, per_cu = 0;
        if (hipGetDevice(&dev) != hipSuccess || hipDeviceGetAttribute(&cus, hipDeviceAttributeMultiprocessorCount, dev) != hipSuccess) { fprintf(stderr, "kernel_launch: device query failed\n"); grid = -1; return; }
        if (hipFuncSetAttribute((const void*)mk_fwd, hipFuncAttributeMaxDynamicSharedMemorySize, LDS_BYTES) != hipSuccess) { fprintf(stderr, "kernel_launch: hipFuncSetAttribute failed\n"); grid = -1; return; }
        if (hipOccupancyMaxActiveBlocksPerMultiprocessor(&per_cu, (const void*)mk_fwd, NWAVES * 64, LDS_BYTES) != hipSuccess || per_cu < 1)
            fprintf(stderr, "kernel_launch: note: the occupancy query reports %d workgroups per CU\n", per_cu);
        (void)hipGetLastError();
        grid = cus;
    }
    if (grid < 0) return;
    if (hipMemsetAsync((char*)d_ws + WS_CTL, 0, CTL_ZERO_BYTES, stream) != hipSuccess) { fprintf(stderr, "kernel_launch: hipMemsetAsync failed\n"); return; }
    Args a{};
    for (int i = 0; i < 20; ++i) a.in[i] = (const float*)d_in[i];
    a.out = (float*)d_out; a.ws = (unsigned char*)d_ws;
    for (int li = 0; li < N_LAUNCHES; ++li) {
        a.ph_lo = (N_LAUNCHES == 1) ? 0 : li; a.ph_hi = (N_LAUNCHES == 1) ? NPHASE : li + 1;
        hipLaunchKernelGGL(mk_fwd, dim3(grid), dim3(NWAVES * 64), LDS_BYTES, stream, a);
        const hipError_t le = hipPeekAtLastError();
        if (le != hipSuccess) { fprintf(stderr, "kernel_launch: launch %d failed: %s\n", li, hipGetErrorName(le)); break; }
    }
}
```

```cpp
#include <hip/hip_runtime.h>
#include <cstdio>
#include <cstdint>
namespace pg8 {
#define PG8_LAS __attribute__((address_space(3)))
typedef unsigned short bf16_t;
typedef short bf16x8 __attribute__((ext_vector_type(8)));
typedef float f32x4 __attribute__((ext_vector_type(4)));
typedef unsigned u32x4 __attribute__((ext_vector_type(4)));
constexpr int BM = 256, BK = 64, HALF = 128, HTB = HALF * BK * 2  , STAGE_BYTES = 8 * HTB, NXCD = 8, WGM = 8;

__host__ __device__ __forceinline__ int lds_byte(int r, int c) { const int st = (r >> 4) * 2 + (c >> 5), rr = r & 15, cc = c & 31, ob = rr * 64 + cc * 2; return st * 1024 + (ob ^ (((ob >> 9) & 1) << 5)); }
__host__ __device__ __forceinline__ void stage_rc(int b, int& R, int& C) { const int st = b / 1024, sb = b % 1024, swz = sb ^ (((sb >> 9) & 1) << 5); R = (st >> 1) * 16 + swz / 64; C = (st & 1) * 32 + (swz % 64) / 2; }
__host__ __device__ __forceinline__ int perm32(int rho) { const int n = rho >> 4, i = rho & 15; return 8 * (i >> 2) + 4 * n + (i & 3); }

struct Unit { int pm, pn; };
struct Gemm { const bf16_t* A; const bf16_t* Bt; int M, N, K; };

struct StaticOrder {
    int nM, nN, nwg, G, c;
    __host__ __device__ void init(int M, int N, int G_, int c_) { nM = M / BM; nN = N / BM; nwg = nM * nN; G = G_; c = c_; }
    __host__ __device__ bool next(int i, Unit& u) const {
        const long L = (long)i * G + c; if (L >= nwg) return false;
        int wgid = (int)L; { const int q = nwg / NXCD, r = nwg % NXCD, xcd = wgid % NXCD, off = wgid / NXCD; wgid = (xcd < r ? xcd * (q + 1) : r * (q + 1) + (xcd - r) * q) + off; }
        const int nig = WGM * nN, gid = wgid / nig, fm = gid * WGM, gsz = (nM - fm) < WGM ? (nM - fm) : WGM;
        u.pm = fm + ((wgid % nig) % gsz); u.pn = (wgid % nig) / gsz; return true;
    }
    __device__ __forceinline__ void a_ready(const Unit&) const {}
    __device__ __forceinline__ void done(const Unit&) const {}
};

__device__ __forceinline__ unsigned cvt_pk_bf16(float lo, float hi) { unsigned r; asm volatile("v_cvt_pk_bf16_f32 %0, %1, %2" : "=v"(r) : "v"(lo), "v"(hi)); return r; }
typedef unsigned u32x2 __attribute__((ext_vector_type(2)));
constexpr float RMS_EPS = 1e-5f;
constexpr int DM = 4096;
__device__ __forceinline__ void rope4(f32x4& v, const f32x4& c, const f32x4& s, int fq) {
#pragma unroll
    for (int j = 0; j < 4; ++j) {
        auto rr = __builtin_amdgcn_permlane32_swap(__float_as_uint(v[j]), __float_as_uint(v[j]), false, false);
        const float x1 = __uint_as_float(rr[0]), x2 = __uint_as_float(rr[1]);
        v[j] = (fq < 2) ? (x1 * c[j] - x2 * s[j]) : (x2 * c[j] + x1 * s[j]);
    }
}
typedef int i32x8 __attribute__((ext_vector_type(8)));
typedef short s16x16 __attribute__((ext_vector_type(16)));
__device__ __forceinline__ unsigned pk4_fp8(float a, float b, float c, float d) {
    a = fminf(fmaxf(a, -448.f), 448.f); b = fminf(fmaxf(b, -448.f), 448.f); c = fminf(fmaxf(c, -448.f), 448.f); d = fminf(fmaxf(d, -448.f), 448.f);
    int w = 0; w = __builtin_amdgcn_cvt_pk_fp8_f32(a, b, w, false); w = __builtin_amdgcn_cvt_pk_fp8_f32(c, d, w, true); return (unsigned)w;
}
struct EpiProj {
    static constexpr bool PERM = true, AFTER_DRAIN = false;
    bf16_t* QKV; const float* ss; const float* cs; int g0; float sc; float* kmf;
    __device__ __forceinline__ void operator()(const f32x4 (&acc)[2][2][4][2], const Unit& u, int wr, int wc, int fr, int fq) const {
        const int g = g0 + (u.pn >> 3), b = u.pm >> 4;
        const bool rope = (wc == 0) && (g != 2) && (g != 5);
        f32x4 ksum[2][2] = {{{0.f, 0.f, 0.f, 0.f}, {0.f, 0.f, 0.f, 0.f}}, {{0.f, 0.f, 0.f, 0.f}, {0.f, 0.f, 0.f, 0.f}}};
#pragma unroll
        for (int ai = 0; ai < 2; ++ai)
#pragma unroll
            for (int m = 0; m < 4; ++m) {
                const int rit = ai * HALF + wr * 64 + m * 16 + fr, s = (u.pm & 15) * 256 + rit, grow = u.pm * 256 + rit;
                const float rs = rsqrtf(ss[grow] * (1.0f / 4096.0f) + RMS_EPS) * sc;
                f32x4 c0 = {1.f, 1.f, 1.f, 1.f}, c1 = c0, s0 = {0.f, 0.f, 0.f, 0.f}, s1 = s0;
                if (rope) { const float* t = cs + (size_t)s * 32 + 8 * (fq & 1); c0 = *(const f32x4*)t; c1 = *(const f32x4*)(t + 4); s0 = *(const f32x4*)(t + 16); s1 = *(const f32x4*)(t + 20); }
#pragma unroll
                for (int bj = 0; bj < 2; ++bj) {
                    f32x4 v0 = acc[ai][bj][m][0] * rs, v1 = acc[ai][bj][m][1] * rs;
                    if (rope) { rope4(v0, c0, s0, fq); rope4(v1, c1, s1, fq); }
                    const int head = (u.pn & 7) * 2 + bj;
                    bf16_t* dst = QKV + ((((size_t)(g * 4 + b) * 16 + head) * 4096 + s) * 128 + wc * 32 + 8 * fq);
                    if (g == 1) {
                        unsigned char* d8 = (unsigned char*)(QKV + (size_t)g * 4 * 16 * 4096 * 128) + ((((size_t)b * 16 + head) * 4096 + s) * 128 + (wc >> 1) * 64 + (fq & 1) * 32 + ((wc & 1) * 2 + (fq >> 1)) * 8);
                        u32x2 w8; w8.x = pk4_fp8(v0[0] * 16.f, v0[1] * 16.f, v0[2] * 16.f, v0[3] * 16.f); w8.y = pk4_fp8(v1[0] * 16.f, v1[1] * 16.f, v1[2] * 16.f, v1[3] * 16.f);
                        *(u32x2*)d8 = w8;
                    } else if (g == 3 || g == 4) {
                        unsigned char* d8 = (unsigned char*)(QKV + (size_t)g * 4 * 16 * 4096 * 128) + ((((size_t)b * 16 + head) * 4096 + s) * 128 + wc * 32 + 8 * fq);
                        u32x2 w8; w8.x = pk4_fp8(v0[0] * 16.f, v0[1] * 16.f, v0[2] * 16.f, v0[3] * 16.f); w8.y = pk4_fp8(v1[0] * 16.f, v1[1] * 16.f, v1[2] * 16.f, v1[3] * 16.f);
                        *(u32x2*)d8 = w8;
                    } else {
                    u32x4 w; w.x = cvt_pk_bf16(v0[0], v0[1]); w.y = cvt_pk_bf16(v0[2], v0[3]); w.z = cvt_pk_bf16(v1[0], v1[1]); w.w = cvt_pk_bf16(v1[2], v1[3]);
                    *(u32x4*)dst = w; }
                    if (g == 1) { ksum[bj][0] += v0; ksum[bj][1] += v1; }
                }
            }
        if (g == 1) {
#pragma unroll
            for (int bj = 0; bj < 2; ++bj)
#pragma unroll
                for (int n = 0; n < 2; ++n)
#pragma unroll
                    for (int j = 0; j < 4; ++j) { float t = ksum[bj][n][j]; t += __shfl_xor(t, 1); t += __shfl_xor(t, 2); t += __shfl_xor(t, 4); t += __shfl_xor(t, 8);
                        if (fr == 0) unsafeAtomicAdd(kmf + (((size_t)(b * 16 + (u.pn & 7) * 2 + bj) * 16 + (u.pm & 15)) * 128 + wc * 32 + 8 * fq + 4 * n + j), t); }
        }
    }
};
struct EpiVT {
    static constexpr bool PERM = true, AFTER_DRAIN = false;
    unsigned char* VT; const float* ss; float sc;
    __device__ __forceinline__ void operator()(const f32x4 (&acc)[2][2][4][2], const Unit& u, int wr, int wc, int fr, int fq) const {
        const int b = u.pm >> 4;
#pragma unroll
        for (int ai = 0; ai < 2; ++ai) { float rs4[4];
#pragma unroll
            for (int m = 0; m < 4; ++m) rs4[m] = rsqrtf(ss[u.pm * 256 + ai * HALF + wr * 64 + m * 16 + fr] * (1.0f / 4096.0f) + RMS_EPS) * (sc * 16.f);
            const int T = (u.pm & 15) * 4 + ai * 2 + wr;
#pragma unroll
            for (int bj = 0; bj < 2; ++bj) { const int head = u.pn * 2 + bj;
                unsigned char* base = VT + (((size_t)b * 16 + head) * 64 + T) * 8192 + (wc * 32 + 8 * fq) * 64 + 32 * (fr >> 3) + 4 * (fr & 7);
#pragma unroll
                for (int n = 0; n < 2; ++n)
#pragma unroll
                    for (int jj = 0; jj < 4; ++jj)
                        *(unsigned*)(base + (4 * n + jj) * 64) = pk4_fp8(acc[ai][bj][0][n][jj] * rs4[0], acc[ai][bj][1][n][jj] * rs4[1], acc[ai][bj][2][n][jj] * rs4[2], acc[ai][bj][3][n][jj] * rs4[3]); } }
    }
};
struct EpiResid {
    static constexpr bool PERM = false, AFTER_DRAIN = false;
    const float* xin; float* xout; bf16_t* xb; unsigned char* x8; float* ss; float sc;
    __device__ __forceinline__ void operator()(const f32x4 (&acc)[2][2][4][2], const Unit& u, int wr, int wc, int fr, int fq) const {
        const int row0 = u.pm * BM + wr * 64 + fr, col0 = u.pn * BM + wc * 32 + 4 * fq;
#pragma unroll
        for (int ai = 0; ai < 2; ++ai)
#pragma unroll
            for (int m = 0; m < 4; ++m) {
                const int row = row0 + ai * HALF + m * 16; const size_t off = (size_t)row * DM + col0; float q = 0.f;
#pragma unroll
                for (int bj = 0; bj < 2; ++bj)
#pragma unroll
                    for (int n = 0; n < 2; ++n) { const size_t o2 = off + bj * HALF + n * 16;
                        const f32x4 v = *(const f32x4*)(xin + o2) + acc[ai][bj][m][n] * sc; *(f32x4*)(xout + o2) = v;
                        q += (v[0] * v[0] + v[1] * v[1]) + (v[2] * v[2] + v[3] * v[3]);
                        if (xb) { u32x2 w; w.x = cvt_pk_bf16(v[0], v[1]); w.y = cvt_pk_bf16(v[2], v[3]); *(u32x2*)(xb + o2) = w; }
                        if (x8) *(unsigned*)(x8 + o2) = pk4_fp8(v[0], v[1], v[2], v[3]); }
                q += __shfl_xor(q, 16); q += __shfl_xor(q, 32);
                if (fq == 0) unsafeAtomicAdd(ss + row, q);
                asm volatile("" ::: "memory");
            }
    }
};
template <bool XF32> struct EpiRes {
    static constexpr bool PERM = true, AFTER_DRAIN = false;
    const void* xin; bf16_t* xb; unsigned char* x8; float* ss; float sc;
    __device__ __forceinline__ void operator()(const f32x4 (&acc)[2][2][4][2], const Unit& u, int wr, int wc, int fr, int fq) const {
        const int row0 = u.pm * BM + wr * 64 + fr, col0 = u.pn * BM + wc * 32 + 8 * fq;
#pragma unroll
        for (int ai = 0; ai < 2; ++ai) {
            f32x4 a[4][2][2];
#pragma unroll
            for (int m = 0; m < 4; ++m)
#pragma unroll
                for (int bj = 0; bj < 2; ++bj) { const size_t o2 = (size_t)(row0 + ai * HALF + m * 16) * DM + col0 + bj * HALF;
                    if constexpr (XF32) { a[m][bj][0] = *(const f32x4*)((const float*)xin + o2); a[m][bj][1] = *(const f32x4*)((const float*)xin + o2 + 4); }
                    else { const u32x4 w = *(const u32x4*)((const bf16_t*)xin + o2); a[m][bj][0] = __builtin_bit_cast(f32x4, w); } }
#pragma unroll
            for (int m = 0; m < 4; ++m) {
                const int row = row0 + ai * HALF + m * 16; const size_t off = (size_t)row * DM + col0; float q = 0.f;
#pragma unroll
                for (int bj = 0; bj < 2; ++bj) { const size_t o2 = off + bj * HALF;
                    f32x4 a0, a1;
                    if constexpr (XF32) { a0 = a[m][bj][0]; a1 = a[m][bj][1]; }
                    else { const u32x4 w = __builtin_bit_cast(u32x4, a[m][bj][0]);
                        a0 = (f32x4){__uint_as_float(w.x << 16), __uint_as_float(w.x & 0xffff0000u), __uint_as_float(w.y << 16), __uint_as_float(w.y & 0xffff0000u)};
                        a1 = (f32x4){__uint_as_float(w.z << 16), __uint_as_float(w.z & 0xffff0000u), __uint_as_float(w.w << 16), __uint_as_float(w.w & 0xffff0000u)}; }
                    const f32x4 v0 = a0 + acc[ai][bj][m][0] * sc, v1 = a1 + acc[ai][bj][m][1] * sc;
                    q += ((v0[0] * v0[0] + v0[1] * v0[1]) + (v0[2] * v0[2] + v0[3] * v0[3])) + ((v1[0] * v1[0] + v1[1] * v1[1]) + (v1[2] * v1[2] + v1[3] * v1[3]));
                    u32x4 wo; wo.x = cvt_pk_bf16(v0[0], v0[1]); wo.y = cvt_pk_bf16(v0[2], v0[3]); wo.z = cvt_pk_bf16(v1[0], v1[1]); wo.w = cvt_pk_bf16(v1[2], v1[3]);
                    *(u32x4*)(xb + o2) = wo;
                    if (x8) { u32x2 w8; w8.x = pk4_fp8(v0[0], v0[1], v0[2], v0[3]); w8.y = pk4_fp8(v1[0], v1[1], v1[2], v1[3]); *(u32x2*)(x8 + o2) = w8; } }
                q += __shfl_xor(q, 16); q += __shfl_xor(q, 32);
                if (fq == 0) unsafeAtomicAdd(ss + row, q);
            }
            asm volatile("" ::: "memory");
        }
    }
};
struct EpiCross {
    static constexpr bool PERM = true, AFTER_DRAIN = false;
    bf16_t* QC; bf16_t* KC; bf16_t* VC; const float* ss; float sc;
    __device__ __forceinline__ void operator()(const f32x4 (&acc)[2][2][4][2], const Unit& u, int wr, int wc, int fr, int fq) const {
        const bool isq = u.pm < 64;
#pragma unroll
        for (int ai = 0; ai < 2; ++ai)
#pragma unroll
            for (int m = 0; m < 4; ++m) {
                const int rit = ai * HALF + wr * 64 + m * 16 + fr;
                float rs = sc; if (isq) rs = rsqrtf(ss[u.pm * 256 + rit] * (1.0f / 4096.0f) + RMS_EPS) * sc;
#pragma unroll
                for (int bj = 0; bj < 2; ++bj) {
                    const f32x4 v0 = acc[ai][bj][m][0] * rs, v1 = acc[ai][bj][m][1] * rs;
                    bf16_t* dst;
                    if (isq) { const int b = u.pm >> 4, s = (u.pm & 15) * 256 + rit, head = 2 * u.pn + bj; dst = QC + (((size_t)(b * 4 + head) * 4096 + s) * 128 + wc * 32 + 8 * fq); }
                    else { const int b = u.pm - 64, cp = 256 * (u.pn - 2) + 128 * bj, head = (cp & 511) >> 7; dst = ((cp >= 512) ? VC : KC) + (((size_t)(b * 4 + head) * 256 + rit) * 128 + wc * 32 + 8 * fq); }
                    u32x4 w; w.x = cvt_pk_bf16(v0[0], v0[1]); w.y = cvt_pk_bf16(v0[2], v0[3]); w.z = cvt_pk_bf16(v1[0], v1[1]); w.w = cvt_pk_bf16(v1[2], v1[3]);
                    *(u32x4*)dst = w;
                }
            }
    }
};
struct CrossOrder {
    int G, c;
    __device__ __forceinline__ bool next(int i, Unit& u) const { const int L = i * G + c; if (L >= 144) return false;
        if (L < 128) { u.pm = L & 63; u.pn = L >> 6; } else { const int j = L - 128; u.pm = 64 + (j >> 2); u.pn = 2 + (j & 3); } return true; }
    __device__ __forceinline__ void a_ready(const Unit&) const {}
    __device__ __forceinline__ void done(const Unit&) const {}
};
struct EpiUp {
    static constexpr bool PERM = true, AFTER_DRAIN = false;
    bf16_t* U; const float* ss;
    __device__ __forceinline__ void operator()(const f32x4 (&acc)[2][2][4][2], const Unit& u, int wr, int wc, int fr, int fq) const {
        const int row0 = u.pm * BM + wr * 64 + fr, col0 = u.pn * BM + wc * 32 + 8 * fq;
#pragma unroll
        for (int ai = 0; ai < 2; ++ai)
#pragma unroll
            for (int m = 0; m < 4; ++m) {
                const int row = row0 + ai * HALF + m * 16;
                const float rs = rsqrtf(ss[row] * (1.0f / 4096.0f) + RMS_EPS);
                bf16_t* rowp = U + (size_t)row * 16384 + col0;
#pragma unroll
                for (int bj = 0; bj < 2; ++bj) {
                    f32x4 v0 = acc[ai][bj][m][0] * rs, v1 = acc[ai][bj][m][1] * rs;
#pragma unroll
                    for (int j = 0; j < 4; ++j) { const float a = fmaxf(v0[j], 0.f), b = fmaxf(v1[j], 0.f); v0[j] = a * a; v1[j] = b * b; }
                    u32x4 w; w.x = cvt_pk_bf16(v0[0], v0[1]); w.y = cvt_pk_bf16(v0[2], v0[3]); w.z = cvt_pk_bf16(v1[0], v1[1]); w.w = cvt_pk_bf16(v1[2], v1[3]);
                    *(u32x4*)(rowp + bj * HALF) = w;
                }
            }
    }
};

struct EpiUp8 {
    static constexpr bool PERM = true, AFTER_DRAIN = false;
    unsigned char* U; const float* ss;
    __device__ __forceinline__ void operator()(const f32x4 (&acc)[2][2][4][2], const Unit& u, int wr, int wc, int fr, int fq) const {
        const int row0 = u.pm * BM + wr * 64 + fr, col0 = u.pn * BM + wc * 32 + 8 * fq;
#pragma unroll
        for (int ai = 0; ai < 2; ++ai)
#pragma unroll
            for (int m = 0; m < 4; ++m) {
                const int row = row0 + ai * HALF + m * 16;
                const float rs = rsqrtf(ss[row] * (1.0f / 4096.0f) + RMS_EPS) * (1.0f / 64.0f);
                unsigned char* rowp = U + ((size_t)(row >> 4) * 512 + (col0 >> 5)) * 512 + (row & 15) * 32 + (col0 & 31);
#pragma unroll
                for (int bj = 0; bj < 2; ++bj) {
                    f32x4 v0 = acc[ai][bj][m][0] * rs, v1 = acc[ai][bj][m][1] * rs;
#pragma unroll
                    for (int j = 0; j < 4; ++j) { const float a = fmaxf(v0[j], 0.f), b = fmaxf(v1[j], 0.f); v0[j] = a * a * 4.f; v1[j] = b * b * 4.f; }
                    u32x2 w; w.x = pk4_fp8(v0[0], v0[1], v0[2], v0[3]); w.y = pk4_fp8(v1[0], v1[1], v1[2], v1[3]);
                    *(u32x2*)(rowp + bj * (HALF / 32) * 512) = w;
                }
            }
    }
};

template <class Epi, class Sched, bool ALIGN_EPI = false, bool SP2 = false>
__device__ __forceinline__ void gemm_phase(PG8_LAS unsigned char* lds, const Gemm g, const Sched& S, const Epi& E) {
    int tid = threadIdx.x; asm volatile("" : "+v"(tid));
    const int wid = __builtin_amdgcn_readfirstlane(tid >> 6), lane = tid & 63, wr = wid >> 2, wc = wid & 3, fr = lane & 15, fq = lane >> 4;
    const int K = g.K, nt = K / BK;
    unsigned voffA[2], voffB[2];
#pragma unroll
    for (int i = 0; i < 2; ++i) { int R, C; stage_rc(tid * 16 + i * 8192, R, C); const int Rb = Epi::PERM ? ((R & ~31) + perm32(R & 31)) : R;
        voffA[i] = (unsigned)(R * K + C) * 2u; voffB[i] = (unsigned)(Rb * K + C) * 2u; }
    const size_t kstep = (size_t)(BK * 2);
    const size_t hstep = (size_t)HALF * K * 2;
    const size_t tstep = 2 * hstep;
    const unsigned ldsw = (unsigned)wid * 1024u;
    const int aoff = lds_byte(wr * 64 + fr, fq * 8), boff = lds_byte(wc * 32 + fr, fq * 8);
#define PG8_SA(b, h) (((b) * 2 + (h)) * HTB)
#define PG8_SB(b, h) ((4 + (b) * 2 + (h)) * HTB)
#define PG8_STAGE(bufoff, gbase, voff) do { _Pragma("unroll") for (int _i = 0; _i < 2; ++_i) \
        __builtin_amdgcn_global_load_lds((const unsigned*)((const char*)(gbase) + (voff)[_i]), (PG8_LAS unsigned*)(lds + (bufoff) + ldsw + _i * 8192), 16, 0, 0); } while (0)
#define PG8_LDA(dst, b, h) do { _Pragma("unroll") for (int m = 0; m < 4; ++m) _Pragma("unroll") for (int k = 0; k < 2; ++k) dst[m][k] = *(const PG8_LAS bf16x8*)(lds + PG8_SA(b, h) + aoff + m * 2048 + k * 1024); } while (0)
#define PG8_LDB(dst, b, h) do { _Pragma("unroll") for (int n = 0; n < 2; ++n) _Pragma("unroll") for (int k = 0; k < 2; ++k) dst[n][k] = *(const PG8_LAS bf16x8*)(lds + PG8_SB(b, h) + boff + n * 2048 + k * 1024); } while (0)
#define PG8_MMA(ai, bj, At, Bt) do { __builtin_amdgcn_s_setprio(1); _Pragma("unroll") for (int m = 0; m < 4; ++m) _Pragma("unroll") for (int n = 0; n < 2; ++n) _Pragma("unroll") for (int k = 0; k < 2; ++k) \
        acc[ai][bj][m][n] = __builtin_amdgcn_mfma_f32_16x16x32_bf16(Bt[n][k], At[m][k], acc[ai][bj][m][n], 0, 0, 0); __builtin_amdgcn_s_setprio(0); } while (0)
#define PG8_WAIT_V(n) asm volatile("s_waitcnt vmcnt(" #n ")" ::: "memory")
#define PG8_WAIT_L(n) asm volatile("s_waitcnt lgkmcnt(" #n ")" ::: "memory")
#define PG8_BAR __builtin_amdgcn_s_barrier()
#define PG8_SCHED __builtin_amdgcn_sched_barrier(0)
    Unit cur, nxt; int ui = 0;
    if (!S.next(0, cur)) return;
    f32x4 acc[2][2][4][2];
#pragma unroll
    for (int a = 0; a < 2; ++a)
#pragma unroll
        for (int b = 0; b < 2; ++b)
#pragma unroll
            for (int m = 0; m < 4; ++m)
#pragma unroll
                for (int n = 0; n < 2; ++n) acc[a][b][m][n] = (f32x4){0.f, 0.f, 0.f, 0.f};
    bf16x8 At[4][2], B0[2][2], B1[2][2];
    const char* cA = (const char*)g.A + (size_t)cur.pm * tstep; const char* cB = (const char*)g.Bt + (size_t)cur.pn * tstep;
    S.a_ready(cur);
    if constexpr (SP2) {
        PG8_STAGE(PG8_SB(0, 0), cB, voffB); PG8_STAGE(PG8_SB(0, 1), cB + hstep, voffB); PG8_STAGE(PG8_SA(0, 0), cA, voffA); PG8_STAGE(PG8_SA(0, 1), cA + hstep, voffA);
        if (wr == 1) PG8_BAR;
        PG8_WAIT_V(2); PG8_BAR;
        PG8_STAGE(PG8_SB(1, 0), cB + kstep, voffB); PG8_STAGE(PG8_SA(1, 0), cA + kstep, voffA); PG8_STAGE(PG8_SB(1, 1), cB + hstep + kstep, voffB);
        PG8_WAIT_V(6); PG8_BAR;
    } else {
        PG8_STAGE(PG8_SB(0, 0), cB, voffB); PG8_STAGE(PG8_SA(0, 0), cA, voffA); PG8_STAGE(PG8_SB(0, 1), cB + hstep, voffB); PG8_STAGE(PG8_SA(0, 1), cA + hstep, voffA);
        if (wr == 1) PG8_BAR;
        PG8_WAIT_V(4); PG8_BAR;
        PG8_STAGE(PG8_SB(1, 0), cB + kstep, voffB); PG8_STAGE(PG8_SA(1, 0), cA + kstep, voffA); PG8_STAGE(PG8_SB(1, 1), cB + hstep + kstep, voffB);
        PG8_WAIT_V(6); PG8_BAR;
    }
    for (;;) {
        const bool has_next = S.next(ui + 1, nxt);
        const char* nA = has_next ? (const char*)g.A + (size_t)nxt.pm * tstep : cA; const char* nB = has_next ? (const char*)g.Bt + (size_t)nxt.pn * tstep : cB;
        for (int t = 0; t < nt; t += 2) {
            const bool last = (t == nt - 2);
            const char* a1 = cA + (size_t)(t + 1) * kstep;
            const char* a2 = last ? nA : cA + (size_t)(t + 2) * kstep; const char* b2 = last ? nB : cB + (size_t)(t + 2) * kstep;
            const char* a3 = a2 + kstep; const char* b3 = b2 + kstep;
            if (last && has_next) S.a_ready(nxt);
            if constexpr (SP2) {
            PG8_LDB(B0, 0, 0); PG8_LDB(B1, 0, 1); PG8_SCHED; PG8_LDA(At, 0, 0); PG8_STAGE(PG8_SA(1, 1), a1 + hstep, voffA);
            PG8_WAIT_V(8); PG8_WAIT_L(0); PG8_BAR; PG8_MMA(0, 0, At, B0); PG8_MMA(0, 1, At, B1); PG8_BAR; PG8_SCHED;
            PG8_LDA(At, 0, 1); PG8_STAGE(PG8_SB(0, 0), b2, voffB); PG8_STAGE(PG8_SB(0, 1), b2 + hstep, voffB); PG8_STAGE(PG8_SA(0, 0), a2, voffA);
            PG8_WAIT_V(8); PG8_WAIT_L(0); PG8_BAR; PG8_MMA(1, 0, At, B0); PG8_MMA(1, 1, At, B1); PG8_BAR; PG8_SCHED;
            PG8_LDB(B0, 1, 0); PG8_LDB(B1, 1, 1); PG8_SCHED; PG8_LDA(At, 1, 0); PG8_STAGE(PG8_SA(0, 1), a2 + hstep, voffA);
            PG8_WAIT_V(8); PG8_WAIT_L(0); PG8_BAR; PG8_MMA(0, 0, At, B0); PG8_MMA(0, 1, At, B1); PG8_BAR; PG8_SCHED;
            PG8_LDA(At, 1, 1); PG8_STAGE(PG8_SB(1, 0), b3, voffB); PG8_STAGE(PG8_SB(1, 1), b3 + hstep, voffB); PG8_STAGE(PG8_SA(1, 0), a3, voffA);
            PG8_WAIT_V(8); PG8_WAIT_L(0); PG8_BAR; PG8_MMA(1, 0, At, B0); PG8_MMA(1, 1, At, B1); PG8_BAR; PG8_SCHED;
            } else {
            PG8_LDB(B0, 0, 0); PG8_SCHED; PG8_LDA(At, 0, 0); PG8_STAGE(PG8_SA(1, 1), a1 + hstep, voffA);
            PG8_WAIT_L(8); PG8_BAR; PG8_WAIT_L(0); PG8_MMA(0, 0, At, B0); PG8_BAR; PG8_SCHED;
            PG8_LDB(B1, 0, 1); PG8_STAGE(PG8_SB(0, 0), b2, voffB);
            PG8_BAR; PG8_WAIT_L(0); PG8_MMA(0, 1, At, B1); PG8_BAR;
            PG8_LDA(At, 0, 1); PG8_STAGE(PG8_SA(0, 0), a2, voffA);
            PG8_BAR; PG8_WAIT_L(0); PG8_MMA(1, 0, At, B0); PG8_BAR; PG8_SCHED;
            PG8_STAGE(PG8_SB(0, 1), b2 + hstep, voffB);
            PG8_WAIT_V(6); PG8_BAR; PG8_MMA(1, 1, At, B1); PG8_BAR;
            PG8_LDB(B0, 1, 0); PG8_SCHED; PG8_LDA(At, 1, 0); PG8_STAGE(PG8_SA(0, 1), a2 + hstep, voffA);
            PG8_WAIT_L(8); PG8_BAR; PG8_WAIT_L(0); PG8_MMA(0, 0, At, B0); PG8_BAR; PG8_SCHED;
            PG8_LDB(B1, 1, 1); PG8_STAGE(PG8_SB(1, 0), b3, voffB);
            PG8_BAR; PG8_WAIT_L(0); PG8_MMA(0, 1, At, B1); PG8_BAR;
            PG8_LDA(At, 1, 1); PG8_STAGE(PG8_SA(1, 0), a3, voffA);
            PG8_BAR; PG8_WAIT_L(0); PG8_MMA(1, 0, At, B0); PG8_BAR; PG8_SCHED;
            PG8_STAGE(PG8_SB(1, 1), b3 + hstep, voffB);
            PG8_WAIT_V(6); PG8_BAR; PG8_MMA(1, 1, At, B1); PG8_BAR;
            }
        }
        if constexpr (ALIGN_EPI) { if (wr == 0) PG8_BAR; }
        if constexpr (!Epi::AFTER_DRAIN) { E(acc, cur, wr, wc, fr, fq); S.done(cur); }
        if (!has_next) break;
#pragma unroll
        for (int a = 0; a < 2; ++a)
#pragma unroll
            for (int b = 0; b < 2; ++b)
#pragma unroll
                for (int m = 0; m < 4; ++m)
#pragma unroll
                    for (int n = 0; n < 2; ++n) acc[a][b][m][n] = (f32x4){0.f, 0.f, 0.f, 0.f};
        cur = nxt; cA = nA; cB = nB; ++ui;
        if constexpr (ALIGN_EPI) { if (wr == 1) PG8_BAR; }
    }
    PG8_WAIT_V(0);
    if constexpr (!ALIGN_EPI) { if (wr == 0) PG8_BAR; }
    PG8_BAR;
    if constexpr (Epi::AFTER_DRAIN) { E.fused(acc, cur, wr, wc, fr, fq, lds, wid, lane); S.done(cur); }
#undef PG8_SA
#undef PG8_SB
#undef PG8_STAGE
#undef PG8_LDA
#undef PG8_LDB
#undef PG8_MMA
#undef PG8_WAIT_V
#undef PG8_WAIT_L
#undef PG8_BAR
#undef PG8_SCHED
}
template <class Epi, class Sched, bool ALIGN_EPI = false, bool SP2 = false, bool ABLK = false, bool BBLK = false>
__device__ __forceinline__ void gemm_phase_f8(PG8_LAS unsigned char* lds, const Gemm g, const Sched& S, const Epi& E) {
    int tid = threadIdx.x; asm volatile("" : "+v"(tid));
    const int wid = __builtin_amdgcn_readfirstlane(tid >> 6), lane = tid & 63, wr = wid >> 2, wc = wid & 3, fr = lane & 15, fq = lane >> 4;
    const int K = g.K  , nt = K / 128;
    unsigned voffA[2], voffB[2];
#pragma unroll
    for (int i = 0; i < 2; ++i) { int R, C; stage_rc(tid * 16 + i * 8192, R, C); const int Rb = Epi::PERM ? ((R & ~31) + perm32(R & 31)) : R;
        voffA[i] = ABLK ? (unsigned)((R >> 4) * (K * 16) + ((2 * C) >> 5) * 512 + (R & 15) * 32 + ((2 * C) & 31)) : (unsigned)(R * K + 2 * C);
        voffB[i] = BBLK ? (unsigned)((Rb >> 4) * (K * 16) + ((2 * C) >> 5) * 512 + (Rb & 15) * 32 + ((2 * C) & 31)) : (unsigned)(Rb * K + 2 * C); }
    const size_t kstepA = ABLK ? (size_t)2048 : (size_t)(BK * 2), kstepB = BBLK ? (size_t)2048 : (size_t)(BK * 2);
    const size_t hstep = (size_t)HALF * K;
    const size_t tstep = 2 * hstep;
    const unsigned ldsw = (unsigned)wid * 1024u;
    const int aoff = lds_byte(wr * 64 + fr, fq * 8), boff = lds_byte(wc * 32 + fr, fq * 8);
#define PG8_SA(b, h) (((b) * 2 + (h)) * HTB)
#define PG8_SB(b, h) ((4 + (b) * 2 + (h)) * HTB)
#define PG8_STAGE(bufoff, gbase, voff) do { _Pragma("unroll") for (int _i = 0; _i < 2; ++_i) \
        __builtin_amdgcn_global_load_lds((const unsigned*)((const char*)(gbase) + (voff)[_i]), (PG8_LAS unsigned*)(lds + (bufoff) + ldsw + _i * 8192), 16, 0, 0); } while (0)
#define PG8_LD32(p) __builtin_bit_cast(i32x8, __builtin_shufflevector(*(const PG8_LAS bf16x8*)(p), *(const PG8_LAS bf16x8*)((p) + 1024), 0, 1, 2, 3, 4, 5, 6, 7, 8, 9, 10, 11, 12, 13, 14, 15))
#define PG8_LDA(dst, b, h) do { _Pragma("unroll") for (int m = 0; m < 4; ++m) dst[m] = PG8_LD32(lds + PG8_SA(b, h) + aoff + m * 2048); } while (0)
#define PG8_LDB(dst, b, h) do { _Pragma("unroll") for (int n = 0; n < 2; ++n) dst[n] = PG8_LD32(lds + PG8_SB(b, h) + boff + n * 2048); } while (0)
#define PG8_MMA(ai, bj, At, Bt) do { __builtin_amdgcn_s_setprio(1); _Pragma("unroll") for (int m = 0; m < 4; ++m) _Pragma("unroll") for (int n = 0; n < 2; ++n) \
        asm volatile("v_mfma_f32_16x16x128_f8f6f4 %0, %1, %2, %0" : "+v"(acc[ai][bj][m][n]) : "v"(Bt[n]), "v"(At[m])); __builtin_amdgcn_s_setprio(0); } while (0)
#define PG8_WAIT_V(n) asm volatile("s_waitcnt vmcnt(" #n ")" ::: "memory")
#define PG8_WAIT_L(n) asm volatile("s_waitcnt lgkmcnt(" #n ")" ::: "memory")
#define PG8_BAR __builtin_amdgcn_s_barrier()
#define PG8_SCHED __builtin_amdgcn_sched_barrier(0)
    Unit cur, nxt; int ui = 0;
    if (!S.next(0, cur)) return;
    f32x4 acc[2][2][4][2];
#pragma unroll
    for (int a = 0; a < 2; ++a)
#pragma unroll
        for (int b = 0; b < 2; ++b)
#pragma unroll
            for (int m = 0; m < 4; ++m)
#pragma unroll
                for (int n = 0; n < 2; ++n) acc[a][b][m][n] = (f32x4){0.f, 0.f, 0.f, 0.f};
    i32x8 At[4], B0[2], B1[2];
    const char* cA = (const char*)g.A + (size_t)cur.pm * tstep; const char* cB = (const char*)g.Bt + (size_t)cur.pn * tstep;
    S.a_ready(cur);
    if constexpr (SP2) {
        PG8_STAGE(PG8_SB(0, 0), cB, voffB); PG8_STAGE(PG8_SB(0, 1), cB + hstep, voffB); PG8_STAGE(PG8_SA(0, 0), cA, voffA); PG8_STAGE(PG8_SA(0, 1), cA + hstep, voffA);
        if (wr == 1) PG8_BAR;
        PG8_WAIT_V(2); PG8_BAR;
        PG8_STAGE(PG8_SB(1, 0), cB + kstepB, voffB); PG8_STAGE(PG8_SA(1, 0), cA + kstepA, voffA); PG8_STAGE(PG8_SB(1, 1), cB + hstep + kstepB, voffB);
        PG8_WAIT_V(6); PG8_BAR;
    } else {
        PG8_STAGE(PG8_SB(0, 0), cB, voffB); PG8_STAGE(PG8_SA(0, 0), cA, voffA); PG8_STAGE(PG8_SB(0, 1), cB + hstep, voffB); PG8_STAGE(PG8_SA(0, 1), cA + hstep, voffA);
        if (wr == 1) PG8_BAR;
        PG8_WAIT_V(4); PG8_BAR;
        PG8_STAGE(PG8_SB(1, 0), cB + kstepB, voffB); PG8_STAGE(PG8_SA(1, 0), cA + kstepA, voffA); PG8_STAGE(PG8_SB(1, 1), cB + hstep + kstepB, voffB);
        PG8_WAIT_V(6); PG8_BAR;
    }
    for (;;) {
        const bool has_next = S.next(ui + 1, nxt);
        const char* nA = has_next ? (const char*)g.A + (size_t)nxt.pm * tstep : cA; const char* nB = has_next ? (const char*)g.Bt + (size_t)nxt.pn * tstep : cB;
        for (int t = 0; t < nt; t += 2) {
            const bool last = (t == nt - 2);
            const char* a1 = cA + (size_t)(t + 1) * kstepA;
            const char* a2 = last ? nA : cA + (size_t)(t + 2) * kstepA; const char* b2 = last ? nB : cB + (size_t)(t + 2) * kstepB;
            const char* a3 = a2 + kstepA; const char* b3 = b2 + kstepB;
            if (last && has_next) S.a_ready(nxt);
            if constexpr (SP2) {
            PG8_LDB(B0, 0, 0); PG8_LDB(B1, 0, 1); PG8_SCHED; PG8_LDA(At, 0, 0); PG8_STAGE(PG8_SA(1, 1), a1 + hstep, voffA);
            PG8_WAIT_V(8); PG8_WAIT_L(0); PG8_BAR; PG8_MMA(0, 0, At, B0); PG8_MMA(0, 1, At, B1); PG8_BAR; PG8_SCHED;
            PG8_LDA(At, 0, 1); PG8_STAGE(PG8_SB(0, 0), b2, voffB); PG8_STAGE(PG8_SB(0, 1), b2 + hstep, voffB); PG8_STAGE(PG8_SA(0, 0), a2, voffA);
            PG8_WAIT_V(8); PG8_WAIT_L(0); PG8_BAR; PG8_MMA(1, 0, At, B0); PG8_MMA(1, 1, At, B1); PG8_BAR; PG8_SCHED;
            PG8_LDB(B0, 1, 0); PG8_LDB(B1, 1, 1); PG8_SCHED; PG8_LDA(At, 1, 0); PG8_STAGE(PG8_SA(0, 1), a2 + hstep, voffA);
            PG8_WAIT_V(8); PG8_WAIT_L(0); PG8_BAR; PG8_MMA(0, 0, At, B0); PG8_MMA(0, 1, At, B1); PG8_BAR; PG8_SCHED;
            PG8_LDA(At, 1, 1); PG8_STAGE(PG8_SB(1, 0), b3, voffB); PG8_STAGE(PG8_SB(1, 1), b3 + hstep, voffB); PG8_STAGE(PG8_SA(1, 0), a3, voffA);
            PG8_WAIT_V(8); PG8_WAIT_L(0); PG8_BAR; PG8_MMA(1, 0, At, B0); PG8_MMA(1, 1, At, B1); PG8_BAR; PG8_SCHED;
            } else {
            PG8_LDB(B0, 0, 0); PG8_SCHED; PG8_LDA(At, 0, 0); PG8_STAGE(PG8_SA(1, 1), a1 + hstep, voffA);
            PG8_WAIT_L(8); PG8_BAR; PG8_WAIT_L(0); PG8_MMA(0, 0, At, B0); PG8_BAR; PG8_SCHED;
            PG8_LDB(B1, 0, 1); PG8_STAGE(PG8_SB(0, 0), b2, voffB);
            PG8_BAR; PG8_WAIT_L(0); PG8_MMA(0, 1, At, B1); PG8_BAR;
            PG8_LDA(At, 0, 1); PG8_STAGE(PG8_SA(0, 0), a2, voffA);
            PG8_BAR; PG8_WAIT_L(0); PG8_MMA(1, 0, At, B0); PG8_BAR; PG8_SCHED;
            PG8_STAGE(PG8_SB(0, 1), b2 + hstep, voffB);
            PG8_WAIT_V(6); PG8_BAR; PG8_MMA(1, 1, At, B1); PG8_BAR;
            PG8_LDB(B0, 1, 0); PG8_SCHED; PG8_LDA(At, 1, 0); PG8_STAGE(PG8_SA(0, 1), a2 + hstep, voffA);
            PG8_WAIT_L(8); PG8_BAR; PG8_WAIT_L(0); PG8_MMA(0, 0, At, B0); PG8_BAR; PG8_SCHED;
            PG8_LDB(B1, 1, 1); PG8_STAGE(PG8_SB(1, 0), b3, voffB);
            PG8_BAR; PG8_WAIT_L(0); PG8_MMA(0, 1, At, B1); PG8_BAR;
            PG8_LDA(At, 1, 1); PG8_STAGE(PG8_SA(1, 0), a3, voffA);
            PG8_BAR; PG8_WAIT_L(0); PG8_MMA(1, 0, At, B0); PG8_BAR; PG8_SCHED;
            PG8_STAGE(PG8_SB(1, 1), b3 + hstep, voffB);
            PG8_WAIT_V(6); PG8_BAR; PG8_MMA(1, 1, At, B1); PG8_BAR;
            }
        }
        if constexpr (ALIGN_EPI) { if (wr == 0) PG8_BAR; }
        asm volatile("s_nop 15\n\ts_nop 15" ::: "memory");
        if constexpr (!Epi::AFTER_DRAIN) { E(acc, cur, wr, wc, fr, fq); S.done(cur); }
        if (!has_next) break;
#pragma unroll
        for (int a = 0; a < 2; ++a)
#pragma unroll
            for (int b = 0; b < 2; ++b)
#pragma unroll
                for (int m = 0; m < 4; ++m)
#pragma unroll
                    for (int n = 0; n < 2; ++n) acc[a][b][m][n] = (f32x4){0.f, 0.f, 0.f, 0.f};
        cur = nxt; cA = nA; cB = nB; ++ui;
        if constexpr (ALIGN_EPI) { if (wr == 1) PG8_BAR; }
    }
    PG8_WAIT_V(0);
    if constexpr (!ALIGN_EPI) { if (wr == 0) PG8_BAR; }
    PG8_BAR;
    if constexpr (Epi::AFTER_DRAIN) { E.fused(acc, cur, wr, wc, fr, fq, lds, wid, lane); S.done(cur); }
#undef PG8_SA
#undef PG8_SB
#undef PG8_STAGE
#undef PG8_LD32
#undef PG8_LDA
#undef PG8_LDB
#undef PG8_MMA
#undef PG8_WAIT_V
#undef PG8_WAIT_L
#undef PG8_BAR
#undef PG8_SCHED
}
}

namespace att {
typedef unsigned short bf16;
typedef short bf16x8 __attribute__((ext_vector_type(8)));
typedef short s16x4 __attribute__((ext_vector_type(4)));
typedef float f32x16 __attribute__((ext_vector_type(16)));
typedef float f32x4 __attribute__((ext_vector_type(4)));
typedef unsigned u32x4 __attribute__((ext_vector_type(4)));
template <class A, class Bt> struct same_t { static constexpr bool v = false; };
template <class A> struct same_t<A, A> { static constexpr bool v = true; };
constexpr int D = 128;
constexpr float SCALE = 0.08838834764831845f;
constexpr float THR = 8.f;
constexpr int NW = 8, QBLK = 32, KVBLK = 64, QB = NW * QBLK;
constexpr int SHM_V = KVBLK * D * 2, SHM_K = KVBLK * D * 2;
constexpr int LDS_WS = 2 * SHM_V + 2 * SHM_K;
constexpr int LDS_SSQ = LDS_WS + NW * 64 * 4;
constexpr int LDS_BYTES = LDS_SSQ + NW * 32 * 4;
typedef int i32x8 __attribute__((ext_vector_type(8)));
typedef int i32x4 __attribute__((ext_vector_type(4)));
#define KSWZ(row, colB) ((row) * 256 + ((colB) ^ (((row) & 15) << 4)))
#define SBAR() __builtin_amdgcn_sched_barrier(0)
__device__ __forceinline__ int v_st(int k, int c) { const int kk = (k & ~0xC) | ((k & 4) << 1) | ((k & 8) >> 1); return ((kk >> 3) * 4 + (c >> 5)) * 512 + ((kk & 7) * 32 + (c & 31)) * 2; }
__device__ __forceinline__ int v_rd_base(int lane) { return ((lane & 3) << 3) | (((lane >> 2) & 3) << 6) | (((lane >> 4) & 1) << 5) | (((lane >> 5) & 1) << 8); }
constexpr int v_rd_off(int d0, int ks, int half) { return d0 * 512 + ks * 4096 + half * 2048; }
__device__ __forceinline__ int crow(int r, int hi) { return (r & 3) + 8 * (r >> 2) + 4 * hi; }
__device__ __forceinline__ unsigned cvtpk(float lo, float hi) {
    unsigned r; asm volatile("v_cvt_pk_bf16_f32 %0, %1, %2" : "=v"(r) : "v"(lo), "v"(hi)); return r;
}
__device__ __forceinline__ bf16x8 pack8(f32x4 a, f32x4 b) {
    u32x4 w = {cvtpk(a[0], a[1]), cvtpk(a[2], a[3]), cvtpk(b[0], b[1]), cvtpk(b[2], b[3])};
    return *reinterpret_cast<bf16x8*>(&w);
}
template <class T> __device__ __forceinline__ bf16x8 load8(const T* p) {
    if constexpr (same_t<T, float>::v) { return pack8(*(const f32x4*)p, *(const f32x4*)(p + 4)); }
    else { return *reinterpret_cast<const bf16x8*>(p); }
}
__device__ __forceinline__ void mask_tile(f32x16& p0, f32x16& p1, int dq, unsigned W) {
    const float NEG = -__builtin_inff();
#pragma unroll
    for (int r = 0; r < 16; ++r) {
        const int c = (r & 3) + 8 * (r >> 2);
        if ((unsigned)(dq - c) >= W) p0[r] = NEG;
        if ((unsigned)(dq - c - 32) >= W) p1[r] = NEG;
    }
}
template <int SH = 0, int THRI = 8, int PSH = 0>
__device__ __forceinline__ void partialSM(f32x16& p0, f32x16& p1, float& m_reg, float& mn, float& alpha, bool dead = false) {
    float pmax;
    { float m0 = fmaxf(p0[0], p0[1]), m1 = fmaxf(p0[2], p0[3]), m2 = fmaxf(p1[0], p1[1]), m3 = fmaxf(p1[2], p1[3]);
#pragma unroll
      for (int r = 4; r < 16; r += 4) { m0 = fmaxf(fmaxf(m0, p0[r]), p0[r + 1]); m1 = fmaxf(fmaxf(m1, p0[r + 2]), p0[r + 3]); m2 = fmaxf(fmaxf(m2, p1[r]), p1[r + 1]); m3 = fmaxf(fmaxf(m3, p1[r + 2]), p1[r + 3]); }
      pmax = fmaxf(fmaxf(m0, m1), fmaxf(m2, m3)); }
    pmax = dead ? -__builtin_inff() : pmax;
    { auto rr = __builtin_amdgcn_permlane32_swap(__float_as_uint(pmax), __float_as_uint(pmax), false, false);
      pmax = fmaxf(__uint_as_float(rr[0]), __uint_as_float(rr[1])); }
    constexpr float SCL = SCALE / (float)(1 << SH), C2 = 1.4426950408889634f * SCL;
    if (__builtin_expect(__all((pmax - m_reg) * SCL <= (float)THRI), 1)) { mn = m_reg; alpha = 1.f; }
    else { mn = fmaxf(m_reg, pmax); alpha = __builtin_amdgcn_exp2f((m_reg - mn) * C2); m_reg = mn; }
    const float mnL = dead ? -__builtin_inff() : -mn * C2 + (float)PSH;
    for (int r = 0; r < 16; ++r) p0[r] = fmaf(p0[r], C2, mnL); for (int r = 0; r < 16; ++r) p1[r] = fmaf(p1[r], C2, mnL);
    for (int r = 0; r < 16; ++r) p0[r] = __builtin_amdgcn_exp2f(p0[r]);
}
__device__ __forceinline__ void finishSM(f32x16& p0, f32x16& p1, float alpha, float& l_reg, bf16x8& pa0, bf16x8& pa1, bf16x8& pa2, bf16x8& pa3) {
    for (int r = 0; r < 16; ++r) p1[r] = __builtin_amdgcn_exp2f(p1[r]);
    float ps;
    { float s0 = p0[0] + p0[1], s1 = p0[2] + p0[3], s2 = p1[0] + p1[1], s3 = p1[2] + p1[3];
#pragma unroll
      for (int r = 4; r < 16; r += 4) { s0 += p0[r]; s0 += p0[r + 1]; s1 += p0[r + 2]; s1 += p0[r + 3]; s2 += p1[r]; s2 += p1[r + 1]; s3 += p1[r + 2]; s3 += p1[r + 3]; }
      ps = (s0 + s1) + (s2 + s3); }
    { auto rr = __builtin_amdgcn_permlane32_swap(__float_as_uint(ps), __float_as_uint(ps), false, false);
      ps = __uint_as_float(rr[0]) + __uint_as_float(rr[1]); }
    l_reg = l_reg * alpha + ps;
#define PK4(P, B_, OUT) do { unsigned a0 = cvtpk(P[B_+0], P[B_+1]), a1 = cvtpk(P[B_+2], P[B_+3]);                          \
        unsigned b0 = cvtpk(P[B_+4], P[B_+5]), b1 = cvtpk(P[B_+6], P[B_+7]);                                             \
        auto r0 = __builtin_amdgcn_permlane32_swap(a0, b0, false, false); auto r1 = __builtin_amdgcn_permlane32_swap(a1, b1, false, false); \
        u32x4 w = {r0[0], r1[0], r0[1], r1[1]}; OUT = *reinterpret_cast<bf16x8*>(&w); } while (0)
    PK4(p0, 0, pa0); PK4(p0, 8, pa1); PK4(p1, 0, pa2); PK4(p1, 8, pa3);
#undef PK4
}
__device__ __forceinline__ void finishSM8(f32x16& p0, f32x16& p1, float alpha, float& l_reg, i32x8& pa) {
    for (int r = 0; r < 16; ++r) p1[r] = __builtin_amdgcn_exp2f(p1[r]);
    float ps;
    { float s0 = p0[0] + p0[1], s1 = p0[2] + p0[3], s2 = p1[0] + p1[1], s3 = p1[2] + p1[3];
#pragma unroll
      for (int r = 4; r < 16; r += 4) { s0 += p0[r]; s0 += p0[r + 1]; s1 += p0[r + 2]; s1 += p0[r + 3]; s2 += p1[r]; s2 += p1[r + 1]; s3 += p1[r + 2]; s3 += p1[r + 3]; }
      ps = (s0 + s1) + (s2 + s3); }
    { auto rr = __builtin_amdgcn_permlane32_swap(__float_as_uint(ps), __float_as_uint(ps), false, false);
      ps = __uint_as_float(rr[0]) + __uint_as_float(rr[1]); }
    l_reg = l_reg * alpha + ps;
#pragma unroll
    for (int d = 0; d < 4; ++d) { int w0 = 0, w1 = 0;
        w0 = __builtin_amdgcn_cvt_pk_fp8_f32(p0[4 * d], p0[4 * d + 1], w0, false); w0 = __builtin_amdgcn_cvt_pk_fp8_f32(p0[4 * d + 2], p0[4 * d + 3], w0, true);
        w1 = __builtin_amdgcn_cvt_pk_fp8_f32(p1[4 * d], p1[4 * d + 1], w1, false); w1 = __builtin_amdgcn_cvt_pk_fp8_f32(p1[4 * d + 2], p1[4 * d + 3], w1, true);
        pa[d] = w0; pa[4 + d] = w1; }
}
__device__ __forceinline__ void mask_tile_perm(f32x16& p0, f32x16& p1, int dq) {
    const float NEG = -__builtin_inff();
#pragma unroll
    for (int r = 0; r < 16; ++r) { const int c = 16 * (r & 3) + (r >> 2);
        if (dq - c < 0) p0[r] = NEG;
        if (dq - c - 4 < 0) p1[r] = NEG; }
}
template <int KB, bool SK>
__device__ __forceinline__ void qkt(f32x16& p0, f32x16& p1, const char* K_lds, int r32, int hi, const bf16x8* qr, bool act) {
    if (SK && !act) { const float NEG = -__builtin_inff();
#pragma unroll
        for (int r = 0; r < 16; ++r) { p0[r] = NEG; p1[r] = NEG; } return; }
    p0 = f32x16{}; p1 = f32x16{};
    typedef const __attribute__((address_space(3))) char* lds_cptr;
    lds_cptr kb[4];
#pragma unroll
    for (int dd = 0; dd < 4; ++dd) kb[dd] = (lds_cptr)(K_lds + KB * SHM_K + KSWZ(r32, (dd * 16 + hi * 8) * 2));
    unsigned flip = 128u; asm volatile("" : "+v"(flip));
#pragma unroll
    for (int d0 = 0; d0 < 8; ++d0) { lds_cptr a = (d0 < 4) ? kb[d0] : (lds_cptr)((unsigned)(__UINTPTR_TYPE__)kb[d0 & 3] ^ flip);
        bf16x8 b0 = *reinterpret_cast<const __attribute__((address_space(3))) bf16x8*>(a);
        bf16x8 b1 = *reinterpret_cast<const __attribute__((address_space(3))) bf16x8*>(a + 32 * 256);
        p0 = __builtin_amdgcn_mfma_f32_32x32x16_bf16(b0, qr[d0], p0, 0, 0, 0);
        p1 = __builtin_amdgcn_mfma_f32_32x32x16_bf16(b1, qr[d0], p1, 0, 0, 0); }
}
template <int KB>
__device__ __forceinline__ void qkt_p(f32x16& p0, f32x16& p1, const char* K_lds, int r32, int hi, const bf16x8* qr) {
    unsigned kb[4], kf[4];
    asm volatile("" : "+v"(r32), "+v"(hi));
#pragma unroll
    for (int dd = 0; dd < 4; ++dd) kb[dd] = (unsigned)(__UINTPTR_TYPE__)K_lds + (unsigned)KSWZ(r32, (dd * 16 + hi * 8) * 2);
    unsigned flip = 128u; asm volatile("" : "+v"(flip));
#pragma unroll
    for (int dd = 0; dd < 4; ++dd) kf[dd] = kb[dd] ^ flip;
    bf16x8 A0, A1, B0, B1, C0, C1;
#define KRD(d0_, d1_, addr) asm volatile("ds_read_b128 %0, %2 offset:%3\n\tds_read_b128 %1, %2 offset:%4" : "=&v"(d0_), "=&v"(d1_) : "v"(addr), "i"(KB * SHM_K), "i"(KB * SHM_K + 32 * 256) : "memory")
#define KWT(n) do { asm volatile("s_waitcnt lgkmcnt(" #n ")" ::: "memory"); SBAR(); } while (0)
#define KMM(f0_, f1_, d0) do { p0 = __builtin_amdgcn_mfma_f32_32x32x16_bf16(f0_, qr[d0], p0, 0, 0, 0); p1 = __builtin_amdgcn_mfma_f32_32x32x16_bf16(f1_, qr[d0], p1, 0, 0, 0); SBAR(); } while (0)
    p0 = f32x16{}; p1 = f32x16{};
    SBAR(); KRD(A0, A1, kb[0]); KRD(B0, B1, kb[1]);
    KRD(C0, C1, kb[2]); KWT(4); KMM(A0, A1, 0);
    KRD(A0, A1, kb[3]); KWT(4); KMM(B0, B1, 1);
    KRD(B0, B1, kf[0]); KWT(4); KMM(C0, C1, 2);
    KRD(C0, C1, kf[1]); KWT(4); KMM(A0, A1, 3);
    KRD(A0, A1, kf[2]); KWT(4); KMM(B0, B1, 4);
    KRD(B0, B1, kf[3]); KWT(4); KMM(C0, C1, 5);
    KWT(2); KMM(A0, A1, 6);
    KWT(0); KMM(B0, B1, 7);
#undef KRD
#undef KWT
#undef KMM
}
template <int KB, bool LOWREG = false>
__device__ __forceinline__ void qkt_f8(f32x16& p0, f32x16& p1, const char* K_lds, int r32, int hi, const i32x8 (&q8)[2]) {
    asm volatile("" : "+v"(r32), "+v"(hi));
    typedef const __attribute__((address_space(3))) bf16x8* lds_f;
    const unsigned sw = (unsigned)((r32 >> 1) & 7), base = (unsigned)(__UINTPTR_TYPE__)K_lds + (unsigned)(r32 * 128) + (unsigned)(KB * SHM_K);
    if constexpr (LOWREG) {
#define KF8(c_, hf_) __builtin_bit_cast(i32x8, __builtin_shufflevector(*(lds_f)(__UINTPTR_TYPE__)(base + ((((unsigned)(4 * (c_) + 2 * hi)) ^ sw) << 4) + (hf_) * 4096),          \
                                                                      *(lds_f)(__UINTPTR_TYPE__)(base + ((((unsigned)(4 * (c_) + 2 * hi + 1)) ^ sw) << 4) + (hf_) * 4096), 0, 1, 2, 3, 4, 5, 6, 7, 8, 9, 10, 11, 12, 13, 14, 15))
        i32x8 f0 = KF8(0, 0), f1 = KF8(0, 1);
        SBAR();
        asm volatile("v_mfma_f32_32x32x64_f8f6f4 %0, %1, %2, 0" : "=&v"(p0) : "v"(f0), "v"(q8[0]));
        asm volatile("v_mfma_f32_32x32x64_f8f6f4 %0, %1, %2, 0" : "=&v"(p1) : "v"(f1), "v"(q8[0]));
        SBAR();
        f0 = KF8(1, 0); f1 = KF8(1, 1);
        SBAR();
        asm volatile("v_mfma_f32_32x32x64_f8f6f4 %0, %1, %2, %0" : "+v"(p0) : "v"(f0), "v"(q8[1]));
        asm volatile("v_mfma_f32_32x32x64_f8f6f4 %0, %1, %2, %0" : "+v"(p1) : "v"(f1), "v"(q8[1]));
        asm volatile("s_nop 15\n\ts_nop 15" ::: "memory");
        SBAR();
#undef KF8
        return;
    }
    i32x8 kf[2][2];
#pragma unroll
    for (int c = 0; c < 2; ++c) { const unsigned a0 = base + ((((unsigned)(4 * c + 2 * hi)) ^ sw) << 4), a1 = base + ((((unsigned)(4 * c + 2 * hi + 1)) ^ sw) << 4);
#pragma unroll
        for (int hf = 0; hf < 2; ++hf)
            kf[c][hf] = __builtin_bit_cast(i32x8, __builtin_shufflevector(*(lds_f)(__UINTPTR_TYPE__)(a0 + hf * 4096), *(lds_f)(__UINTPTR_TYPE__)(a1 + hf * 4096), 0, 1, 2, 3, 4, 5, 6, 7, 8, 9, 10, 11, 12, 13, 14, 15)); }
    SBAR();
    asm volatile("v_mfma_f32_32x32x64_f8f6f4 %0, %1, %2, 0" : "=&v"(p0) : "v"(kf[0][0]), "v"(q8[0]));
    asm volatile("v_mfma_f32_32x32x64_f8f6f4 %0, %1, %2, 0" : "=&v"(p1) : "v"(kf[0][1]), "v"(q8[0]));
    asm volatile("v_mfma_f32_32x32x64_f8f6f4 %0, %1, %2, %0" : "+v"(p0) : "v"(kf[1][0]), "v"(q8[1]));
    asm volatile("v_mfma_f32_32x32x64_f8f6f4 %0, %1, %2, %0" : "+v"(p1) : "v"(kf[1][1]), "v"(q8[1]));
    asm volatile("s_nop 15\n\ts_nop 15" ::: "memory");
    SBAR();
}
template <int VB, bool SK>
__device__ __forceinline__ void pv_tile(f32x16* o, int vb0, bf16x8 pa0, bf16x8 pa1, bf16x8 pa2, bf16x8 pa3, bool act) {
    if (SK && !act) return;
#define TRRD(dst, off) asm volatile("ds_read_b64_tr_b16 %0, %1 offset:%2" : "=&v"(dst) : "v"(vb0), "i"(off) : "memory")
#define PV_D0(d0) do { s16x4 l0, l1, l2, l3, h0, h1, h2, h3; constexpr int b_ = VB * SHM_V + v_rd_off(d0, 0, 0);     \
        TRRD(l0, b_); TRRD(h0, b_ + 2048); TRRD(l1, b_ + 4096); TRRD(h1, b_ + 6144); TRRD(l2, b_ + 8192); TRRD(h2, b_ + 10240); TRRD(l3, b_ + 12288); TRRD(h3, b_ + 14336); \
        asm volatile("s_waitcnt lgkmcnt(0)" ::: "memory"); SBAR();                 \
        o[d0] = __builtin_amdgcn_mfma_f32_32x32x16_bf16(pa0, (bf16x8){l0[0], l0[1], l0[2], l0[3], h0[0], h0[1], h0[2], h0[3]}, o[d0], 0, 0, 0);   \
        o[d0] = __builtin_amdgcn_mfma_f32_32x32x16_bf16(pa1, (bf16x8){l1[0], l1[1], l1[2], l1[3], h1[0], h1[1], h1[2], h1[3]}, o[d0], 0, 0, 0);   \
        o[d0] = __builtin_amdgcn_mfma_f32_32x32x16_bf16(pa2, (bf16x8){l2[0], l2[1], l2[2], l2[3], h2[0], h2[1], h2[2], h2[3]}, o[d0], 0, 0, 0);   \
        o[d0] = __builtin_amdgcn_mfma_f32_32x32x16_bf16(pa3, (bf16x8){l3[0], l3[1], l3[2], l3[3], h3[0], h3[1], h3[2], h3[3]}, o[d0], 0, 0, 0); } while (0)
    PV_D0(0); PV_D0(1); PV_D0(2); PV_D0(3);
#undef PV_D0
#undef TRRD
}

struct BlockRef { const bf16* Q; const bf16* K; const bf16* V; int P0; };
struct Seam { bf16x8 qr[8]; bf16x8 st_v0, st_v1, st_k0, st_k1; i32x8 q8[2]; };
#define ROW(p, k0, rr) ((p) + (size_t)((k0) + (rr)) * D + sc)
#define VMW() asm volatile("s_waitcnt vmcnt(0)" ::: "memory")
#define SLOAD_H(Kp, Vp, k0) do { if constexpr (F8) { S.st_v0 = *reinterpret_cast<const bf16x8*>((const char*)(Vp) + (size_t)(k0) * 128 + tid * 16);                 \
                                             S.st_k0 = *reinterpret_cast<const bf16x8*>((const char*)(Kp) + (size_t)((k0) + kp8) * 128 + kc8); }                 \
                         else { S.st_v0 = load8<bf16>(ROW(Vp, k0, sr)); S.st_v1 = load8<bf16>(ROW(Vp, k0, 32 + sr));                                              \
                                S.st_k0 = load8<bf16>(ROW(Kp, k0, sr)); S.st_k1 = load8<bf16>(ROW(Kp, k0, 32 + sr)); } } while (0)
#define SWRITE_HK(bf) do { if constexpr (F8) { *(bf16x8*)(K_lds + (bf) * SHM_K + kws8) = S.st_k0; }                                                          \
                           else { *(bf16x8*)(K_lds + (bf) * SHM_K + kws) = S.st_k0; *(bf16x8*)(K_lds + (bf) * SHM_K + kws + 32 * 256) = S.st_k1; } } while (0)
#define SWRITE_HV(bf) do { if constexpr (F8) { *(bf16x8*)(V_lds + (bf) * SHM_V + vws8) = S.st_v0; }                                                          \
                           else { *(bf16x8*)(V_lds + (bf) * SHM_V + vst0) = S.st_v0; *(bf16x8*)(V_lds + (bf) * SHM_V + vst1) = S.st_v1; } } while (0)
#define SWRITE_H(bf) do { SWRITE_HV(bf); SWRITE_HK(bf); } while (0)
constexpr int KM_LDS = 69632, KM_PITCH = 132;
template <bool F8 = false, bool KML = false>
__device__ __forceinline__ void prime(const BlockRef& cur, char* lds, Seam& S, const float* KMg = nullptr) {
    int tid = threadIdx.x; asm volatile("" : "+v"(tid));
    const int wid = __builtin_amdgcn_readfirstlane(tid >> 6), lane = tid & 63, r32 = lane & 31, hi = lane >> 5;
    const int sr = tid >> 4, sc = (tid & 15) * 8, kws = KSWZ(sr, sc * 2); char* K_lds = lds + 2 * SHM_V;
    const int kr8 = tid >> 3, kc8 = (tid & 7) * 16, kws8 = kr8 * 128 + (((tid & 7) ^ ((kr8 >> 1) & 7)) << 4);
    const int krp8 = kr8 & 31, kt8 = (krp8 & 3) + 4 * (krp8 >> 3) + 16 * (kr8 >> 5), kp8 = 16 * (kt8 & 3) + (kt8 >> 2) + 8 * ((krp8 >> 2) & 1);
    f32x4 kmv = {0.f, 0.f, 0.f, 0.f};
    if constexpr (KML) kmv = *(const f32x4*)(KMg + tid * 4);
#pragma unroll
    for (int d0 = 0; d0 < 8; ++d0) S.qr[d0] = load8<bf16>(cur.Q + (size_t)(wid * QBLK + r32) * D + d0 * 16 + hi * 8);
    SLOAD_H(cur.K, cur.V, 0); VMW(); SWRITE_HK(0);
    if constexpr (KML) *(f32x4*)((float*)(lds + KM_LDS) + (tid >> 5) * KM_PITCH + (tid & 31) * 4) = kmv * (1.0f / 256.0f);
    __syncthreads();
}
template <class Epi, bool F8 = false>
__device__ __forceinline__ void block(const BlockRef& cur, int skv, char* lds, Seam& S, bool moba, unsigned selmask, const Epi& E) {
    int tid = threadIdx.x; asm volatile("" : "+v"(tid));
    const int wid = __builtin_amdgcn_readfirstlane(tid >> 6), lane = tid & 63, r32 = lane & 31, hi = lane >> 5;
    int j_hi = (cur.P0 + QB - 1) / KVBLK + 1; if (j_hi > skv / KVBLK) j_hi = skv / KVBLK;
    const int NT = j_hi;
    const int qlo = cur.P0 + wid * QBLK, qm = qlo + r32 - 4 * hi;
    char* V_lds = lds; char* K_lds = lds + 2 * SHM_V;
    float* ws = (float*)(lds + LDS_WS) + wid * 64; float* li_l = ws, * al_l = ws + 32;
    float m_reg = -1e30f, l_reg = 0; f32x16 o[4] = {};
    const int sr = tid >> 4, sc = (tid & 15) * 8, vst0 = v_st(sr, sc), vst1 = v_st(32 + sr, sc), kws = KSWZ(sr, sc * 2);
    const int kr8 = tid >> 3, kc8 = (tid & 7) * 16, kws8 = kr8 * 128 + (((tid & 7) ^ ((kr8 >> 1) & 7)) << 4);
    const int krp8 = kr8 & 31, kt8 = (krp8 & 3) + 4 * (krp8 >> 3) + 16 * (kr8 >> 5), kp8 = 16 * (kt8 & 3) + (kt8 >> 2) + 8 * ((krp8 >> 2) & 1);
    const int vc8 = tid >> 2, vws8 = vc8 * 64 + (((tid & 3) ^ ((vc8 >> 2) & 3)) << 4), qm8 = qlo + r32 - 8 * hi;
    typedef const __attribute__((address_space(3))) bf16x8* lds_f;
    const unsigned vsw = (unsigned)((r32 >> 2) & 3), va0 = (unsigned)(__UINTPTR_TYPE__)V_lds + (unsigned)(r32 * 64) + (((unsigned)(2 * hi) ^ vsw) << 4), va1 = (unsigned)(__UINTPTR_TYPE__)V_lds + (unsigned)(r32 * 64) + (((unsigned)(2 * hi + 1) ^ vsw) << 4);
    i32x8 pa8;
#define VF8N(VB_, g) __builtin_bit_cast(i32x8, __builtin_shufflevector(*(lds_f)(__UINTPTR_TYPE__)(va0 + (VB_) * SHM_V + (g) * 2048), *(lds_f)(__UINTPTR_TYPE__)(va1 + (VB_) * SHM_V + (g) * 2048), 0, 1, 2, 3, 4, 5, 6, 7, 8, 9, 10, 11, 12, 13, 14, 15))
#define MM8(g, f_) asm volatile("v_mfma_f32_32x32x64_f8f6f4 %0, %1, %2, %0" : "+v"(o[g]) : "v"(pa8), "v"(f_))
#define PV8(VB_) do { SBAR(); i32x8 f0_ = VF8N(VB_, 0), f1_ = VF8N(VB_, 1); SBAR(); MM8(0, f0_); f0_ = VF8N(VB_, 2); SBAR(); MM8(1, f1_); f1_ = VF8N(VB_, 3); SBAR(); MM8(2, f0_); MM8(3, f1_);   \
        asm volatile("s_nop 15\n\ts_nop 15" ::: "memory"); SBAR(); } while (0)
#define FIN(PY0_, PY1_, alY_) do { if constexpr (F8) finishSM8(PY0_, PY1_, alY_, l_reg, pa8); else finishSM(PY0_, PY1_, alY_, l_reg, pa0, pa1, pa2, pa3); } while (0)
#define PVT(VB_) do { if constexpr (F8) PV8(VB_); else pv_tile<VB_, false>(o, vb0, pa0, pa1, pa2, pa3, true); } while (0)
#define PSM(P0_, P1_, mn_, al_) partialSM<F8 ? 8 : 0, F8 ? 2 : 8, F8 ? 5 : 0>(P0_, P1_, m_reg, mn_, al_, dead_)
    bool dead_ = false;
    const int vb0 = (int)(uintptr_t)V_lds + v_rd_base(lane);
    const bf16* Kh = cur.K; const bf16* Vh = cur.V;
#define RESC(a) do { if (__any((a) < 1.f)) { if (hi == 0) al_l[r32] = (a); asm volatile("s_waitcnt lgkmcnt(0)" ::: "memory");              \
                     for (int d_ = 0; d_ < 4; ++d_) for (int r = 0; r < 16; ++r) o[d_][r] *= al_l[crow(r, hi)]; } } while (0)
#define KBASE(t) ((t) * KVBLK)
#define QKT(KB_, P0_, P1_) do { if constexpr (F8) qkt_f8<KB_, true>(P0_, P1_, K_lds, r32, hi, S.q8); else qkt<KB_, false>(P0_, P1_, K_lds, r32, hi, S.qr, true); } while (0)
#define MASKT(P0_, P1_, t) do { const int kb_ = KBASE(t); if (kb_ + KVBLK - 1 > qlo) { if constexpr (F8) mask_tile_perm(P0_, P1_, qm8 - kb_); else mask_tile(P0_, P1_, qm - kb_, 0x7fffffffu); }   \
        dead_ = moba && kb_ < cur.P0 && (((selmask >> (kb_ >> 8)) & 1u) == 0u); } while (0)
    f32x16 pA0, pA1, pB0, pB1; float mnA, mnB, alA, alB; bf16x8 pa0, pa1, pa2, pa3;
    SWRITE_HV(0); SBAR();
    if (NT > 1) SLOAD_H(Kh, Vh, KBASE(1));
    SBAR(); QKT(0, pA0, pA1);
    MASKT(pA0, pA1, 0); PSM(pA0, pA1, mnA, alA);
    if (NT > 1) { VMW(); SWRITE_H(1); }
    __syncthreads();
#define HALF_STEP(PX0, PX1, mnX, alX, PY0, PY1, alY, t, KB, VB, SB) do {                                                      \
        SBAR(); QKT(KB, PX0, PX1);                                                         \
        FIN(PY0, PY1, alY); SBAR();                                                           \
        if ((t) + 1 < NT) { SLOAD_H(Kh, Vh, KBASE((t) + 1)); SBAR(); }                                                        \
        PVT(VB); MASKT(PX0, PX1, (t)); PSM(PX0, PX1, mnX, alX);     \
        __syncthreads();                                                                                                      \
        if ((t) + 1 < NT) { VMW(); SWRITE_H(SB); }                                                                            \
        RESC(alX); __syncthreads(); } while (0)
    for (int t = 1; t + 1 < NT; t += 2) {
        HALF_STEP(pB0, pB1, mnB, alB, pA0, pA1, alA, t, 1, 0, 0);
        HALF_STEP(pA0, pA1, mnA, alA, pB0, pB1, alB, t + 1, 0, 1, 1);
    }
    const bool even = (NT & 1) == 0;
    if (even) { SBAR(); QKT(1, pB0, pB1); SBAR(); }
    FIN(pA0, pA1, alA); SBAR();
    PVT(0);
    if (even) { MASKT(pB0, pB1, NT - 1); PSM(pB0, pB1, mnB, alB); __syncthreads(); RESC(alB);
        FIN(pB0, pB1, alB); SBAR(); PVT(1); }
    SBAR();
    if (hi == 0) li_l[r32] = l_reg; asm volatile("s_waitcnt lgkmcnt(0)" ::: "memory");
    float rli[16];
#pragma unroll
    for (int r = 0; r < 16; ++r) rli[r] = __builtin_amdgcn_rcpf(li_l[crow(r, hi)]) * (F8 ? 1.0f / 16.0f : 1.0f);
    E(o, rli, wid, lane, r32, hi);
    __syncthreads();
#undef RESC
#undef KBASE
#undef QKT
#undef VF8N
#undef MM8
#undef PV8
#undef FIN
#undef PVT
#undef PSM
#undef MASKT
#undef HALF_STEP
}
constexpr int WIDE_WS = 4 * SHM_V + 2 * SHM_K;
constexpr int WIDE_BYTES = WIDE_WS + NW * 64 * 4;
template <class Epi, int VAR = 0>
__device__ __forceinline__ void block_wide(const BlockRef& cur, const bf16* V2, int skv, char* lds, Seam& S, const Epi& E) {
    int tid = threadIdx.x; asm volatile("" : "+v"(tid));
    const int wid = __builtin_amdgcn_readfirstlane(tid >> 6), lane = tid & 63, r32 = lane & 31, hi = lane >> 5;
    int j_hi = (cur.P0 + QB - 1) / KVBLK + 1; if (j_hi > skv / KVBLK) j_hi = skv / KVBLK;
    const int NT = j_hi;
    const int qlo = cur.P0 + wid * QBLK, qm = qlo + r32 - 4 * hi;
    char* V_lds = lds; char* K_lds = lds + 4 * SHM_V;
    float* ws = (float*)(lds + WIDE_WS) + wid * 64; float* li_l = ws, * al_l = ws + 32;
    float m_reg = -1e30f, l_reg = 0; f32x16 o[8] = {};
    const int vb0 = (int)(uintptr_t)V_lds + v_rd_base(lane);
    const int krow = 8 * wid + (lane >> 3);
    const unsigned koff = (unsigned)(krow * 128 + (((lane & 7) ^ ((krow >> 1) & 7)) << 4));
    const int vkk = (wid >> 1) * 8 + ((lane >> 2) & 7), vkey = (vkk & ~0xC) | ((vkk & 4) << 1) | ((vkk & 8) >> 1);
    const unsigned voff = (unsigned)(vkey * 256 + ((((wid & 1) * 2 + (lane >> 5)) * 32 + (lane & 3) * 8) * 2));
    const char* Kh = (const char*)cur.K; const char* Va = (const char*)cur.V; const char* Vb = (const char*)V2;
    typedef __attribute__((address_space(3))) unsigned* lds_uptr;
#define WDMA(gb, ldsb) do { __builtin_amdgcn_global_load_lds((const unsigned*)((gb) + voff_), (lds_uptr)((ldsb) + wid * 1024), 16, 0, 0);                    \
                            __builtin_amdgcn_global_load_lds((const unsigned*)((gb) + 8192 + voff_), (lds_uptr)((ldsb) + 8192 + wid * 1024), 16, 0, 0); } while (0)
#define WLOADK(k0, par) do { if constexpr (VAR == 4) { if ((k0) > 0) break; } const size_t tb_ = (VAR == 5) ? (size_t)0 : (size_t)(k0) * D;                                            \
        __builtin_amdgcn_global_load_lds((const unsigned*)(Kh + tb_ + koff), (lds_uptr)(K_lds + (par) * SHM_K + wid * 1024), 16, 0, 0); } while (0)
#define WLOADV(k0, par) do { if constexpr (VAR == 4) { if ((k0) > 0) break; } const size_t tb_ = (VAR == 5) ? (size_t)0 : (size_t)(k0) * (D * 2); const unsigned voff_ = voff;                                \
        WDMA(Va + tb_, V_lds + (2 * (par)) * SHM_V); WDMA(Vb + tb_, V_lds + (2 * (par) + 1) * SHM_V); } while (0)
    i32x8 q8[2];
    { const i32x4* qp = (const i32x4*)((const char*)cur.Q + (size_t)(wid * QBLK + r32) * D + hi * 32);
#pragma unroll
      for (int c = 0; c < 2; ++c) { const i32x4 lo_ = qp[4 * c], hi_ = qp[4 * c + 1]; q8[c] = (i32x8){lo_[0], lo_[1], lo_[2], lo_[3], hi_[0], hi_[1], hi_[2], hi_[3]}; } }
    WLOADK(0, 0); WLOADV(0, 0); VMW();
    __syncthreads();
    f32x16 p0, p1; float mn, al; bf16x8 pa0, pa1, pa2, pa3;
#define WBAR() do { asm volatile("s_waitcnt vmcnt(0) lgkmcnt(0)" ::: "memory"); __builtin_amdgcn_s_barrier(); asm volatile("" ::: "memory"); } while (0)
#define WBARN(more, n) do { if (more) asm volatile("s_waitcnt vmcnt(" #n ") lgkmcnt(0)" ::: "memory"); else asm volatile("s_waitcnt vmcnt(0) lgkmcnt(0)" ::: "memory");                 \
        __builtin_amdgcn_s_barrier(); asm volatile("" ::: "memory"); } while (0)
#define WQKSM(t, PAR) do { __builtin_amdgcn_s_setprio(1);       \
        qkt_f8<PAR>(p0, p1, K_lds, r32, hi, q8);                                                                                                   \
        { const int kb_ = (t) * KVBLK; if (kb_ + KVBLK - 1 > qlo) mask_tile(p0, p1, qm - kb_, 0x7fffffffu); }                                      \
        if constexpr (VAR != 1) { partialSM<8>(p0, p1, m_reg, mn, al);                                                                               \
        if (__any(al < 1.f)) { if (hi == 0) al_l[r32] = al; asm volatile("s_waitcnt lgkmcnt(0)" ::: "memory");                                     \
            for (int d_ = 0; d_ < 8; ++d_) for (int r = 0; r < 16; ++r) o[d_][r] *= al_l[crow(r, hi)]; }                                            \
        finishSM(p0, p1, al, l_reg, pa0, pa1, pa2, pa3); }                                                                                         \
        else { pa0 = pack8(f32x4{p0[0], p0[1], p0[2], p0[3]}, f32x4{p0[4], p0[5], p0[6], p0[7]}); pa1 = pack8(f32x4{p0[8], p0[9], p0[10], p0[11]}, f32x4{p0[12], p0[13], p0[14], p0[15]});   \
               pa2 = pack8(f32x4{p1[0], p1[1], p1[2], p1[3]}, f32x4{p1[4], p1[5], p1[6], p1[7]}); pa3 = pack8(f32x4{p1[8], p1[9], p1[10], p1[11]}, f32x4{p1[12], p1[13], p1[14], p1[15]}); l_reg += p0[0]; } \
        __builtin_amdgcn_s_setprio(0); SBAR(); } while (0)
    s16x4 Xl0, Xl1, Xl2, Xl3, Xh0, Xh1, Xh2, Xh3, Yl0, Yl1, Yl2, Yl3, Yh0, Yh1, Yh2, Yh3;
#define TRRD(dst, off) asm volatile("ds_read_b64_tr_b16 %0, %1 offset:%2" : "=&v"(dst) : "v"(vb0), "i"(off) : "memory")
#define WRD(S_, PAR, g) do { constexpr int b_ = (2 * (PAR) + ((g) >> 2)) * SHM_V + ((g) & 3) * 512;                                                \
        TRRD(S_##l0, b_); TRRD(S_##h0, b_ + 2048); TRRD(S_##l1, b_ + 4096); TRRD(S_##h1, b_ + 6144);                                             \
        TRRD(S_##l2, b_ + 8192); TRRD(S_##h2, b_ + 10240); TRRD(S_##l3, b_ + 12288); TRRD(S_##h3, b_ + 14336); } while (0)
#define WMM(S_, g) do {                                                                                                                            \
        o[g] = __builtin_amdgcn_mfma_f32_32x32x16_bf16(pa0, (bf16x8){S_##l0[0], S_##l0[1], S_##l0[2], S_##l0[3], S_##h0[0], S_##h0[1], S_##h0[2], S_##h0[3]}, o[g], 0, 0, 0);   \
        o[g] = __builtin_amdgcn_mfma_f32_32x32x16_bf16(pa1, (bf16x8){S_##l1[0], S_##l1[1], S_##l1[2], S_##l1[3], S_##h1[0], S_##h1[1], S_##h1[2], S_##h1[3]}, o[g], 0, 0, 0);   \
        o[g] = __builtin_amdgcn_mfma_f32_32x32x16_bf16(pa2, (bf16x8){S_##l2[0], S_##l2[1], S_##l2[2], S_##l2[3], S_##h2[0], S_##h2[1], S_##h2[2], S_##h2[3]}, o[g], 0, 0, 0);   \
        o[g] = __builtin_amdgcn_mfma_f32_32x32x16_bf16(pa3, (bf16x8){S_##l3[0], S_##l3[1], S_##l3[2], S_##l3[3], S_##h3[0], S_##h3[1], S_##h3[2], S_##h3[3]}, o[g], 0, 0, 0); SBAR(); } while (0)
#define WW8() do { asm volatile("s_waitcnt lgkmcnt(8)" ::: "memory"); SBAR(); } while (0)
#define WPV(PAR) do { if constexpr (VAR == 2) { o[0][0] += (float)pa0[0] + (float)pa1[0] + (float)pa2[0] + (float)pa3[0]; break; } SBAR(); WRD(X, PAR, 0); WRD(Y, PAR, 1); WW8(); WMM(X, 0); WRD(X, PAR, 2); WW8(); WMM(Y, 1); WRD(Y, PAR, 3); WW8(); WMM(X, 2); WRD(X, PAR, 4); WW8(); WMM(Y, 3);    \
        WRD(Y, PAR, 5); WW8(); WMM(X, 4); WRD(X, PAR, 6); WW8(); WMM(Y, 5); WRD(Y, PAR, 7); WW8(); WMM(X, 6); asm volatile("s_waitcnt lgkmcnt(0)" ::: "memory"); SBAR(); WMM(Y, 7); } while (0)
    if (wid < 4) {
#define WSTEP_L(t, PAR) do { const bool more_ = (t) + 1 < NT; if (more_) WLOADK(((t) + 1) * KVBLK, 1 - PAR); WQKSM(t, PAR); WBARN(more_, 1); if (more_) WLOADV(((t) + 1) * KVBLK, 1 - PAR); WPV(PAR); WBARN(more_, 4); } while (0)
        for (int t = 0; t < NT; t += 2) { WSTEP_L(t, 0); WSTEP_L(t + 1, 1); }
        WBAR();
#undef WSTEP_L
    } else {
#define WSTEP_T(t, PAR) do { const bool more_ = (t) + 1 < NT; if (more_) WLOADK(((t) + 1) * KVBLK, 1 - PAR); if ((t) > 0) WPV(1 - PAR); WBARN(more_, 1); if (more_) WLOADV(((t) + 1) * KVBLK, 1 - PAR); WQKSM(t, PAR); WBARN(more_, 4); } while (0)
        for (int t = 0; t < NT; t += 2) { WSTEP_T(t, 0); WSTEP_T(t + 1, 1); }
        WPV(1); WBAR();
#undef WSTEP_T
    }
    if (hi == 0) li_l[r32] = l_reg; asm volatile("s_waitcnt lgkmcnt(0)" ::: "memory");
    float rli[16];
#pragma unroll
    for (int r = 0; r < 16; ++r) rli[r] = __builtin_amdgcn_rcpf(li_l[crow(r, hi)]);
    E(o, rli, wid, lane, r32, hi);
    __syncthreads();
#undef WBAR
#undef WBARN
#undef WQKSM
#undef WPV
#undef TRRD
#undef WRD
#undef WMM
#undef WW8
#undef WDMA
#undef WLOADK
#undef WLOADV
}
template <class Epi>
__device__ __forceinline__ void block_wide8(const BlockRef& cur, const bf16* V2, int skv, char* lds, Seam& S, const Epi& E) {
    int tid = threadIdx.x; asm volatile("" : "+v"(tid));
    const int wid = __builtin_amdgcn_readfirstlane(tid >> 6), lane = tid & 63, r32 = lane & 31, hi = lane >> 5;
    int j_hi = (cur.P0 + QB - 1) / KVBLK + 1; if (j_hi > skv / KVBLK) j_hi = skv / KVBLK;
    const int NT = j_hi;
    const int qlo = cur.P0 + wid * QBLK, qm = qlo + r32 - 8 * hi;
    char* V_lds = lds; char* K_lds = lds + 4 * SHM_V;
    float* ws = (float*)(lds + WIDE_WS) + wid * 64; float* li_l = ws, * al_l = ws + 32;
    float m_reg = -1e30f, l_reg = 0; f32x16 o[8] = {};
    const int krow = 8 * wid + (lane >> 3), krp = krow & 31, kt = (krp & 3) + 4 * (krp >> 3) + 16 * (krow >> 5), kkey = 16 * (kt & 3) + (kt >> 2) + 8 * ((krp >> 2) & 1);
    const unsigned koff = (unsigned)(kkey * 128 + (((lane & 7) ^ ((krow >> 1) & 7)) << 4));
    const int vc = 16 * wid + (lane >> 2);
    const unsigned voff = (unsigned)(vc * 64 + (((lane & 3) ^ ((vc >> 2) & 3)) << 4));
    const char* Kh = (const char*)cur.K; const char* Va = (const char*)cur.V; const char* Vb = (const char*)V2;
    typedef __attribute__((address_space(3))) unsigned* lds_uptr;
#define WLOADK(t_, par) __builtin_amdgcn_global_load_lds((const unsigned*)(Kh + (size_t)(t_) * (KVBLK * D) + koff), (lds_uptr)(K_lds + (par) * SHM_K + wid * 1024), 16, 0, 0)
#define WLOADV(t_, par) do { __builtin_amdgcn_global_load_lds((const unsigned*)(Va + (size_t)(t_) * 8192 + voff), (lds_uptr)(V_lds + (2 * (par)) * SHM_V + wid * 1024), 16, 0, 0);      \
                             __builtin_amdgcn_global_load_lds((const unsigned*)(Vb + (size_t)(t_) * 8192 + voff), (lds_uptr)(V_lds + (2 * (par) + 1) * SHM_V + wid * 1024), 16, 0, 0); } while (0)
    i32x8 q8[2];
    { const i32x4* qp = (const i32x4*)((const char*)cur.Q + (size_t)(wid * QBLK + r32) * D + hi * 32);
#pragma unroll
      for (int c = 0; c < 2; ++c) { const i32x4 lo_ = qp[4 * c], hi_ = qp[4 * c + 1]; q8[c] = (i32x8){lo_[0], lo_[1], lo_[2], lo_[3], hi_[0], hi_[1], hi_[2], hi_[3]}; } }
    WLOADK(0, 0); WLOADV(0, 0); VMW();
    __syncthreads();
    f32x16 p0, p1; float mn, al; i32x8 pa8;
    typedef const __attribute__((address_space(3))) bf16x8* lds_f;
    const unsigned vsw = (unsigned)((r32 >> 2) & 3), va0 = (unsigned)(__UINTPTR_TYPE__)V_lds + (unsigned)(r32 * 64) + (((unsigned)(2 * hi) ^ vsw) << 4), va1 = (unsigned)(__UINTPTR_TYPE__)V_lds + (unsigned)(r32 * 64) + (((unsigned)(2 * hi + 1) ^ vsw) << 4);
#define VF8(PAR, g) __builtin_bit_cast(i32x8, __builtin_shufflevector(*(lds_f)(__UINTPTR_TYPE__)(va0 + (2 * (PAR) + ((g) >> 2)) * SHM_V + ((g) & 3) * 2048),                       \
                                                                      *(lds_f)(__UINTPTR_TYPE__)(va1 + (2 * (PAR) + ((g) >> 2)) * SHM_V + ((g) & 3) * 2048), 0, 1, 2, 3, 4, 5, 6, 7, 8, 9, 10, 11, 12, 13, 14, 15))
#define MM8(g, f_) asm volatile("v_mfma_f32_32x32x64_f8f6f4 %0, %1, %2, %0" : "+v"(o[g]) : "v"(pa8), "v"(f_))
#define WBAR() do { asm volatile("s_waitcnt vmcnt(0) lgkmcnt(0)" ::: "memory"); __builtin_amdgcn_s_barrier(); asm volatile("" ::: "memory"); } while (0)
#define WBARN(more, n) do { if (more) asm volatile("s_waitcnt vmcnt(" #n ") lgkmcnt(0)" ::: "memory"); else asm volatile("s_waitcnt vmcnt(0) lgkmcnt(0)" ::: "memory");                 \
        __builtin_amdgcn_s_barrier(); asm volatile("" ::: "memory"); } while (0)
#define WQKSM(t, PAR) do { __builtin_amdgcn_s_setprio(1);                                                                                          \
        qkt_f8<PAR, true>(p0, p1, K_lds, r32, hi, q8);                                                                                                   \
        { const int kb_ = (t) * KVBLK; if (kb_ + KVBLK - 1 > qlo) mask_tile_perm(p0, p1, qm - kb_); }                                              \
        partialSM<8, 2, 5>(p0, p1, m_reg, mn, al);                                                                                                 \
        if (__any(al < 1.f)) { if (hi == 0) al_l[r32] = al; asm volatile("s_waitcnt lgkmcnt(0)" ::: "memory");                                     \
            for (int d_ = 0; d_ < 8; ++d_) for (int r = 0; r < 16; ++r) o[d_][r] *= al_l[crow(r, hi)]; }                                            \
        finishSM8(p0, p1, al, l_reg, pa8);                                                                                                         \
        __builtin_amdgcn_s_setprio(0); SBAR(); } while (0)
#define WPV(PAR) do { SBAR(); i32x8 f0_ = VF8(PAR, 0), f1_ = VF8(PAR, 1); SBAR(); MM8(0, f0_); f0_ = VF8(PAR, 2); SBAR(); MM8(1, f1_); f1_ = VF8(PAR, 3); SBAR(); MM8(2, f0_); f0_ = VF8(PAR, 4); SBAR();   \
        MM8(3, f1_); f1_ = VF8(PAR, 5); SBAR(); MM8(4, f0_); f0_ = VF8(PAR, 6); SBAR(); MM8(5, f1_); f1_ = VF8(PAR, 7); SBAR(); MM8(6, f0_); MM8(7, f1_);                                                  \
        asm volatile("s_nop 15\n\ts_nop 15" ::: "memory"); SBAR(); } while (0)
    if (wid < 4) {
#define WSTEP_L(t, PAR) do { const bool more_ = (t) + 1 < NT; if (more_) WLOADK((t) + 1, 1 - PAR); WQKSM(t, PAR); WBARN(more_, 1); if (more_) WLOADV((t) + 1, 1 - PAR); WPV(PAR); WBARN(more_, 2); } while (0)
        for (int t = 0; t < NT; t += 2) { WSTEP_L(t, 0); WSTEP_L(t + 1, 1); }
        WBAR();
#undef WSTEP_L
    } else {
#define WSTEP_T(t, PAR) do { const bool more_ = (t) + 1 < NT; if (more_) WLOADK((t) + 1, 1 - PAR); if ((t) > 0) WPV(1 - PAR); WBARN(more_, 1); if (more_) WLOADV((t) + 1, 1 - PAR); WQKSM(t, PAR); WBARN(more_, 2); } while (0)
        for (int t = 0; t < NT; t += 2) { WSTEP_T(t, 0); WSTEP_T(t + 1, 1); }
        WPV(1); WBAR();
#undef WSTEP_T
    }
    if (hi == 0) li_l[r32] = l_reg; asm volatile("s_waitcnt lgkmcnt(0)" ::: "memory");
    float rli[16];
#pragma unroll
    for (int r = 0; r < 16; ++r) rli[r] = __builtin_amdgcn_rcpf(li_l[crow(r, hi)]) * (1.0f / 16.0f);
    E(o, rli, wid, lane, r32, hi);
    __syncthreads();
#undef WLOADK
#undef WLOADV
#undef VF8
#undef MM8
#undef WBAR
#undef WBARN
#undef WQKSM
#undef WPV
}
#undef ROW
#undef VMW
#undef SLOAD_H
#undef SWRITE_HK
#undef SWRITE_HV
#undef SWRITE_H

template <int X> __device__ __forceinline__ float swz_xor(float v) {
    return __int_as_float(__builtin_amdgcn_ds_swizzle(__float_as_int(v), (X << 10) | 0x1f));
}
__device__ __forceinline__ float half_sum(float s) {
    s += swz_xor<1>(s); s += swz_xor<2>(s); s += swz_xor<4>(s); s += swz_xor<8>(s); s += swz_xor<16>(s); return s;
}
__device__ __forceinline__ void store_pair(bf16* p, float v, int r32) {
    const float vn = swz_xor<1>(v);
    if ((r32 & 1) == 0) *(unsigned*)p = cvtpk(v, vn);
}
__device__ __forceinline__ void store_quad8(unsigned char* p, float v, int r32) {
    v = fminf(fmaxf(v, -448.f), 448.f);
    const float v1 = swz_xor<1>(v);
    const int w = __builtin_amdgcn_cvt_pk_fp8_f32(v, v1, 0, false);
    const int w2 = __builtin_amdgcn_ds_swizzle(w, (2 << 10) | 0x1f);
    if ((r32 & 3) == 0) *(unsigned*)p = ((unsigned)w & 0xffffu) | ((unsigned)w2 << 16);
}
struct EpiSelf {
    int mode, vh;
    unsigned char* out;
    const float* gain;
    float* scr;
    float* ssq;
    float lam;
    __device__ __forceinline__ void operator()(f32x16 (&o)[4], const float (&rli)[16], int wid, int lane, int r32, int hi) const {
        asm volatile("" : "+v"(lane), "+v"(r32), "+v"(hi));
        unsigned char* base = out + (size_t)(wid * QBLK) * 4096;
        if (mode == 0) {
            float rn[16];
#pragma unroll
            for (int r = 0; r < 16; ++r) { float s = 0.f;
#pragma unroll
                for (int d0 = 0; d0 < 4; ++d0) { const float v = o[d0][r] * rli[r]; o[d0][r] = v; s += v * v; }
                s = half_sum(s); rn[r] = rsqrtf(s * (1.0f / 128.0f) + 1e-5f); }
            float g[4];
#pragma unroll
            for (int d0 = 0; d0 < 4; ++d0) g[d0] = gain[d0 * 32 + r32];
#pragma unroll
            for (int r = 0; r < 16; ++r)
#pragma unroll
                for (int d0 = 0; d0 < 4; ++d0) store_quad8(base + (size_t)crow(r, hi) * 4096 + d0 * 32 + r32, o[d0][r] * rn[r] * g[d0], r32);
        } else if (mode == 1) {
            float* p = scr + vh * 4096 + lane;
#pragma unroll
            for (int r = 0; r < 16; ++r)
#pragma unroll
                for (int d0 = 0; d0 < 4; ++d0) p[(r * 4 + d0) * 64] = o[d0][r] * rli[r];
        } else {
            float* p = scr + vh * 4096 + lane;
            float rn[16];
#pragma unroll
            for (int r = 0; r < 16; ++r) { float s = 0.f;
#pragma unroll
                for (int d0 = 0; d0 < 4; ++d0) { const float t = p[(r * 4 + d0) * 64]; const float dd = t - lam * (o[d0][r] * rli[r]); o[d0][r] = dd; s += dd * dd;
                    if (vh == 0) p[(r * 4 + d0) * 64] = dd; }
                s = half_sum(s);
                if (vh == 0) { if (r32 == 0) ssq[crow(r, hi)] = s; rn[r] = 0.f; }
                else rn[r] = rsqrtf((s + ssq[crow(r, hi)]) * (1.0f / 256.0f) + 1e-5f) * 0.8f; }
            if (vh == 1) {
                float g[4];
#pragma unroll
                for (int d0 = 0; d0 < 4; ++d0) g[d0] = gain[128 + d0 * 32 + r32];
#pragma unroll
                for (int r = 0; r < 16; ++r)
#pragma unroll
                    for (int d0 = 0; d0 < 4; ++d0) store_quad8(base + (size_t)crow(r, hi) * 4096 + 128 + d0 * 32 + r32, o[d0][r] * rn[r] * g[d0], r32);
                const float* pa = scr + lane;
#pragma unroll
                for (int d0 = 0; d0 < 4; ++d0) g[d0] = gain[d0 * 32 + r32];
#pragma unroll
                for (int r = 0; r < 16; ++r)
#pragma unroll
                    for (int d0 = 0; d0 < 4; ++d0) store_quad8(base + (size_t)crow(r, hi) * 4096 + d0 * 32 + r32, pa[(r * 4 + d0) * 64] * rn[r] * g[d0], r32);
            }
        }
    }
};
__device__ __forceinline__ float mul_ns(float a, float b) { float r; asm("v_mul_f32 %0, %1, %2" : "=v"(r) : "v"(a), "v"(b)); return r; }
__device__ __forceinline__ float fma_ns(float a, float b, float c) { float r; asm("v_fma_f32 %0, %1, %2, %3" : "=v"(r) : "v"(a), "v"(b), "v"(c)); return r; }
struct EpiWide {
    int mode;
    unsigned char* out;
    const float* gain;
    float* scr;
    float lam;
    __device__ __forceinline__ void operator()(f32x16 (&o)[8], const float (&rli)[16], int wid, int lane, int r32, int hi) const {
        asm volatile("" : "+v"(lane), "+v"(r32), "+v"(hi));
        const unsigned ul = (unsigned)lane;
        unsigned* const scw = (unsigned*)scr;
        if (mode == 1) {
#pragma unroll
            for (int r = 0; r < 16; ++r)
#pragma unroll
                for (int k = 0; k < 4; ++k) (scw + (r * 4 + k) * 64)[ul] = cvtpk(mul_ns(o[2 * k][r], rli[r]), mul_ns(o[2 * k + 1][r], rli[r]));
        } else {
            unsigned char* base = out + (size_t)(wid * QBLK) * 4096; const unsigned uo = (unsigned)(hi * 4 * 4096 + r32);
            const float nlam = -lam;
            float rn[16];
#pragma unroll
            for (int rb = 0; rb < 16; rb += 4) { unsigned tw[4][4];
#pragma unroll
                for (int q = 0; q < 4; ++q)
#pragma unroll
                    for (int k = 0; k < 4; ++k) tw[q][k] = (scw + ((rb + q) * 4 + k) * 64)[ul];
                asm volatile("" ::: "memory"); SBAR();
#pragma unroll
                for (int q = 0; q < 4; ++q) { const int r = rb + q; float s = 0.f;
#pragma unroll
                    for (int d0 = 0; d0 < 8; ++d0) { const float t = __uint_as_float((d0 & 1) ? (tw[q][d0 >> 1] & 0xffff0000u) : (tw[q][d0 >> 1] << 16));
                        const float dd = fma_ns(nlam, mul_ns(o[d0][r], rli[r]), t); s = fma_ns(dd, dd, s); }
                    s = half_sum(s); rn[r] = rsqrtf(s * (1.0f / 256.0f) + 1e-5f) * 0.8f; }
                asm volatile("" ::: "memory"); SBAR(); }
            float g[8];
#pragma unroll
            for (int d0 = 0; d0 < 8; ++d0) g[d0] = gain[d0 * 32 + r32];
#pragma unroll
            for (int rb = 0; rb < 16; rb += 4) { unsigned tw[4][4];
#pragma unroll
                for (int q = 0; q < 4; ++q)
#pragma unroll
                    for (int k = 0; k < 4; ++k) tw[q][k] = (scw + ((rb + q) * 4 + k) * 64)[ul];
                asm volatile("" ::: "memory"); SBAR();
#pragma unroll
                for (int q = 0; q < 4; ++q) { const int r = rb + q;
#pragma unroll
                    for (int d0 = 0; d0 < 8; ++d0) { const float t = __uint_as_float((d0 & 1) ? (tw[q][d0 >> 1] & 0xffff0000u) : (tw[q][d0 >> 1] << 16));
                        const float dd = fma_ns(nlam, mul_ns(o[d0][r], rli[r]), t);
                        store_quad8(base + (crow(r, 0) * 4096 + d0 * 32) + uo, mul_ns(mul_ns(dd, rn[r]), g[d0]), r32); } }
                asm volatile("" ::: "memory"); SBAR(); }
        }
    }
};
struct EpiNull {
    float* scr;
    __device__ __forceinline__ void operator()(f32x16 (&o)[8], const float (&rli)[16], int wid, int lane, int r32, int hi) const {
        float a = 0.f;
#pragma unroll
        for (int d0 = 0; d0 < 8; ++d0)
#pragma unroll
            for (int r = 0; r < 16; ++r) a += o[d0][r] * rli[r];
        if (a == 123.456f) scr[lane] = a;
    }
};
struct EpiMem {
    unsigned char* out;
    __device__ __forceinline__ void operator()(f32x16 (&o)[4], const float (&rli)[16], int wid, int lane, int r32, int hi) const {
        asm volatile("" : "+v"(lane), "+v"(r32), "+v"(hi));
        unsigned char* base = out + (size_t)(wid * QBLK) * 512;
#pragma unroll
        for (int r = 0; r < 16; ++r)
#pragma unroll
            for (int d0 = 0; d0 < 4; ++d0) store_quad8(base + (size_t)crow(r, hi) * 512 + d0 * 32 + r32, o[d0][r] * rli[r] * 16.f, r32);
    }
};
__device__ __forceinline__ unsigned moba_select(const Seam& S, const char* lds, int qb, int r32, int hi) {
    asm volatile("" : "+v"(r32), "+v"(hi));
    f32x16 g = f32x16{};
#pragma unroll
    for (int d0 = 0; d0 < 8; ++d0) { const __attribute__((address_space(3))) float* kp = (const __attribute__((address_space(3))) float*)(lds + KM_LDS) + (r32 & 15) * KM_PITCH + d0 * 16 + hi * 8;
        const bf16x8 kf = pack8(*(const __attribute__((address_space(3))) f32x4*)kp, *(const __attribute__((address_space(3))) f32x4*)(kp + 4));
        g = __builtin_amdgcn_mfma_f32_32x32x16_bf16(kf, S.qr[d0], g, 0, 0, 0); }
    const float NEG = -__builtin_inff();
    float gate[16];
#pragma unroll
    for (int r = 0; r < 8; ++r) { const float own = g[r]; const auto sw = __builtin_amdgcn_permlane32_swap(__float_as_uint(own), __float_as_uint(own), false, false);
        const float oth = __uint_as_float(hi ? sw[0] : sw[1]);
        const int blk = (r & 3) + 8 * (r >> 2);
        gate[blk] = hi ? oth : own; gate[blk + 4] = hi ? own : oth; }
#pragma unroll
    for (int blk = 0; blk < 16; ++blk) gate[blk] = (blk < qb) ? gate[blk] : NEG;
    unsigned sel = 0u;
#pragma unroll
    for (int k = 0; k < 3; ++k) { float best = NEG; int bi = 16;
#pragma unroll
        for (int blk = 0; blk < 16; ++blk) if (gate[blk] > best) { best = gate[blk]; bi = blk; }
        sel |= (bi < 16) ? (1u << bi) : 0u;
#pragma unroll
        for (int blk = 0; blk < 16; ++blk) gate[blk] = (blk == bi) ? NEG : gate[blk]; }
    return sel;
}
__device__ __forceinline__ void q8_from_qr(Seam& S) {
#pragma unroll
    for (int c = 0; c < 2; ++c)
#pragma unroll
        for (int dd = 0; dd < 4; ++dd) { const bf16x8 v = S.qr[4 * c + dd]; float f[8];
#pragma unroll
            for (int j = 0; j < 8; ++j) f[j] = __builtin_amdgcn_fmed3f(__uint_as_float(((unsigned)(unsigned short)v[j]) << 16) * 16.f, -448.f, 448.f);
            int w0 = 0, w1 = 0;
            w0 = __builtin_amdgcn_cvt_pk_fp8_f32(f[0], f[1], w0, false); w0 = __builtin_amdgcn_cvt_pk_fp8_f32(f[2], f[3], w0, true);
            w1 = __builtin_amdgcn_cvt_pk_fp8_f32(f[4], f[5], w1, false); w1 = __builtin_amdgcn_cvt_pk_fp8_f32(f[6], f[7], w1, true);
            S.q8[c][2 * dd] = w0; S.q8[c][2 * dd + 1] = w1; }
}
}

#ifndef MK_N_LAUNCHES
#define MK_N_LAUNCHES 1
#endif
constexpr int NWAVES = 8;
constexpr int NPHASE = 11;
constexpr int N_LAUNCHES = MK_N_LAUNCHES;
constexpr int BATCH = 4, SEQ = 4096, DMODEL = 4096, MTOK = BATCH * SEQ, NPROJ = 12288, MEMLEN = 256, MEMW = 512, DFF = 16384;
constexpr size_t MiB = 1u << 20;
constexpr size_t WS_CTL = 0, CTL_ZERO_BYTES = 1 * MiB;
constexpr size_t WS_ROPE = 1 * MiB;
constexpr size_t WS_SS0 = WS_ROPE + 512 * 1024;
constexpr size_t WS_KMEAN = WS_SS0 + 128 * 1024;
constexpr size_t WS_WUP = 4 * MiB, WS_WDOWN = 136 * MiB;
constexpr size_t WS_XB8 = 68 * MiB;
constexpr size_t WS_XB = 260 * MiB;
constexpr size_t WS_WOUT = 396 * MiB, WS_WCQKV = 428 * MiB, WS_WCO = 440 * MiB;
constexpr size_t WS_QKV = 444 * MiB;
constexpr size_t WS_MERGED = 828 * MiB, WS_WIN = 828 * MiB;
constexpr size_t WS_QC = 444 * MiB, WS_KC = 460 * MiB, WS_VC = 461 * MiB, WS_OC = 462 * MiB;
constexpr size_t WS_SCR = 892 * MiB;
constexpr size_t WS_U = 444 * MiB;
constexpr size_t WS_END = 956 * MiB;
constexpr int CW_TMO = 0, CW_CODE = 1, CW_QUEUE = 64, CW_BAR = 4096, CW_SS1 = 8192, CW_SS2 = CW_SS1 + 16384, CW_SS3 = CW_SS2 + 16384, CW_KMF = 81920;
static_assert(CW_SS3 + 2 * 16384 <= CW_KMF && (CW_KMF + 131072) * 4 <= (int)CTL_ZERO_BYTES, "CTL words inside the memset region");
constexpr int RING_OFF = 0, RING_BYTES = 131072;
constexpr int LDSCTL_OFF = 135168, MISC_OFF = LDSCTL_OFF + 320;
constexpr int LDS_BYTES = 147456;
static_assert(att::LDS_BYTES <= RING_BYTES && att::WIDE_BYTES <= RING_BYTES, "attention LDS");

#define GAS __attribute__((address_space(1)))
#define LAS __attribute__((address_space(3)))
typedef unsigned short bf16;
typedef unsigned v4u __attribute__((ext_vector_type(4)));
typedef unsigned v2u __attribute__((ext_vector_type(2)));
typedef float f32x4 __attribute__((ext_vector_type(4)));
typedef GAS unsigned gu32;
#define RLX_AGENT __ATOMIC_RELAXED, __HIP_MEMORY_SCOPE_AGENT
#define LDS_WAIT() asm volatile("s_waitcnt lgkmcnt(0)" ::: "memory")
#define VM_WAIT() asm volatile("s_waitcnt vmcnt(0)" ::: "memory")
__device__ __forceinline__ unsigned f2bf(float f) { unsigned u = __builtin_bit_cast(unsigned, f); return (u + 0x7fffu + ((u >> 16) & 1u)) >> 16; }
__device__ __forceinline__ unsigned pk2(float lo, float hi) { return f2bf(lo) | (f2bf(hi) << 16); }

#define XB_TMO      128
#define XB_XCNT(j)  (256  + 64 * (j))
#define XB_XSUB(j)  (1280 + 64 * (j))
#define XB_XGEN(j)  (2304 + 64 * (j))
#define XB_TOP      3328
#define XB_TOPGEN   3392
#define XCD_BAR_WORDS 3456
#define XB_SPIN_CAP (1u << 18)

__device__ __forceinline__ unsigned xb_ld(unsigned* p)              { return __hip_atomic_load(p, __ATOMIC_RELAXED, __HIP_MEMORY_SCOPE_AGENT); }
__device__ __forceinline__ unsigned xb_add(unsigned* p, unsigned v) { return __hip_atomic_fetch_add(p, v, __ATOMIC_RELAXED, __HIP_MEMORY_SCOPE_AGENT); }
__device__ __forceinline__ unsigned xb_xcc_id() { return (unsigned)__builtin_amdgcn_s_getreg((3 << 11) | 20) & 0xFu; }
#define XB_SPIN(cond, bar) do { unsigned _sp = 0; while (cond) { __builtin_amdgcn_s_sleep(1); \
    if ((++_sp & 255u) == 0u) { if (xb_ld(&(bar)[XB_TMO])) break; if (_sp > XB_SPIN_CAP) { atomicAdd(&(bar)[XB_TMO], 1u); break; } } } } while (0)

struct XcdBarrier {
    unsigned* bar; unsigned x;
    volatile LAS unsigned* st;
};

__device__ __forceinline__ XcdBarrier xcd_barrier_post(unsigned* bar, volatile LAS unsigned* st) {
    XcdBarrier b; b.bar = bar; b.x = xb_xcc_id(); b.st = st;
    if (threadIdx.x == 0) (void)xb_add(&bar[XB_XCNT(b.x)], 1u);
    return b;
}
__device__ __forceinline__ void xcd_barrier_complete(unsigned* bar, unsigned x, unsigned& nloc, unsigned& nx) {
    const unsigned G = gridDim.x * gridDim.y * gridDim.z;
    unsigned sum, cnt, mine, sp = 0u;
    for (;;) {
        sum = 0u; cnt = 0u; mine = 0u;
#pragma unroll
        for (unsigned j = 0; j < 16; ++j) { const unsigned c = xb_ld(&bar[XB_XCNT(j)]); sum += c; cnt += (c > 0u) ? 1u : 0u; mine = (j == x) ? c : mine; }
        if (sum == G) break;
        __builtin_amdgcn_s_sleep(1);
        if ((++sp & 255u) == 0u) { if (xb_ld(&bar[XB_TMO])) break; if (sp > XB_SPIN_CAP) { atomicAdd(&bar[XB_TMO], 1u); break; } }
    }
    nloc = mine > 0u ? mine : 1u; nx = cnt > 0u ? cnt : 1u;
}

__device__ __forceinline__ void xcd_barrier(const XcdBarrier& b) {
    asm volatile("s_waitcnt vmcnt(0)" ::: "memory");
    __syncthreads();
    if (threadIdx.x == 0) {
        unsigned* bar = b.bar;
        __builtin_amdgcn_s_waitcnt(0);
        unsigned nloc = b.st[0], nx = b.st[1];
        if (nloc == 0u) { xcd_barrier_complete(bar, b.x, nloc, nx); b.st[0] = nloc; b.st[1] = nx; }
        const unsigned old = xb_add(&bar[XB_XSUB(b.x)], 1u);
        const unsigned gen = old / nloc;
        if (old + 1u == (gen + 1u) * nloc) {
            __builtin_amdgcn_fence(__ATOMIC_RELEASE, "agent");
            asm volatile("s_waitcnt vmcnt(0)" ::: "memory");
            const unsigned og = xb_add(&bar[XB_TOP], 1u);
            const unsigned tg = og / nx;
            if (og + 1u == (tg + 1u) * nx) xb_add(&bar[XB_TOPGEN], 1u);
            else XB_SPIN(xb_ld(&bar[XB_TOPGEN]) == tg, bar);
            __builtin_amdgcn_fence(__ATOMIC_ACQUIRE, "agent");
            xb_add(&bar[XB_XGEN(b.x)], 1u);
            asm volatile("s_waitcnt vmcnt(0)" ::: "memory");
        } else {
            XB_SPIN(xb_ld(&bar[XB_XGEN(b.x)]) == gen, bar);
            __builtin_amdgcn_fence(__ATOMIC_ACQUIRE, "agent");
            asm volatile("s_waitcnt vmcnt(0)" ::: "memory");
        }
    }
    __syncthreads();
}


__device__ __forceinline__ float wave_sum(float v) {
#pragma unroll
    for (int o = 1; o < 64; o <<= 1) v += __shfl_xor(v, o);
    return v;
}
__device__ __forceinline__ void p0_transpose_item(const float* W, int K, int N, const float* gk, bf16* WT, int row_off, LAS float* scr, int item, int lane, int ldw = 0) {
    const int nblk = N / 64, kb = item / nblk, nb = item - kb * nblk, k0 = 64 * kb, n0 = 64 * nb; if (ldw == 0) ldw = N;
    const int c4 = lane & 15, kq = lane >> 4;
#pragma unroll 4
    for (int i = 0; i < 16; ++i) { const int kk = 4 * i + kq;
        f32x4 v = __builtin_nontemporal_load((const GAS f32x4*)(W + (size_t)(k0 + kk) * ldw + n0 + 4 * c4));
        if (gk) v = v * gk[k0 + kk];
        LAS float* d = scr + kk * 65 + 4 * c4; d[0] = v[0]; d[1] = v[1]; d[2] = v[2]; d[3] = v[3]; }
    LDS_WAIT(); asm volatile("" ::: "memory");
    const int c = lane & 7;
#pragma unroll
    for (int j = 0; j < 8; ++j) { const int n = (lane >> 3) + 8 * j; const LAS float* s = scr + (8 * c) * 65 + n;
        v4u o; o.x = pk2(s[0 * 65], s[1 * 65]); o.y = pk2(s[2 * 65], s[3 * 65]); o.z = pk2(s[4 * 65], s[5 * 65]); o.w = pk2(s[6 * 65], s[7 * 65]);
        *(GAS v4u*)(WT + (size_t)(row_off + n0 + n) * K + k0 + 8 * c) = o; }
    LDS_WAIT(); asm volatile("" ::: "memory");
}
__device__ __forceinline__ void p0_transpose_item_f8(const float* W, int K, int N, const float* gk, float scale, unsigned char* WT, LAS float* scr, int item, int lane, int ldw = 0) {
    const int nblk = N / 64, kb = item / nblk, nb = item - kb * nblk, k0 = 64 * kb, n0 = 64 * nb; if (ldw == 0) ldw = N;
    const int c4 = lane & 15, kq = lane >> 4;
#pragma unroll 4
    for (int i = 0; i < 16; ++i) { const int kk = 4 * i + kq;
        f32x4 v = __builtin_nontemporal_load((const GAS f32x4*)(W + (size_t)(k0 + kk) * ldw + n0 + 4 * c4));
        v = v * (gk ? gk[k0 + kk] * scale : scale);
        LAS float* d = scr + kk * 65 + 4 * c4; d[0] = v[0]; d[1] = v[1]; d[2] = v[2]; d[3] = v[3]; }
    LDS_WAIT(); asm volatile("" ::: "memory");
    const int c = lane & 3;
#pragma unroll
    for (int j = 0; j < 4; ++j) { const int n = (lane >> 2) + 16 * j; const LAS float* s = scr + (16 * c) * 65 + n;
        v4u o; o.x = pg8::pk4_fp8(s[0 * 65], s[1 * 65], s[2 * 65], s[3 * 65]); o.y = pg8::pk4_fp8(s[4 * 65], s[5 * 65], s[6 * 65], s[7 * 65]);
        o.z = pg8::pk4_fp8(s[8 * 65], s[9 * 65], s[10 * 65], s[11 * 65]); o.w = pg8::pk4_fp8(s[12 * 65], s[13 * 65], s[14 * 65], s[15 * 65]);
        *(GAS v4u*)(WT + ((size_t)((n0 + n) >> 4) * (K >> 5) + ((k0 + 16 * c) >> 5)) * 512 + ((n0 + n) & 15) * 32 + ((16 * c) & 31)) = o; }
    LDS_WAIT(); asm volatile("" ::: "memory");
}
__device__ __forceinline__ void cos_sin_d(float angf, float& co, float& si) {
    const double a = (double)angf;
    const double kd = __builtin_rint(a * 0.6366197723675814);
    const double r = __builtin_fma(-kd, 1.5707963267948966, a) - kd * 6.123233995736766e-17;
    const double r2 = r * r;
    const double sp = r * (1.0 + r2 * (-1.0 / 6 + r2 * (1.0 / 120 + r2 * (-1.0 / 5040 + r2 * (1.0 / 362880 + r2 * (-1.0 / 39916800 + r2 * (1.0 / 6227020800.0)))))));
    const double cp = 1.0 + r2 * (-0.5 + r2 * (1.0 / 24 + r2 * (-1.0 / 720 + r2 * (1.0 / 40320 + r2 * (-1.0 / 3628800 + r2 * (1.0 / 479001600 + r2 * (-1.0 / 87178291200.0)))))));
    const int q = (int)((long long)kd & 3);
    const double c = (q == 0) ? cp : (q == 1) ? -sp : (q == 2) ? -cp : sp;
    const double s = (q == 0) ? sp : (q == 1) ? cp : (q == 2) ? -sp : -cp;
    co = (float)c; si = (float)s;
}

struct Args { const float* in[20]; float* out; unsigned char* ws; int ph_lo, ph_hi; };
__global__ void __launch_bounds__(NWAVES * 64, 2) mk_fwd(Args args) {
    extern __shared__ __attribute__((aligned(16))) unsigned char lds[];
    LAS unsigned char* const ldsl = (LAS unsigned char*)lds;
    volatile LAS unsigned* const MISC = (volatile LAS unsigned*)(ldsl + MISC_OFF);
    const int tid = threadIdx.x, lane = tid & 63, wave = __builtin_amdgcn_readfirstlane(tid >> 6);
    const int G = gridDim.x; const int bx = blockIdx.x;
    const int vcu = (G % 8 == 0) ? (bx % 8) * (G / 8) + bx / 8 : bx;
    unsigned char* const ws = args.ws;
    gu32* const ctl = (gu32*)(ws + WS_CTL);
    const float* x = args.in[0]; const float* mem = args.in[1]; const float* ln_mix_g = args.in[2]; const float* w_in = args.in[3]; const float* moba_out_g = args.in[4];
    const float* lq1 = args.in[5]; const float* lk1 = args.in[6]; const float* lq2 = args.in[7]; const float* lk2 = args.in[8]; const float* subln_g = args.in[9];
    const float* w_out = args.in[10]; const float* ln_cross_g = args.in[11]; const float* ln_mem_g = args.in[12]; const float* w_cq = args.in[13]; const float* w_ckv = args.in[14];
    const float* w_co = args.in[15]; const float* ln_mlp_g = args.in[16]; const float* w_up = args.in[17]; const float* w_down = args.in[18]; const float* final_g = args.in[19];
    float* const out = args.out;
    bf16* const W_INA_T = (bf16*)(ws + WS_WIN); unsigned char* const W_IN8 = ws + WS_WIN + 32 * MiB; unsigned char* const X8 = ws + WS_XB8; unsigned char* const W_OUT8 = ws + WS_WOUT; unsigned char* const W_CQKV8 = ws + WS_WCQKV; bf16* const W_CO_T = (bf16*)(ws + WS_WCO);
    unsigned char* const W_UP8 = ws + WS_WUP; unsigned char* const W_DN8 = ws + WS_WDOWN; unsigned char* const XB8 = ws + WS_XB8; unsigned char* const U8 = ws + WS_U;
    bf16* const XB = (bf16*)(ws + WS_XB); bf16* const QKV = (bf16*)(ws + WS_QKV); unsigned char* const MERGED8 = ws + WS_MERGED;
    bf16* const QC = (bf16*)(ws + WS_QC); bf16* const KC = (bf16*)(ws + WS_KC); bf16* const VC = (bf16*)(ws + WS_VC); bf16* const OC = (bf16*)(ws + WS_OC);
    float* const KMF = (float*)(ws + WS_CTL) + CW_KMF;
    float* const ROPE = (float*)(ws + WS_ROPE); float* const SS0 = (float*)(ws + WS_SS0);
    float* const SS1 = (float*)(ws + WS_CTL) + CW_SS1; float* const SS2 = (float*)(ws + WS_CTL) + CW_SS2; float* const SS3 = (float*)(ws + WS_CTL) + CW_SS3;
    float* const SCR = (float*)(ws + WS_SCR);

    for (int u = tid; u < (LDS_BYTES - LDSCTL_OFF) / 4; u += NWAVES * 64) ((LAS unsigned*)(ldsl + LDSCTL_OFF))[u] = 0u;
    __syncthreads();
    const int lo = args.ph_lo, hi_ph = args.ph_hi;
    XcdBarrier bar; bar.bar = (unsigned*)(ctl + CW_BAR); bar.x = 0; bar.st = nullptr;
    if (hi_ph - lo > 1) bar = xcd_barrier_post((unsigned*)(ctl + CW_BAR), MISC + 8);
#ifndef REPEAT_MASK
#define REPEAT_MASK 0
#endif
#define NREP(k) (1 + ((REPEAT_MASK >> (k)) & 1))
#ifndef PHASE_MASK
#define PHASE_MASK 0x7ff
#endif
#define IN(k) (((PHASE_MASK >> (k)) & 1) && lo <= (k) && (k) < hi_ph)
#define BOTH(k) (IN(k) && IN((k) + 1))
#define GRID_BAR(k) do { if (BOTH(k)) xcd_barrier(bar); } while (0)
    const int gw = vcu * NWAVES + wave, NGW = G * NWAVES;
    constexpr int I_INA = 64 * 64, I_INB = 64 * 128, I_OUT = 64 * 64, I_CQ = 64 * 8, I_CKV = 64 * 16, I_CO = 8 * 64, I_UP = 64 * 256, I_DN = 256 * 64;
    constexpr int ND = I_OUT + I_CQ + I_CKV + I_CO + I_UP + I_DN;

    if (IN(0)) for (int rep = 0; rep < NREP(0); ++rep) {
        LAS float* scr = (LAS float*)(ldsl + RING_OFF + wave * 16640);
        constexpr int NITEMS = I_INA + I_INB;
        for (int it = gw; it < NITEMS; it += NGW) {
            int r = it;
            if (r < I_INA) { p0_transpose_item(w_in, DMODEL, 4096, ln_mix_g, W_INA_T, 0, scr, r, lane, NPROJ); continue; } r -= I_INA;
            p0_transpose_item_f8(w_in + 4096, DMODEL, 8192, ln_mix_g, 64.f, W_IN8, scr, r, lane, NPROJ);
        }
        for (int m = gw; m < MTOK; m += NGW) {
            const GAS f32x4* xr = (const GAS f32x4*)(x + (size_t)m * DMODEL) + lane;
            f32x4 v[16]; float s = 0.f;
#pragma unroll
            for (int j = 0; j < 16; ++j) { v[j] = __builtin_nontemporal_load(xr + 64 * j); s += (v[j].x * v[j].x + v[j].y * v[j].y) + (v[j].z * v[j].z + v[j].w * v[j].w); }
            s = wave_sum(s);
            if (lane == 0) SS0[m] = s;
            GAS v2u* o8 = (GAS v2u*)(XB + (size_t)m * DMODEL) + lane; GAS unsigned* o4 = (GAS unsigned*)(X8 + (size_t)m * DMODEL) + lane;
#pragma unroll
            for (int j = 0; j < 16; ++j) { v2u w; w.x = pk2(v[j].x, v[j].y); w.y = pk2(v[j].z, v[j].w); o8[64 * j] = w; o4[64 * j] = pg8::pk4_fp8(v[j].x, v[j].y, v[j].z, v[j].w); }
        }
        for (int m = gw; m < BATCH * MEMLEN; m += NGW) {
            const GAS f32x4* xr = (const GAS f32x4*)(mem + (size_t)m * DMODEL) + lane;
            const GAS f32x4* gr = (const GAS f32x4*)ln_mem_g + lane;
            f32x4 v[16]; float s = 0.f;
#pragma unroll
            for (int j = 0; j < 16; ++j) { v[j] = xr[64 * j]; s += (v[j].x * v[j].x + v[j].y * v[j].y) + (v[j].z * v[j].z + v[j].w * v[j].w); }
            const float rs = rsqrtf(wave_sum(s) * (1.0f / DMODEL) + 1e-5f);
            GAS unsigned* o4 = (GAS unsigned*)(XB8 + (size_t)(MTOK + m) * DMODEL) + lane;
#pragma unroll
            for (int j = 0; j < 16; ++j) { const f32x4 g = gr[64 * j]; o4[64 * j] = pg8::pk4_fp8(v[j].x * rs * g.x, v[j].y * rs * g.y, v[j].z * rs * g.z, v[j].w * rs * g.w); }
        }
        for (int e = gw * 64 + lane; e < SEQ * 16; e += NGW * 64) {
            const int pos = e >> 4, i = e & 15;
            const double invd = (i == 0) ? 1.0 : (i == 1) ? 0.44036660267178046 : (i == 2) ? 0.19392274474868576 : (i == 3) ? 0.08539710028576561 : (i == 4) ? 0.03760603093086393
                : (i == 5) ? 0.016560440080994446 : (i == 6) ? 0.007292664737217109 : (i == 7) ? 0.003211445994752591 : (i == 8) ? 0.001414213562373095 : (i == 9) ? 0.000622772421914596
                : (i == 10) ? 0.0002742481756762073 : (i == 11) ? 0.00012076973741146504 : (i == 12) ? 5.318295896944988e-05 : (i == 13) ? 2.341999896140934e-05
                : (i == 14) ? 1.031338537721246e-05 : 4.5416704806078695e-06;
            const float ang = (float)pos * (float)invd;
            float co, si; cos_sin_d(ang, co, si);
            ROPE[pos * 32 + i] = co; ROPE[pos * 32 + 16 + i] = si;
        }
        if (rep == NREP(0) - 1) GRID_BAR(0);
    }

    if (IN(1)) {
        { pg8::Gemm g{XB, W_INA_T, MTOK, 4096, DMODEL}; pg8::StaticOrder S; S.init(MTOK, 4096, G, bx);
          pg8::EpiProj E{QKV, SS0, ROPE, 0, 1.f, KMF};
          pg8::gemm_phase<pg8::EpiProj, pg8::StaticOrder, true, true>(ldsl + RING_OFF, g, S, E);
          if (NREP(1) == 2) pg8::gemm_phase<pg8::EpiProj, pg8::StaticOrder, true, true>(ldsl + RING_OFF, g, S, E); }
        { pg8::Gemm g{(const bf16*)X8, (const bf16*)(W_IN8 + (size_t)2048 * DMODEL), MTOK, 4096, DMODEL  }; pg8::StaticOrder S; S.init(MTOK, 4096, G, bx);
          pg8::EpiProj E{QKV, SS0, ROPE, 3, 1.0f / 64.0f, KMF};
          pg8::gemm_phase_f8<pg8::EpiProj, pg8::StaticOrder, true, true, false, true>(ldsl + RING_OFF, g, S, E);
          if (NREP(1) == 2) pg8::gemm_phase_f8<pg8::EpiProj, pg8::StaticOrder, true, true, false, true>(ldsl + RING_OFF, g, S, E); }
#pragma unroll
        for (int vg = 0; vg < 2; ++vg) {
          pg8::Gemm g{(const bf16*)X8, (const bf16*)(W_IN8 + (size_t)(vg ? 6144 : 0) * DMODEL), MTOK, 2048, DMODEL}; pg8::StaticOrder S; S.init(MTOK, 2048, G, bx);
          pg8::EpiVT E{(unsigned char*)(QKV + (size_t)(vg ? 5 : 2) * 64 * 4096 * 128), SS0, 1.0f / 64.0f};
          pg8::gemm_phase_f8<pg8::EpiVT, pg8::StaticOrder, true, true, false, true>(ldsl + RING_OFF, g, S, E);
          if (NREP(1) == 2) pg8::gemm_phase_f8<pg8::EpiVT, pg8::StaticOrder, true, true, false, true>(ldsl + RING_OFF, g, S, E); }
        GRID_BAR(1);
    }


    if (IN(3)) {
        float lam;
        { const float s1 = wave_sum(lq1[lane] * lk1[lane] + lq1[lane + 64] * lk1[lane + 64]), s2 = wave_sum(lq2[lane] * lk2[lane] + lq2[lane + 64] * lk2[lane + 64]);
          lam = __expf(s1) - __expf(s2) + 0.2f; lam = __uint_as_float(__builtin_amdgcn_readfirstlane(__float_as_uint(lam))); }
        att::Seam S;
        float* const scrw = SCR + ((size_t)bx * NWAVES + wave) * 8192;
        float* const ssqw = (float*)((char*)lds + RING_OFF + att::LDS_SSQ) + wave * 32;
        constexpr size_t GRP = (size_t)64 * 4096 * 128;
        for (int rep = 0; rep < NREP(3); ++rep) {
#define P3_DEFERRED(it_) do { int r_ = (it_); int lane = (int)(threadIdx.x & 63u); asm volatile("" : "+v"(lane));     \
            LAS float* scr_ = (LAS float*)(ldsl + RING_OFF + wave * 16640);                                             \
            if (r_ < I_OUT) { p0_transpose_item_f8(w_out, DMODEL, DMODEL, nullptr, 64.f, W_OUT8, scr_, r_, lane); break; } r_ -= I_OUT;                          \
            if (r_ < I_CQ) { p0_transpose_item_f8(w_cq, DMODEL, MEMW, ln_cross_g, 64.f, W_CQKV8, scr_, r_, lane); break; } r_ -= I_CQ;                          \
            if (r_ < I_CKV) { p0_transpose_item_f8(w_ckv, DMODEL, 2 * MEMW, nullptr, 64.f, W_CQKV8 + (size_t)MEMW * DMODEL, scr_, r_, lane); break; } r_ -= I_CKV; \
            if (r_ < I_CO) { p0_transpose_item_f8(w_co, MEMW, DMODEL, nullptr, 64.f, (unsigned char*)W_CO_T, scr_, r_, lane); break; } r_ -= I_CO;                                    \
            if (r_ < I_UP) { p0_transpose_item_f8(w_up, DMODEL, DFF, ln_mlp_g, 64.f, W_UP8, scr_, r_, lane); break; } r_ -= I_UP;                              \
            p0_transpose_item_f8(w_down, DFF, DMODEL, nullptr, 128.f, W_DN8, scr_, r_, lane); } while (0)
        int cd = (rep == 0) ? 0 : 100000;
        constexpr int ND_Q = 512, NM_Q = 1024;
        int t = 0, pass = 0, npass = 0;
        for (;;) {
            if (pass == npass) {
                for (int k = 0; k < 4 && cd * NGW < ND; ++k, ++cd) { const int it = cd * NGW + gw; if (it < ND) P3_DEFERRED(it); }
                if (tid == 0) MISC[16] = __hip_atomic_fetch_add(ctl + CW_QUEUE + 64 * rep, 1u, RLX_AGENT);
                __syncthreads();
                t = __builtin_amdgcn_readfirstlane((int)MISC[16]);
#ifdef P3_REP_KIND
                if (rep == 1) { if (P3_REP_KIND == 1 && t >= ND_Q) break; if (P3_REP_KIND == 2) t += ND_Q; }
#endif
                if (t >= ND_Q + NM_Q) break;
                pass = 0; npass = (t < ND_Q) ? 2 : 1;
            }
            att::BlockRef r;
            if (t < ND_Q) {
                const int lvl = t >> 5, idx = t & 31, b = idx >> 3, h = idx & 7, s = pass, qb = 15 - lvl;
                r.Q = (const bf16*)((const unsigned char*)(QKV + 3 * GRP) + ((size_t)(b * 16 + 2 * h + s) * 4096 + qb * 256) * 128);
                r.K = (const bf16*)((const unsigned char*)(QKV + 4 * GRP) + (size_t)(b * 16 + 2 * h + s) * 4096 * 128);
                r.V = (const bf16*)((const unsigned char*)(QKV + 5 * GRP) + (size_t)(b * 16 + 2 * h) * 4096 * 128); r.P0 = qb * 256;
                att::EpiWide E; E.mode = s ? 2 : 1; E.out = MERGED8 + (size_t)(b * 4096 + qb * 256) * 4096 + 2048 + h * 256; E.gain = subln_g; E.scr = scrw; E.lam = lam;
#ifdef P3_WIDE_VAR
                if (rep == 1) { att::EpiNull EN; EN.scr = scrw; att::block_wide<att::EpiNull, P3_WIDE_VAR>(r, r.V + (size_t)4096 * 128, SEQ, (char*)lds + RING_OFF, S, EN); } else
#endif
                att::block_wide8<att::EpiWide>(r, (const bf16*)((const unsigned char*)r.V + (size_t)4096 * 128), SEQ, (char*)lds + RING_OFF, S, E);
            } else {
                const int u = t - ND_Q, lvl = u >> 6, idx = u & 63, b = idx >> 4, h = idx & 15, qb = 15 - lvl;
                r.Q = QKV + ((size_t)(b * 16 + h) * 4096 + qb * 256) * 128; r.K = (const bf16*)((const unsigned char*)(QKV + 1 * GRP) + (size_t)(b * 16 + h) * 4096 * 128);
                r.V = (const bf16*)((const unsigned char*)(QKV + 2 * GRP) + (size_t)(b * 16 + h) * 4096 * 128); r.P0 = qb * 256;
                att::EpiSelf E; E.mode = 0; E.vh = 0; E.out = MERGED8 + (size_t)(b * 4096 + qb * 256) * 4096 + h * 128; E.gain = moba_out_g + h * 128; E.scr = scrw; E.ssq = ssqw; E.lam = lam;
                const float* KMp = KMF + (size_t)(b * 16 + h) * 16 * 128;
                att::prime<true, true>(r, (char*)lds + RING_OFF, S, KMp);
                unsigned sel = 0u;
                if (qb > 0) { int ln_ = (int)(threadIdx.x & 63u); asm volatile("" : "+v"(ln_)); sel = att::moba_select(S, (const char*)lds + RING_OFF, qb, ln_ & 31, ln_ >> 5); }
                att::q8_from_qr(S);
                att::block<att::EpiSelf, true>(r, SEQ, (char*)lds + RING_OFF, S, true, sel, E);
            }
            ++pass;
        }
        for (; cd * NGW < ND; ++cd) { const int it = cd * NGW + gw; if (it < ND) P3_DEFERRED(it); }
#undef P3_DEFERRED
        }
        GRID_BAR(3);
    }

    if (IN(4)) {
        pg8::Gemm g{(const bf16*)MERGED8, (const bf16*)W_OUT8, MTOK, DMODEL, DMODEL  }; pg8::StaticOrder S; S.init(MTOK, DMODEL, G, bx);
        pg8::EpiRes<false> E{XB, XB, XB8, SS1, 1.0f / 64.0f};
        pg8::gemm_phase_f8<pg8::EpiRes<false>, pg8::StaticOrder, true, true, false, true>(ldsl + RING_OFF, g, S, E);
        if (NREP(4) == 2) { E.ss = SS1 + 3 * 16384; E.sc = 0.f; pg8::gemm_phase_f8<pg8::EpiRes<false>, pg8::StaticOrder, true, true, false, true>(ldsl + RING_OFF, g, S, E); }
        GRID_BAR(4);
    }

    if (IN(5)) {
        pg8::Gemm g{(const bf16*)XB8, (const bf16*)W_CQKV8, MTOK + BATCH * MEMLEN, 3 * MEMW, DMODEL  }; pg8::CrossOrder S{G, bx};
        pg8::EpiCross E{QC, KC, VC, SS1, 1.0f / 64.0f};
        pg8::gemm_phase_f8<pg8::EpiCross, pg8::CrossOrder, true, true, false, true>(ldsl + RING_OFF, g, S, E);
        if (NREP(5) == 2) pg8::gemm_phase_f8<pg8::EpiCross, pg8::CrossOrder, true, true, false, true>(ldsl + RING_OFF, g, S, E);
        GRID_BAR(5);
    }

    if (IN(6)) {
        att::Seam S;
        for (int rep = 0; rep < NREP(6); ++rep)
        for (int u = bx; u < 256; u += G) {
            const int b = u >> 6, hh = (u >> 4) & 3, qb = u & 15;
            att::BlockRef r; r.Q = QC + ((size_t)(b * 4 + hh) * 4096 + qb * 256) * 128; r.K = KC + (size_t)(b * 4 + hh) * 256 * 128; r.V = VC + (size_t)(b * 4 + hh) * 256 * 128; r.P0 = 1 << 20;
            att::EpiMem E{(unsigned char*)OC + (size_t)(b * 4096 + qb * 256) * 512 + hh * 128};
            att::prime(r, (char*)lds + RING_OFF, S);
            att::block<att::EpiMem>(r, MEMLEN, (char*)lds + RING_OFF, S, false, 0u, E);
        }
        GRID_BAR(6);
    }

    if (IN(7)) {
        pg8::Gemm g{OC, W_CO_T, MTOK, DMODEL, MEMW  }; pg8::StaticOrder S; S.init(MTOK, DMODEL, G, bx);
        pg8::EpiRes<false> E{XB, XB, XB8, SS2, 1.0f / 1024.0f};
        pg8::gemm_phase_f8<pg8::EpiRes<false>, pg8::StaticOrder, true, true, false, true>(ldsl + RING_OFF, g, S, E);
        if (NREP(7) == 2) { E.ss = SS1 + 3 * 16384; E.sc = 0.f; pg8::gemm_phase_f8<pg8::EpiRes<false>, pg8::StaticOrder, true, true, false, true>(ldsl + RING_OFF, g, S, E); }
        GRID_BAR(7);
    }

    if (IN(8)) {
        pg8::Gemm g{(const bf16*)XB8, (const bf16*)W_UP8, MTOK, DFF, DMODEL  }; pg8::StaticOrder S; S.init(MTOK, DFF, G, bx);
        pg8::EpiUp8 E{U8, SS2};
        pg8::gemm_phase_f8<pg8::EpiUp8, pg8::StaticOrder, true, true, false, true>(ldsl + RING_OFF, g, S, E);
        if (NREP(8) == 2) pg8::gemm_phase_f8<pg8::EpiUp8, pg8::StaticOrder, true, true, false, true>(ldsl + RING_OFF, g, S, E);
        GRID_BAR(8);
    }

    if (IN(9)) {
        pg8::Gemm g{(const bf16*)U8, (const bf16*)W_DN8, MTOK, DMODEL, DFF  }; pg8::StaticOrder S; S.init(MTOK, DMODEL, G, bx);
        pg8::EpiRes<false> E{XB, XB, nullptr, SS3, 1.0f / 512.0f};
        pg8::gemm_phase_f8<pg8::EpiRes<false>, pg8::StaticOrder, true, true, true, true>(ldsl + RING_OFF, g, S, E);
        if (NREP(9) == 2) { E.ss = SS1 + 3 * 16384; E.sc = 0.f; pg8::gemm_phase_f8<pg8::EpiRes<false>, pg8::StaticOrder, true, true, true, true>(ldsl + RING_OFF, g, S, E); }
        GRID_BAR(9);
    }

    if (IN(10)) {
        const GAS f32x4* gr = (const GAS f32x4*)final_g + 2 * lane;
        for (int m = gw; m < MTOK; m += NGW) {
            const GAS v4u* xr = (const GAS v4u*)(XB + (size_t)m * DMODEL) + lane;
            GAS f32x4* orow = (GAS f32x4*)(out + (size_t)m * DMODEL) + 2 * lane;
            const float rs = rsqrtf(__hip_atomic_load(SS3 + m, __ATOMIC_RELAXED, __HIP_MEMORY_SCOPE_AGENT) * (1.0f / DMODEL) + 1e-5f);
#pragma unroll
            for (int j = 0; j < 8; ++j) { const v4u w = __builtin_nontemporal_load(xr + 64 * j); const f32x4 g0 = gr[128 * j], g1 = gr[128 * j + 1];
                const f32x4 a0 = {__uint_as_float(w.x << 16), __uint_as_float(w.x & 0xffff0000u), __uint_as_float(w.y << 16), __uint_as_float(w.y & 0xffff0000u)};
                const f32x4 a1 = {__uint_as_float(w.z << 16), __uint_as_float(w.z & 0xffff0000u), __uint_as_float(w.w << 16), __uint_as_float(w.w & 0xffff0000u)};
                __builtin_nontemporal_store(a0 * rs * g0, orow + 128 * j); __builtin_nontemporal_store(a1 * rs * g1, orow + 128 * j + 1); }
        }
    }
#undef IN
#undef BOTH
#undef GRID_BAR
}

extern "C" void kernel_launch(void* const* d_in, const int* in_sizes, int n_in, void* d_out, int out_size, void* d_ws, size_t ws_size, hipStream_t stream) {
    static int grid = 0;
    if (grid == 0) {
        if (n_in != 20 || in_sizes[0] != MTOK * DMODEL || out_size != MTOK * DMODEL || ws_size < WS_END) {
            fprintf(stderr, "kernel_launch: built for 20 inputs, x/out of %d floats, >= %zu bytes of workspace; got n_in %d, in0 %d, out %d, ws %zu; nothing launched\n", MTOK * DMODEL, (size_t)WS_END, n_in, n_in > 0 ? in_sizes[0] : -1, out_size, ws_size);
            grid = -1; return; }
        int dev = 0, cus = 0, per_cu = 0;
        if (hipGetDevice(&dev) != hipSuccess || hipDeviceGetAttribute(&cus, hipDeviceAttributeMultiprocessorCount, dev) != hipSuccess) { fprintf(stderr, "kernel_launch: device query failed\n"); grid = -1; return; }
        if (hipFuncSetAttribute((const void*)mk_fwd, hipFuncAttributeMaxDynamicSharedMemorySize, LDS_BYTES) != hipSuccess) { fprintf(stderr, "kernel_launch: hipFuncSetAttribute failed\n"); grid = -1; return; }
        if (hipOccupancyMaxActiveBlocksPerMultiprocessor(&per_cu, (const void*)mk_fwd, NWAVES * 64, LDS_BYTES) != hipSuccess || per_cu < 1)
            fprintf(stderr, "kernel_launch: note: the occupancy query reports %d workgroups per CU\n", per_cu);
        (void)hipGetLastError();
        grid = cus;
    }
    if (grid < 0) return;
    if (hipMemsetAsync((char*)d_ws + WS_CTL, 0, CTL_ZERO_BYTES, stream) != hipSuccess) { fprintf(stderr, "kernel_launch: hipMemsetAsync failed\n"); return; }
    Args a{};
    for (int i = 0; i < 20; ++i) a.in[i] = (const float*)d_in[i];
    a.out = (float*)d_out; a.ws = (unsigned char*)d_ws;
    for (int li = 0; li < N_LAUNCHES; ++li) {
        a.ph_lo = (N_LAUNCHES == 1) ? 0 : li; a.ph_hi = (N_LAUNCHES == 1) ? NPHASE : li + 1;
        hipLaunchKernelGGL(mk_fwd, dim3(grid), dim3(NWAVES * 64), LDS_BYTES, stream, a);
        const hipError_t le = hipPeekAtLastError();
        if (le != hipSuccess) { fprintf(stderr, "kernel_launch: launch %d failed: %s\n", li, hipGetErrorName(le)); break; }
    }
}
```
